# Optimizing an MI355X kernel written in HIP

```python
import math
import jax
import jax.numpy as jnp
from jax import lax
import numpy as np

D_MODEL = 1024
BATCH = 8
SEQ = 8192
DEPTH = 1
DEC_BATCH = 8
DEC_SEQ = 32
PAST_LEN = 2048

CHUNK = 64
D_MIX = D_MODEL
SSD_WIDTH = D_MIX // 2
SSD_HEAD_DIM = 64
SSD_HEADS = SSD_WIDTH // SSD_HEAD_DIM
SSD_GROUPS = 2
SSD_HEADS_PER_GROUP = SSD_HEADS // SSD_GROUPS
SSD_STATE = 128
SSD_CONV = 4
SSD_CONV_DIM = SSD_WIDTH + 2 * SSD_GROUPS * SSD_STATE
SSD_CHUNK = CHUNK
S5_WIDTH = D_MIX - SSD_WIDTH
S5_GROUP_CH = 16
S5_GROUPS = S5_WIDTH // S5_GROUP_CH
S5_STATE = 64
D_FF = 2816
FFN_CONV = 3
D_IN = SSD_WIDTH + SSD_CONV_DIM + SSD_HEADS + S5_WIDTH
EPS = 1e-6

kernel_name = "hybrid_ssd_s5_streaming_step"


def rmsnorm(x, w):
    xf = x.astype(jnp.float32)
    xf = xf * lax.rsqrt(jnp.mean(xf * xf, axis=-1, keepdims=True) + EPS)
    return (xf * w.astype(jnp.float32)).astype(x.dtype)


def causal_dwconv(u, hist, w, b):
    k = w.shape[0]
    length = u.shape[1]
    full = jnp.concatenate([hist.astype(u.dtype), u], axis=1)
    out = b + full[:, 0:length] * w[0]
    for i in range(1, k):
        out = out + full[:, i:i + length] * w[i]
    return out, full[:, length:]


def ssd_scan(xs, dt, a, bm, cm, h0):
    bsz, length, nh, hd = xs.shape
    q = SSD_CHUNK if length % SSD_CHUNK == 0 else length
    nc = length // q
    x_c = xs.reshape(bsz, nc, q, nh, hd)
    dt_c = dt.reshape(bsz, nc, q, nh)
    b_c = bm.reshape(bsz, nc, q, nh, SSD_STATE)
    c_c = cm.reshape(bsz, nc, q, nh, SSD_STATE)
    cs = jnp.cumsum(dt_c * a, axis=2)
    causal = jnp.tril(jnp.ones((q, q), dtype=bool))[None, None, :, :, None]
    seg = cs[:, :, :, None, :] - cs[:, :, None, :, :]
    decay = jnp.exp(jnp.where(causal, seg, -jnp.inf))
    scores = jnp.einsum("bclhn,bcshn->bclsh", c_c, b_c)
    y_diag = jnp.einsum("bclsh,bcshp->bclhp", scores * decay * dt_c[:, :, None, :, :], x_c)
    w_end = jnp.exp(cs[:, :, -1:, :] - cs) * dt_c
    states = jnp.einsum("bcshn,bcsh,bcshp->bchpn", b_c, w_end, x_c)
    chunk_decay = jnp.exp(cs[:, :, -1, :])

    def step(h, inp):
        st, dcy = inp
        return h * dcy[:, :, None, None] + st, h

    h_final, h_prev = lax.scan(step, h0.astype(states.dtype),
                               (jnp.moveaxis(states, 1, 0), jnp.moveaxis(chunk_decay, 1, 0)))
    h_prev = jnp.moveaxis(h_prev, 0, 1)
    y_off = jnp.einsum("bclhn,bchpn,bclh->bclhp", c_c, h_prev, jnp.exp(cs))
    return (y_diag + y_off).reshape(bsz, length, nh, hd), h_final


def ssd_mixer(z, xbc, dt_raw, conv_hist, h0, conv_w, conv_b, dt_bias, a_log, d, norm_w):
    bsz, length, _ = z.shape
    xbc, new_conv = causal_dwconv(xbc, conv_hist, conv_w, conv_b)
    xbc = jax.nn.silu(xbc)
    xs, bm, cm = jnp.split(xbc, [SSD_WIDTH, SSD_WIDTH + SSD_GROUPS * SSD_STATE], axis=-1)
    xs = xs.reshape(bsz, length, SSD_HEADS, SSD_HEAD_DIM)
    bm = jnp.repeat(bm.reshape(bsz, length, SSD_GROUPS, SSD_STATE), SSD_HEADS_PER_GROUP, axis=2)
    cm = jnp.repeat(cm.reshape(bsz, length, SSD_GROUPS, SSD_STATE), SSD_HEADS_PER_GROUP, axis=2)
    dt = jax.nn.softplus(dt_raw + dt_bias)
    a = -jnp.exp(a_log)
    y, h_new = ssd_scan(xs, dt, a, bm, cm, h0)
    y = y + d[:, None] * xs
    g = (y.reshape(bsz, length, SSD_WIDTH) * jax.nn.silu(z)).reshape(bsz, length, SSD_GROUPS, -1)
    g = rmsnorm(g, norm_w.reshape(SSD_GROUPS, -1)).reshape(bsz, length, SSD_WIDTH)
    return g, new_conv, h_new


def complex_affine_combine(e1, e2):
    a1r, a1i, b1r, b1i = e1
    a2r, a2i, b2r, b2i = e2
    return (a2r * a1r - a2i * a1i,
            a2r * a1i + a2i * a1r,
            a2r * b1r - a2i * b1i + b2r,
            a2r * b1i + a2i * b1r + b2i)


def s5_mixer(u, h0_re, h0_im, lam_re, lam_im, log_dt, b_re, b_im, c_re, c_im, d, glu_w, glu_b):
    bsz, length, _ = u.shape
    ug = u.reshape(bsz, length, S5_GROUPS, S5_GROUP_CH)
    dt = jnp.exp(log_dt)[:, None]
    mag = jnp.exp(lam_re * dt)
    ang = lam_im * dt
    lb_re = mag * jnp.cos(ang)
    lb_im = mag * jnp.sin(ang)
    den = lam_re * lam_re + lam_im * lam_im
    q_re = ((lb_re - 1) * lam_re + lb_im * lam_im) / den
    q_im = (lb_im * lam_re - (lb_re - 1) * lam_im) / den
    bb_re = q_re[..., None] * b_re - q_im[..., None] * b_im
    bb_im = q_re[..., None] * b_im + q_im[..., None] * b_re
    bu_re = jnp.einsum("blgc,gpc->blgp", ug, bb_re)
    bu_im = jnp.einsum("blgc,gpc->blgp", ug, bb_im)
    first_re = bu_re[:, 0] + lb_re * h0_re - lb_im * h0_im
    first_im = bu_im[:, 0] + lb_re * h0_im + lb_im * h0_re
    bu_re = bu_re.at[:, 0].set(first_re.astype(bu_re.dtype))
    bu_im = bu_im.at[:, 0].set(first_im.astype(bu_im.dtype))
    a_re = jnp.broadcast_to(lb_re, (1, length, S5_GROUPS, S5_STATE))
    a_im = jnp.broadcast_to(lb_im, (1, length, S5_GROUPS, S5_STATE))
    _, _, h_re, h_im = lax.associative_scan(complex_affine_combine, (a_re, a_im, bu_re, bu_im), axis=1)
    y = (jnp.einsum("blgp,gcp->blgc", h_re, c_re) - jnp.einsum("blgp,gcp->blgc", h_im, c_im)
         + d * ug)
    g = jnp.einsum("blgc,gck->blgk", jax.nn.gelu(y, approximate=True), glu_w) + glu_b
    out = g[..., :S5_GROUP_CH] * jax.nn.sigmoid(g[..., S5_GROUP_CH:])
    return out.reshape(bsz, length, S5_WIDTH), h_re[:, -1], h_im[:, -1]


def hybrid_layer(x, conv_hist, ssd_h0, s5_h0_re, s5_h0_im, ffn_hist,
                 pre_mix_norm_w, w_in, ssd_conv_w, ssd_conv_b, ssd_dt_bias, ssd_a_log, ssd_d, ssd_norm_w,
                 s5_lambda_re, s5_lambda_im, s5_log_dt, s5_b_re, s5_b_im, s5_c_re, s5_c_im, s5_d,
                 s5_glu_w, s5_glu_b, w_out, post_mix_norm_w, pre_ffn_norm_w, w_up, ffn_conv_w, ffn_conv_b,
                 w_down, post_ffn_norm_w):
    xn = rmsnorm(x, pre_mix_norm_w)
    proj = xn @ w_in
    z, xbc, dt_raw, u_s5 = jnp.split(
        proj, [SSD_WIDTH, SSD_WIDTH + SSD_CONV_DIM, SSD_WIDTH + SSD_CONV_DIM + SSD_HEADS], axis=-1)
    y_ssd, new_conv, new_ssd = ssd_mixer(z, xbc, dt_raw, conv_hist, ssd_h0, ssd_conv_w, ssd_conv_b,
                                         ssd_dt_bias, ssd_a_log, ssd_d, ssd_norm_w)
    y_s5, new_re, new_im = s5_mixer(u_s5, s5_h0_re, s5_h0_im, s5_lambda_re, s5_lambda_im, s5_log_dt,
                                    s5_b_re, s5_b_im, s5_c_re, s5_c_im, s5_d, s5_glu_w, s5_glu_b)
    mix = jnp.concatenate([y_ssd, y_s5], axis=-1) @ w_out
    h = x + rmsnorm(mix, post_mix_norm_w)
    up, new_ffn = causal_dwconv(rmsnorm(h, pre_ffn_norm_w) @ w_up, ffn_hist, ffn_conv_w, ffn_conv_b)
    gate, val = jnp.split(up, 2, axis=-1)
    ffn = (jax.nn.gelu(gate, approximate=True) * val) @ w_down
    y = h + rmsnorm(ffn, post_ffn_norm_w)
    return y, new_conv, new_ssd, new_re, new_im, new_ffn


def setup_inputs(seed: int = 0) -> dict:
    key = jax.random.key(seed)
    ks = iter(jax.random.split(key, 48))

    def nrm(shape, scale):
        return jax.random.normal(next(ks), shape, jnp.float32) * scale

    def gain(shape):
        return 1.0 + nrm(shape, 0.05)

    dt0 = jnp.exp(jax.random.uniform(next(ks), (DEPTH, SSD_HEADS), jnp.float32,
                                     minval=math.log(1e-3), maxval=math.log(1e-1)))
    n_idx = jnp.arange(S5_STATE, dtype=jnp.float32)
    return {
        "x_prompt": nrm((BATCH, SEQ, D_MODEL), 1.0),
        "x_sample": nrm((DEC_BATCH, DEC_SEQ, D_MODEL), 1.0),
        "cache_ssd_conv": nrm((DEPTH, DEC_BATCH, SSD_CONV - 1, SSD_CONV_DIM), 1.0),
        "state_ssd": nrm((DEPTH, DEC_BATCH, SSD_HEADS, SSD_HEAD_DIM, SSD_STATE), 0.1),
        "state_s5_re": nrm((DEPTH, DEC_BATCH, S5_GROUPS, S5_STATE), 0.5),
        "state_s5_im": nrm((DEPTH, DEC_BATCH, S5_GROUPS, S5_STATE), 0.5),
        "cache_ffn_conv": nrm((DEPTH, DEC_BATCH, FFN_CONV - 1, 2 * D_FF), 1.0),
        "pre_mix_norm_w": gain((DEPTH, D_MODEL)),
        "w_in": nrm((DEPTH, D_MODEL, D_IN), D_MODEL ** -0.5),
        "ssd_conv_w": nrm((DEPTH, SSD_CONV, SSD_CONV_DIM), 0.3),
        "ssd_conv_b": nrm((DEPTH, SSD_CONV_DIM), 0.02),
        "ssd_dt_bias": dt0 + jnp.log(-jnp.expm1(-dt0)),
        "ssd_a_log": jnp.log(jax.random.uniform(next(ks), (DEPTH, SSD_HEADS), jnp.float32, minval=1.0, maxval=16.0)),
        "ssd_d": 1.0 + nrm((DEPTH, SSD_HEADS), 0.1),
        "ssd_norm_w": gain((DEPTH, SSD_WIDTH)),
        "s5_lambda_re": -0.5 + nrm((DEPTH, S5_GROUPS, S5_STATE), 0.01),
        "s5_lambda_im": math.pi * n_idx + nrm((DEPTH, S5_GROUPS, S5_STATE), 0.01),
        "s5_log_dt": jax.random.uniform(next(ks), (DEPTH, S5_GROUPS), jnp.float32,
                                        minval=math.log(1e-3), maxval=math.log(1e-1)),
        "s5_b_re": nrm((DEPTH, S5_GROUPS, S5_STATE, S5_GROUP_CH), (2 * S5_GROUP_CH) ** -0.5),
        "s5_b_im": nrm((DEPTH, S5_GROUPS, S5_STATE, S5_GROUP_CH), (2 * S5_GROUP_CH) ** -0.5),
        "s5_c_re": nrm((DEPTH, S5_GROUPS, S5_GROUP_CH, S5_STATE), (2 * S5_STATE) ** -0.5),
        "s5_c_im": nrm((DEPTH, S5_GROUPS, S5_GROUP_CH, S5_STATE), (2 * S5_STATE) ** -0.5),
        "s5_d": nrm((DEPTH, S5_GROUPS, S5_GROUP_CH), 0.5),
        "s5_glu_w": nrm((DEPTH, S5_GROUPS, S5_GROUP_CH, 2 * S5_GROUP_CH), S5_GROUP_CH ** -0.5),
        "s5_glu_b": nrm((DEPTH, S5_GROUPS, 2 * S5_GROUP_CH), 0.02),
        "w_out": nrm((DEPTH, D_MIX, D_MODEL), D_MIX ** -0.5),
        "post_mix_norm_w": gain((DEPTH, D_MODEL)),
        "pre_ffn_norm_w": gain((DEPTH, D_MODEL)),
        "w_up": nrm((DEPTH, D_MODEL, 2 * D_FF), D_MODEL ** -0.5),
        "ffn_conv_w": nrm((DEPTH, FFN_CONV, 2 * D_FF), 0.5),
        "ffn_conv_b": nrm((DEPTH, 2 * D_FF), 0.02),
        "w_down": nrm((DEPTH, D_FF, D_MODEL), D_FF ** -0.5),
        "post_ffn_norm_w": gain((DEPTH, D_MODEL)),
    }


def reference(x_prompt, x_sample, cache_ssd_conv, state_ssd, state_s5_re, state_s5_im, cache_ffn_conv,
              pre_mix_norm_w, w_in, ssd_conv_w, ssd_conv_b, ssd_dt_bias, ssd_a_log, ssd_d, ssd_norm_w,
              s5_lambda_re, s5_lambda_im, s5_log_dt, s5_b_re, s5_b_im, s5_c_re, s5_c_im, s5_d,
              s5_glu_w, s5_glu_b, w_out, post_mix_norm_w, pre_ffn_norm_w, w_up, ffn_conv_w, ffn_conv_b,
              w_down, post_ffn_norm_w):
    bsz = x_prompt.shape[0]
    dtp = x_prompt.dtype
    y_prompt, y_sample = x_prompt, x_sample
    p_conv, p_ssd, p_re, p_im, p_ffn = [], [], [], [], []
    s_conv, s_ssd, s_re, s_im, s_ffn = [], [], [], [], []
    for l in range(DEPTH):
        lw = (pre_mix_norm_w[l], w_in[l], ssd_conv_w[l], ssd_conv_b[l], ssd_dt_bias[l], ssd_a_log[l],
              ssd_d[l], ssd_norm_w[l], s5_lambda_re[l], s5_lambda_im[l], s5_log_dt[l], s5_b_re[l],
              s5_b_im[l], s5_c_re[l], s5_c_im[l], s5_d[l], s5_glu_w[l], s5_glu_b[l], w_out[l],
              post_mix_norm_w[l], pre_ffn_norm_w[l], w_up[l], ffn_conv_w[l], ffn_conv_b[l], w_down[l],
              post_ffn_norm_w[l])
        y_prompt, pc, ph, pr, pi_, pf = hybrid_layer(
            y_prompt,
            jnp.zeros((bsz, SSD_CONV - 1, SSD_CONV_DIM), dtp),
            jnp.zeros((bsz, SSD_HEADS, SSD_HEAD_DIM, SSD_STATE), dtp),
            jnp.zeros((bsz, S5_GROUPS, S5_STATE), dtp),
            jnp.zeros((bsz, S5_GROUPS, S5_STATE), dtp),
            jnp.zeros((bsz, FFN_CONV - 1, 2 * D_FF), dtp),
            *lw)
        y_sample, sc, sh, sr, si, sf = hybrid_layer(
            y_sample, cache_ssd_conv[l], state_ssd[l], state_s5_re[l], state_s5_im[l], cache_ffn_conv[l], *lw)
        p_conv.append(pc); p_ssd.append(ph); p_re.append(pr); p_im.append(pi_); p_ffn.append(pf)
        s_conv.append(sc); s_ssd.append(sh); s_re.append(sr); s_im.append(si); s_ffn.append(sf)
    new_ssd_conv_prompt = jnp.stack(p_conv)
    new_ssd_state_prompt = jnp.stack(p_ssd)
    new_s5_re_prompt = jnp.stack(p_re)
    new_s5_im_prompt = jnp.stack(p_im)
    new_ffn_conv_prompt = jnp.stack(p_ffn)
    new_ssd_conv_sample = jnp.stack(s_conv)
    new_ssd_state_sample = jnp.stack(s_ssd)
    new_s5_re_sample = jnp.stack(s_re)
    new_s5_im_sample = jnp.stack(s_im)
    new_ffn_conv_sample = jnp.stack(s_ffn)
    return (y_prompt, y_sample,
            new_ssd_conv_prompt, new_ssd_state_prompt, new_s5_re_prompt, new_s5_im_prompt, new_ffn_conv_prompt,
            new_ssd_conv_sample, new_ssd_state_sample, new_s5_re_sample, new_s5_im_sample, new_ffn_conv_sample)
```

```cpp
#include <hip/hip_runtime.h>
#include <hip/hip_cooperative_groups.h>
#include <cstdio>
namespace cg = cooperative_groups;

#ifndef ONE_LAUNCH
#define ONE_LAUNCH 1
#endif

#define LAS __attribute__((address_space(3)))
typedef unsigned short bf16_t;
typedef short bf16x8 __attribute__((ext_vector_type(8)));
typedef short bf16x4 __attribute__((ext_vector_type(4)));
typedef float f32x4 __attribute__((ext_vector_type(4)));
typedef float f32x16 __attribute__((ext_vector_type(16)));
typedef unsigned u32x4 __attribute__((ext_vector_type(4)));
typedef unsigned u32x2 __attribute__((ext_vector_type(2)));

constexpr int DM = 1024, SEQ = 8192, NBATCH = 8, DSEQ = 32;
constexpr int RP = NBATCH * SEQ;
constexpr int RS = NBATCH * DSEQ;
constexpr int R = RP + RS;
constexpr int NPROJ = 2048;
constexpr int DFF = 2816, NUP = 5632;
constexpr int NCHUNK = 128;
constexpr int NUNITS_BC = NBATCH * NCHUNK + NBATCH;
constexpr float EPS = 1e-6f;

constexpr size_t MiB = 1u << 20;
constexpr size_t WS_BAR = 512 * 1024;
constexpr size_t WS_WDT = 0;
constexpr size_t WS_RSTD1 = 1 * MiB, WS_SUMSQ2 = 1 * MiB + 512 * 1024, WS_RSTD3 = 2 * MiB, WS_SUMSQ4 = 2 * MiB + 512 * 1024;
constexpr size_t WS_DTV = 3 * MiB;
constexpr size_t WS_CDEC = 6 * MiB;
constexpr size_t WS_S5LOC = 7 * MiB, WS_S5HIN = 8 * MiB;
constexpr size_t WS_WIN = 10 * MiB, WS_WOUT = 14 * MiB, WS_WUP = 16 * MiB, WS_WDOWN = 28 * MiB;
constexpr size_t WS_HB = 36 * MiB;
constexpr size_t WS_PROJ = 168 * MiB;
constexpr size_t WS_SST = 426 * MiB;
constexpr size_t WS_MIXIN = 556 * MiB;
constexpr size_t WS_MIX = 686 * MiB;
constexpr size_t WS_ACT = 168 * MiB;
constexpr size_t WS_FFN = 556 * MiB;
constexpr size_t WS_END = 816 * MiB;

constexpr size_t O_YP = 0, O_YS = O_YP + (size_t)RP * DM, O_CONVP = O_YS + (size_t)RS * DM, O_SSDP = O_CONVP + 8 * 3 * 1024,
                 O_S5REP = O_SSDP + 8 * 8 * 64 * 128, O_S5IMP = O_S5REP + 8 * 32 * 64, O_FFNP = O_S5IMP + 8 * 32 * 64,
                 O_CONVS = O_FFNP + 8 * 2 * NUP, O_SSDS = O_CONVS + 8 * 3 * 1024, O_S5RES = O_SSDS + 8 * 8 * 64 * 128,
                 O_S5IMS = O_S5RES + 8 * 32 * 64, O_FFNS = O_S5IMS + 8 * 32 * 64;

struct Args {
    const float* in[33];
    float* out; unsigned char* ws;
    int ph_lo, ph_hi;
};
enum { I_XP = 0, I_XS, I_CSSD, I_SSSD, I_S5RE, I_S5IM, I_CFFN, I_PREMIX, I_WIN, I_SCW, I_SCB, I_DTB, I_ALOG, I_SSDD, I_SNW,
       I_LRE, I_LIM, I_LDT, I_BRE, I_BIM, I_CRE, I_CIM, I_S5D, I_GLUW, I_GLUB, I_WOUT, I_POSTMIX, I_PREFFN, I_WUP, I_FCW, I_FCB, I_WDOWN, I_POSTFFN };

__device__ __forceinline__ float bf2f(unsigned v) { return __uint_as_float(v << 16); }
__device__ __forceinline__ unsigned f2bf(float f) { unsigned u = __float_as_uint(f); return (u + 0x7fffu + ((u >> 16) & 1u)) >> 16; }
typedef __bf16 hwbf2 __attribute__((ext_vector_type(2)));
typedef float f32x2 __attribute__((ext_vector_type(2)));
__device__ __forceinline__ unsigned pk2(float lo, float hi) { f32x2 v; v.x = lo; v.y = hi; return __builtin_bit_cast(unsigned, __builtin_convertvector(v, hwbf2)); }
__device__ __forceinline__ float wave_sum(float v) {
#pragma unroll
    for (int o = 1; o < 64; o <<= 1) v += __shfl_xor(v, o);
    return v;
}
__device__ __forceinline__ float silu_f(float v) { return v * __builtin_amdgcn_rcpf(1.f + __builtin_amdgcn_exp2f(-1.4426950409f * v)); }
__device__ __forceinline__ float gelu_tanh(float v) {
    const float w = v * (-2.3022082f + -0.1029432f * (v * v));
    return v * __builtin_amdgcn_rcpf(1.f + __builtin_amdgcn_exp2f(w));
}

namespace pg8 {
constexpr int BM = 256, BK = 64, HALF = 128, HTB = HALF * BK * 2, STAGE_BYTES = 8 * HTB, NXCD = 8, WGM = 8;
__host__ __device__ __forceinline__ int lds_byte(int r, int c) { const int st = (r >> 4) * 2 + (c >> 5), rr = r & 15, cc = c & 31, ob = rr * 64 + cc * 2; return st * 1024 + (ob ^ (((ob >> 9) & 1) << 5)); }
__host__ __device__ __forceinline__ void stage_rc(int b, int& R_, int& C) { const int st = b / 1024, sb = b % 1024, swz = sb ^ (((sb >> 9) & 1) << 5); R_ = (st >> 1) * 16 + swz / 64; C = (st & 1) * 32 + (swz % 64) / 2; }
__host__ __device__ __forceinline__ int perm32(int rho) { const int n = rho >> 4, i = rho & 15; return 8 * (i >> 2) + 4 * n + (i & 3); }
struct Unit { int pm, pn; };
struct Gemm { const bf16_t* A; const bf16_t* Bt; int nM, nN, K, rp64; };
struct StaticOrder {
    int nM, nN, nwg, G, c;
    __device__ void init(int nM_, int nN_, int G_, int c_) { nM = nM_; nN = nN_; nwg = nM * nN; G = G_; c = c_; }
    __device__ bool next(int i, Unit& u) const {
        const long L = (long)i * G + c; if (L >= nwg) return false;
        int wgid = (int)L; { const int q = nwg / NXCD, r = nwg % NXCD, xcd = wgid % NXCD, off = wgid / NXCD; wgid = (xcd < r ? xcd * (q + 1) : r * (q + 1) + (xcd - r) * q) + off; }
        const int nig = WGM * nN, gid = wgid / nig, fm = gid * WGM, gsz = (nM - fm) < WGM ? (nM - fm) : WGM;
        u.pm = fm + ((wgid % nig) % gsz); u.pn = (wgid % nig) / gsz; return true;
    }
};

template <class Epi>
__device__ __forceinline__ void gemm_phase(LAS unsigned char* lds, const Gemm g, const StaticOrder& S, const Epi& E) {
    const int tid = threadIdx.x, wid = __builtin_amdgcn_readfirstlane(tid >> 6), lane = tid & 63, wr = wid >> 2, wc = wid & 3, fr = lane & 15, fq = lane >> 4;
    const int K = g.K, nt = K / BK;
    unsigned voffA[2], voffB[2];
#pragma unroll
    for (int i = 0; i < 2; ++i) { int R_, C; stage_rc(tid * 16 + i * 8192, R_, C); const int Rb = Epi::PERM ? ((R_ & ~31) + perm32(R_ & 31)) : R_;
        const int Ra = (R_ >> 6) * g.rp64 + (R_ & 63);
        voffA[i] = (unsigned)(Ra * K + C) * 2u; voffB[i] = (unsigned)(Rb * K + C) * 2u; }
    const size_t kstep = (size_t)(BK * 2);
    const size_t hstepB = (size_t)HALF * K * 2, tstepB = 2 * hstepB;
    const size_t hstepA = (size_t)2 * g.rp64 * K * 2, tstepA = 2 * hstepA;
    const unsigned ldsw = (unsigned)wid * 1024u;
    const int aoff = lds_byte(wr * 64 + fr, fq * 8), boff = lds_byte(wc * 32 + fr, fq * 8);
#define PG8_SA(b, h) (((b) * 2 + (h)) * HTB)
#define PG8_SB(b, h) ((4 + (b) * 2 + (h)) * HTB)
#define PG8_STAGE(bufoff, gbase, voff) do { _Pragma("unroll") for (int _i = 0; _i < 2; ++_i) \
        __builtin_amdgcn_global_load_lds((const unsigned*)((const char*)(gbase) + (voff)[_i]), (LAS unsigned*)(lds + (bufoff) + ldsw + _i * 8192), 16, 0, 0); } while (0)
#define PG8_LDA(dst, b, h) do { _Pragma("unroll") for (int m = 0; m < 4; ++m) _Pragma("unroll") for (int k = 0; k < 2; ++k) dst[m][k] = *(const LAS bf16x8*)(lds + PG8_SA(b, h) + aoff + m * 2048 + k * 1024); } while (0)
#define PG8_LDB(dst, b, h) do { _Pragma("unroll") for (int n = 0; n < 2; ++n) _Pragma("unroll") for (int k = 0; k < 2; ++k) dst[n][k] = *(const LAS bf16x8*)(lds + PG8_SB(b, h) + boff + n * 2048 + k * 1024); } while (0)
#define PG8_MMA(ai, bj, At, Bt) do { __builtin_amdgcn_s_setprio(1); _Pragma("unroll") for (int m = 0; m < 4; ++m) _Pragma("unroll") for (int n = 0; n < 2; ++n) _Pragma("unroll") for (int k = 0; k < 2; ++k) \
        acc[ai][bj][m][n] = __builtin_amdgcn_mfma_f32_16x16x32_bf16(Bt[n][k], At[m][k], acc[ai][bj][m][n], 0, 0, 0); __builtin_amdgcn_s_setprio(0); } while (0)
#define PG8_WAIT_V(n) asm volatile("s_waitcnt vmcnt(" #n ")" ::: "memory")
#define PG8_WAIT_L(n) asm volatile("s_waitcnt lgkmcnt(" #n ")" ::: "memory")
#define PG8_BAR __builtin_amdgcn_s_barrier()
#define PG8_SCHED __builtin_amdgcn_sched_barrier(0)
    Unit cur, nxt; int ui = 0;
    if (!S.next(0, cur)) return;
    f32x4 acc[2][2][4][2];
#pragma unroll
    for (int a = 0; a < 2; ++a)
#pragma unroll
        for (int b = 0; b < 2; ++b)
#pragma unroll
            for (int m = 0; m < 4; ++m)
#pragma unroll
                for (int n = 0; n < 2; ++n) acc[a][b][m][n] = (f32x4){0.f, 0.f, 0.f, 0.f};
    bf16x8 At[4][2], B0[2][2], B1[2][2];
    const char* cA = (const char*)g.A + (size_t)cur.pm * tstepA; const char* cB = (const char*)g.Bt + (size_t)cur.pn * tstepB;
    PG8_STAGE(PG8_SB(0, 0), cB, voffB); PG8_STAGE(PG8_SA(0, 0), cA, voffA); PG8_STAGE(PG8_SB(0, 1), cB + hstepB, voffB); PG8_STAGE(PG8_SA(0, 1), cA + hstepA, voffA);
    if (wr == 1) PG8_BAR;
    PG8_WAIT_V(4); PG8_BAR;
    PG8_STAGE(PG8_SB(1, 0), cB + kstep, voffB); PG8_STAGE(PG8_SA(1, 0), cA + kstep, voffA); PG8_STAGE(PG8_SB(1, 1), cB + hstepB + kstep, voffB);
    PG8_WAIT_V(6); PG8_BAR;
    for (;;) {
        const bool has_next = S.next(ui + 1, nxt);
        const char* nA = has_next ? (const char*)g.A + (size_t)nxt.pm * tstepA : cA; const char* nB = has_next ? (const char*)g.Bt + (size_t)nxt.pn * tstepB : cB;
        for (int t = 0; t < nt; t += 2) {
            const bool last = (t == nt - 2);
            const char* a1 = cA + (size_t)(t + 1) * kstep;
            const char* a2 = last ? nA : cA + (size_t)(t + 2) * kstep; const char* b2 = last ? nB : cB + (size_t)(t + 2) * kstep;
            const char* a3 = a2 + kstep; const char* b3 = b2 + kstep;
            PG8_LDB(B0, 0, 0); PG8_SCHED; PG8_LDA(At, 0, 0); PG8_STAGE(PG8_SA(1, 1), a1 + hstepA, voffA);
            PG8_WAIT_L(8); PG8_BAR; PG8_WAIT_L(0); PG8_MMA(0, 0, At, B0); PG8_BAR; PG8_SCHED;
            PG8_LDB(B1, 0, 1); PG8_STAGE(PG8_SB(0, 0), b2, voffB);
            PG8_BAR; PG8_WAIT_L(0); PG8_MMA(0, 1, At, B1); PG8_BAR;
            PG8_LDA(At, 0, 1); PG8_STAGE(PG8_SA(0, 0), a2, voffA);
            PG8_BAR; PG8_WAIT_L(0); PG8_MMA(1, 0, At, B0); PG8_BAR; PG8_SCHED;
            PG8_STAGE(PG8_SB(0, 1), b2 + hstepB, voffB);
            PG8_WAIT_V(6); PG8_BAR; PG8_MMA(1, 1, At, B1); PG8_BAR;
            PG8_LDB(B0, 1, 0); PG8_SCHED; PG8_LDA(At, 1, 0); PG8_STAGE(PG8_SA(0, 1), a2 + hstepA, voffA);
            PG8_WAIT_L(8); PG8_BAR; PG8_WAIT_L(0); PG8_MMA(0, 0, At, B0); PG8_BAR; PG8_SCHED;
            PG8_LDB(B1, 1, 1); PG8_STAGE(PG8_SB(1, 0), b3, voffB);
            PG8_BAR; PG8_WAIT_L(0); PG8_MMA(0, 1, At, B1); PG8_BAR;
            PG8_LDA(At, 1, 1); PG8_STAGE(PG8_SA(1, 0), a3, voffA);
            PG8_BAR; PG8_WAIT_L(0); PG8_MMA(1, 0, At, B0); PG8_BAR; PG8_SCHED;
            PG8_STAGE(PG8_SB(1, 1), b3 + hstepB, voffB);
            PG8_WAIT_V(6); PG8_BAR; PG8_MMA(1, 1, At, B1); PG8_BAR;
        }
        E(acc, cur, wr, wc, fr, fq);
        if (!has_next) break;
#pragma unroll
        for (int a = 0; a < 2; ++a)
#pragma unroll
            for (int b = 0; b < 2; ++b)
#pragma unroll
                for (int m = 0; m < 4; ++m)
#pragma unroll
                    for (int n = 0; n < 2; ++n) acc[a][b][m][n] = (f32x4){0.f, 0.f, 0.f, 0.f};
        cur = nxt; cA = nA; cB = nB; ++ui;
    }
    PG8_WAIT_V(0);
    if (wr == 0) PG8_BAR;
    PG8_BAR;
#undef PG8_SA
#undef PG8_SB
#undef PG8_STAGE
#undef PG8_LDA
#undef PG8_LDB
#undef PG8_MMA
#undef PG8_WAIT_V
#undef PG8_WAIT_L
#undef PG8_BAR
#undef PG8_SCHED
}
}

struct EpiProj {
    static constexpr bool PERM = true;
    bf16_t* O; const float* rstd; int ldc;
    __device__ __forceinline__ void operator()(const f32x4 (&acc)[2][2][4][2], const pg8::Unit& u, int wr, int wc, int fr, int fq) const {
        const int row0 = u.pm * 256 + wr * 64 + fr, col0 = u.pn * 256 + wc * 32 + 8 * fq;
#pragma unroll
        for (int ai = 0; ai < 2; ++ai)
#pragma unroll
            for (int m = 0; m < 4; ++m) { const int row = row0 + ai * 128 + m * 16; const float s = rstd[row]; bf16_t* rowp = O + (size_t)row * ldc + col0;
#pragma unroll
                for (int bj = 0; bj < 2; ++bj) { const f32x4 v0 = acc[ai][bj][m][0] * s, v1 = acc[ai][bj][m][1] * s;
                    u32x4 w; w.x = pk2(v0[0], v0[1]); w.y = pk2(v0[2], v0[3]); w.z = pk2(v1[0], v1[1]); w.w = pk2(v1[2], v1[3]);
                    *(u32x4*)(rowp + bj * 128) = w; } }
    }
};
struct EpiSq {
    static constexpr bool PERM = true;
    bf16_t* O; float* sumsq; int ldc;
    __device__ __forceinline__ void operator()(const f32x4 (&acc)[2][2][4][2], const pg8::Unit& u, int wr, int wc, int fr, int fq) const {
        const int row0 = u.pm * 256 + wr * 64 + fr, col0 = u.pn * 256 + wc * 32 + 8 * fq;
#pragma unroll
        for (int ai = 0; ai < 2; ++ai)
#pragma unroll
            for (int m = 0; m < 4; ++m) { const int row = row0 + ai * 128 + m * 16; bf16_t* rowp = O + (size_t)row * ldc + col0; float ss = 0.f;
#pragma unroll
                for (int bj = 0; bj < 2; ++bj) { const f32x4 v0 = acc[ai][bj][m][0], v1 = acc[ai][bj][m][1];
                    ss += (v0[0] * v0[0] + v0[1] * v0[1]) + (v0[2] * v0[2] + v0[3] * v0[3]) + (v1[0] * v1[0] + v1[1] * v1[1]) + (v1[2] * v1[2] + v1[3] * v1[3]);
                    u32x4 w; w.x = pk2(v0[0], v0[1]); w.y = pk2(v0[2], v0[3]); w.z = pk2(v1[0], v1[1]); w.w = pk2(v1[2], v1[3]);
                    *(u32x4*)(rowp + bj * 128) = w; }
                ss += __shfl_xor(ss, 16); ss += __shfl_xor(ss, 32);
                if (fq == 0) atomicAdd(sumsq + row, ss); }
    }
};
constexpr int SLAB_LD = 40, SLAB_BYTES = 64 * SLAB_LD;
struct EpiUp {
    static constexpr bool PERM = true;
    bf16_t* act; const float* rstd3; const float* cw; const float* cb; const float* cache; float* outp; float* outs; LAS unsigned char* xl;
    __device__ __forceinline__ void operator()(const f32x4 (&acc)[2][2][4][2], const pg8::Unit& u, int wr, int wc, int fr_, int fq_) const {
        int fr = fr_, fq = fq_; asm volatile("" : "+v"(fr), "+v"(fq));
        LAS unsigned char* slab = xl + (wr * 4 + wc) * SLAB_BYTES;
        const int lane = fq * 16 + fr, cq = lane & 3, rs = lane >> 2;
        const int j0 = u.pn * 128 + wc * 32 + 8 * cq;
        float sc[2][4];
#pragma unroll
        for (int ai = 0; ai < 2; ++ai)
#pragma unroll
            for (int m = 0; m < 4; ++m) { const int row = 248 * u.pm + 62 * (2 * ai + wr) - 2 + 16 * m + fr; sc[ai][m] = (row >= 0 && row < R) ? rstd3[row] : 0.f; }
        f32x4 wn[4];
        { const int colb = j0; wn[0] = *(const f32x4*)(cw + colb); wn[1] = *(const f32x4*)(cw + NUP + colb); wn[2] = *(const f32x4*)(cw + 2 * NUP + colb); wn[3] = *(const f32x4*)(cb + colb); }
        float cgv[4][4];
#pragma unroll
        for (int sp = 0; sp < 8; ++sp) {
            const int ai = sp >> 2, n = (sp >> 1) & 1, bj = sp & 1;
            const int rowbase = 248 * u.pm + 62 * (2 * ai + wr) - 2;
            const f32x4 w0 = wn[0], w1 = wn[1], w2 = wn[2], bb = wn[3];
            if (sp < 7) { const int sq = sp + 1, n2 = (sq >> 1) & 1, bj2 = sq & 1, colb = bj2 * DFF + j0 + 4 * n2;
                wn[0] = *(const f32x4*)(cw + colb); wn[1] = *(const f32x4*)(cw + NUP + colb); wn[2] = *(const f32x4*)(cw + 2 * NUP + colb); wn[3] = *(const f32x4*)(cb + colb); }
#pragma unroll
            for (int m = 0; m < 4; ++m) { const f32x4 v = acc[ai][bj][m][n] * sc[ai][m];
                u32x2 w; w.x = pk2(v[0], v[1]); w.y = pk2(v[2], v[3]); *(LAS u32x2*)(slab + (16 * m + fr) * SLAB_LD + fq * 8) = w; }
            f32x4 p2, p1;
            { const int h1 = rs > 0 ? 4 * rs - 1 : 0, h2 = rs > 0 ? 4 * rs - 2 : 0;
                const u32x2 q1 = *(const LAS u32x2*)(slab + h1 * SLAB_LD + cq * 8), q2 = *(const LAS u32x2*)(slab + h2 * SLAB_LD + cq * 8);
                p1[0] = bf2f(q1.x & 0xffff); p1[1] = bf2f(q1.x >> 16); p1[2] = bf2f(q1.y & 0xffff); p1[3] = bf2f(q1.y >> 16);
                p2[0] = bf2f(q2.x & 0xffff); p2[1] = bf2f(q2.x >> 16); p2[2] = bf2f(q2.y & 0xffff); p2[3] = bf2f(q2.y >> 16); }
#pragma unroll
            for (int i = 0; i < 4; ++i) {
                const int lr = 4 * rs + i, row = rowbase + lr;
                const u32x2 q0 = *(const LAS u32x2*)(slab + lr * SLAB_LD + cq * 8);
                f32x4 cur; cur[0] = bf2f(q0.x & 0xffff); cur[1] = bf2f(q0.x >> 16); cur[2] = bf2f(q0.y & 0xffff); cur[3] = bf2f(q0.y >> 16);
                const bool smp = row >= RP;
                const int t = smp ? ((row - RP) & (DSEQ - 1)) : (row & (SEQ - 1));
                const bool valid = (lr >= 2) && (row < R) && (t >= 2);
                const f32x4 cv = bb + w0 * p2 + w1 * p1 + w2 * cur;
                p2 = p1; p1 = cur;
                if (bj == 0) { cgv[i][0] = cv[0]; cgv[i][1] = cv[1]; cgv[i][2] = cv[2]; cgv[i][3] = cv[3]; }
                else { u32x2 w; w.x = pk2(gelu_tanh(cgv[i][0]) * cv[0], gelu_tanh(cgv[i][1]) * cv[1]); w.y = pk2(gelu_tanh(cgv[i][2]) * cv[2], gelu_tanh(cgv[i][3]) * cv[3]); if (valid) *(u32x2*)(act + (size_t)row * DFF + j0 + 4 * n) = w; }
            }
        }
    }
};

template <int MODE>
__device__ __forceinline__ void mini_gemm(LAS unsigned char* lds, const bf16_t* A, const bf16_t* Bt, int K, int N, bf16_t* O, int ldc, const float* rstd, float* sumsq, int bx, int G, int tid, int wave, int lane) {
    const int r = lane & 31, hf = lane >> 5, ntn = N >> 5, ntiles = 8 * ntn, kw = K >> 3;
    LAS float* red = (LAS float*)lds;
    for (int tile = bx; tile < ntiles; tile += G) {
        const int m0 = (tile / ntn) * 32, n0 = (tile % ntn) * 32;
        const bf16_t* ap = A + (size_t)(m0 + r) * K + wave * kw + 8 * hf; const bf16_t* bp = Bt + (size_t)(n0 + r) * K + wave * kw + 8 * hf;
        f32x16 acc; for (int i = 0; i < 16; ++i) acc[i] = 0.f;
        for (int k = 0; k < kw; k += 16) { const bf16x8 af = *(const bf16x8*)(ap + k), bf = *(const bf16x8*)(bp + k); acc = __builtin_amdgcn_mfma_f32_32x32x16_bf16(af, bf, acc, 0, 0, 0); }
        __syncthreads();
#pragma unroll
        for (int i = 0; i < 16; ++i) red[(wave * 16 + i) * 64 + lane] = acc[i];
        __syncthreads();
#pragma unroll
        for (int h2 = 0; h2 < 2; ++h2) {
            const int e = tid + h2 * 512, i = e >> 6, ln = e & 63;
            float v = 0.f;
#pragma unroll
            for (int w = 0; w < 8; ++w) v += red[(w * 16 + i) * 64 + ln];
            const int row = m0 + (i & 3) + 8 * (i >> 2) + 4 * (ln >> 5), col = n0 + (ln & 31);
            if (MODE == 0) { O[(size_t)row * ldc + col] = (bf16_t)f2bf(v * rstd[row]); }
            else { O[(size_t)row * ldc + col] = (bf16_t)f2bf(v); float ss = v * v;
#pragma unroll
                for (int o = 1; o < 32; o <<= 1) ss += __shfl_xor(ss, o);
                if ((ln & 31) == 0) atomicAdd(sumsq + row, ss); }
        }
    }
    __syncthreads();
}

__device__ __forceinline__ int fix_row(int m) { const int sq = m >> 2, k4 = m & 3; return sq < 8 ? sq * SEQ + (k4 < 2 ? k4 : SEQ - 4 + k4) : RP + (sq - 8) * DSEQ + (k4 < 2 ? k4 : DSEQ - 4 + k4); }
__device__ __forceinline__ void up_fixup(const Args& a, LAS unsigned char* lds, int bx, int G, int tid, int wave, int lane) {
    const int r = lane & 31, hf = lane >> 5;
    LAS float* red = (LAS float*)lds;
    LAS float* tile = (LAS float*)(lds + 65536);
    const bf16_t* hb = (const bf16_t*)(a.ws + WS_HB); const bf16_t* W = (const bf16_t*)(a.ws + WS_WUP); const float* rstd3 = (const float*)(a.ws + WS_RSTD3);
    for (int item = bx; item < 176; item += G) {
        const int mt = item / 88, cp = item % 88, pn = cp >> 2, sub = cp & 3;
        const bf16_t* ap = hb + (size_t)fix_row(mt * 32 + r) * DM + wave * 128 + 8 * hf;
        const bf16_t* bg = W + (size_t)(256 * pn + 32 * sub + r) * DM + wave * 128 + 8 * hf; const bf16_t* bv = bg + (size_t)128 * DM;
        f32x16 ag, av; for (int i = 0; i < 16; ++i) { ag[i] = 0.f; av[i] = 0.f; }
#pragma unroll
        for (int k = 0; k < 128; k += 16) { const bf16x8 af = *(const bf16x8*)(ap + k); ag = __builtin_amdgcn_mfma_f32_32x32x16_bf16(af, *(const bf16x8*)(bg + k), ag, 0, 0, 0); av = __builtin_amdgcn_mfma_f32_32x32x16_bf16(af, *(const bf16x8*)(bv + k), av, 0, 0, 0); }
        __syncthreads();
#pragma unroll
        for (int i = 0; i < 16; ++i) { red[((wave * 2 + 0) * 16 + i) * 64 + lane] = ag[i]; red[((wave * 2 + 1) * 16 + i) * 64 + lane] = av[i]; }
        __syncthreads();
#pragma unroll
        for (int h4 = 0; h4 < 4; ++h4) {
            const int e = tid + h4 * 512, gv = e >> 10, i = (e >> 6) & 15, ln = e & 63;
            float v = 0.f;
#pragma unroll
            for (int w = 0; w < 8; ++w) v += red[((w * 2 + gv) * 16 + i) * 64 + ln];
            const int ml = (i & 3) + 8 * (i >> 2) + 4 * (ln >> 5);
            tile[(gv * 32 + ml) * 32 + (ln & 31)] = v * rstd3[fix_row(mt * 32 + ml)];
        }
        __syncthreads();
        {
            const int q = tid >> 6, c = tid & 31, part = (tid >> 5) & 1, m0 = 4 * q, b = q;
            const int j = 128 * pn + 32 * sub + c;
            if (part == 0) {
                const float* cw = a.in[I_FCW]; const float* cb = a.in[I_FCB];
                const float ug0 = tile[(m0) * 32 + c], ug1 = tile[(m0 + 1) * 32 + c], uv0 = tile[(32 + m0) * 32 + c], uv1 = tile[(32 + m0 + 1) * 32 + c];
                float hg0 = 0.f, hg1 = 0.f, hv0 = 0.f, hv1 = 0.f;
                if (mt) { const float* ch = a.in[I_CFFN] + (size_t)(b * 2) * NUP; hg0 = ch[j]; hg1 = ch[NUP + j]; hv0 = ch[DFF + j]; hv1 = ch[NUP + DFF + j]; }
                const float wg0 = cw[j], wg1 = cw[NUP + j], wg2 = cw[2 * NUP + j], bgg = cb[j], wv0 = cw[DFF + j], wv1 = cw[NUP + DFF + j], wv2 = cw[2 * NUP + DFF + j], bvv = cb[DFF + j];
                const float cg0 = bgg + wg0 * hg0 + wg1 * hg1 + wg2 * ug0, cv0 = bvv + wv0 * hv0 + wv1 * hv1 + wv2 * uv0;
                const float cg1 = bgg + wg0 * hg1 + wg1 * ug0 + wg2 * ug1, cv1 = bvv + wv0 * hv1 + wv1 * uv0 + wv2 * uv1;
                bf16_t* act = (bf16_t*)(a.ws + WS_ACT);
                const int row0 = fix_row(mt * 32 + m0);
                act[(size_t)row0 * DFF + j] = (bf16_t)f2bf(gelu_tanh(cg0) * cv0); act[(size_t)(row0 + 1) * DFF + j] = (bf16_t)f2bf(gelu_tanh(cg1) * cv1);
            } else {
                float* op = (mt ? a.out + O_FFNS : a.out + O_FFNP) + (size_t)(b * 2) * NUP;
                op[j] = tile[(m0 + 2) * 32 + c]; op[NUP + j] = tile[(m0 + 3) * 32 + c]; op[DFF + j] = tile[(32 + m0 + 2) * 32 + c]; op[NUP + DFF + j] = tile[(32 + m0 + 3) * 32 + c];
            }
        }
    }
    __syncthreads();
}

__device__ __forceinline__ void transpose_item(const float* W, int ldw, int K, bf16_t* WT, const float* kscale, LAS float* scr, int k0, int srccol0, int dstrow0, int lane) {
#pragma unroll 8
    for (int i = 0; i < 32; ++i) { const int kk = 2 * i + (lane >> 5); float v = W[(size_t)(k0 + kk) * ldw + srccol0 + (lane & 31)]; if (kscale) v *= kscale[k0 + kk]; scr[kk * 33 + (lane & 31)] = v; }
    asm volatile("s_waitcnt lgkmcnt(0)" ::: "memory");
    const int c = lane & 7;
#pragma unroll
    for (int j = 0; j < 4; ++j) { const int n = (lane >> 3) + 8 * j; const LAS float* s = scr + (8 * c) * 33 + n;
        u32x4 o; o.x = pk2(s[0 * 33], s[1 * 33]); o.y = pk2(s[2 * 33], s[3 * 33]); o.z = pk2(s[4 * 33], s[5 * 33]); o.w = pk2(s[6 * 33], s[7 * 33]);
        *(u32x4*)(WT + (size_t)(dstrow0 + n) * K + k0 + 8 * c) = o; }
    asm volatile("s_waitcnt lgkmcnt(0)" ::: "memory");
}

__device__ __forceinline__ void p0_prologue(const Args& a, LAS unsigned char* lds, int gw, int NGW, int lane, int wave) {
    unsigned char* ws = a.ws;
    LAS float* scr = (LAS float*)(lds + wave * 16384);
    bf16_t* WinT = (bf16_t*)(ws + WS_WIN); bf16_t* WoutT = (bf16_t*)(ws + WS_WOUT); bf16_t* WupT = (bf16_t*)(ws + WS_WUP); bf16_t* WdownT = (bf16_t*)(ws + WS_WDOWN);
    constexpr int I_IN = 16 * 64, I_OUT = 16 * 32, I_UP = 16 * 176, I_DOWN = 44 * 32, NIT = I_IN + I_OUT + I_UP + I_DOWN;
    for (int it = gw; it < NIT; it += NGW) {
        int r = it;
        if (r < I_IN) { const int kb = r / 64, nb = r % 64; const int dst = nb * 32; const int src = dst < 1536 ? dst : dst + 8;
            transpose_item(a.in[I_WIN], 2056, 1024, WinT, a.in[I_PREMIX], scr, kb * 64, src, dst, lane); continue; }
        r -= I_IN;
        if (r < I_OUT) { const int kb = r / 32, nb = r % 32; transpose_item(a.in[I_WOUT], 1024, 1024, WoutT, nullptr, scr, kb * 64, nb * 32, nb * 32, lane); continue; }
        r -= I_OUT;
        if (r < I_UP) { const int kb = r / 176, nb = r % 176; const int dst = nb * 32; const int pn = dst >> 8, i = dst & 255; const int src = i < 128 ? pn * 128 + i : DFF + pn * 128 + (i - 128);
            transpose_item(a.in[I_WUP], NUP, 1024, WupT, a.in[I_PREFFN], scr, kb * 64, src, dst, lane); continue; }
        r -= I_UP;
        { const int kb = r / 32, nb = r % 32; transpose_item(a.in[I_WDOWN], 1024, DFF, WdownT, nullptr, scr, kb * 64, nb * 32, nb * 32, lane); }
    }
    { float* s2 = (float*)(ws + WS_SUMSQ2); float* s4 = (float*)(ws + WS_SUMSQ4);
      for (int i = gw * 64 + lane; i < R; i += NGW * 64) { s2[i] = 0.f; s4[i] = 0.f; } }
    float wd[8][16];
    { const float* Win = a.in[I_WIN]; const float* pw = a.in[I_PREMIX];
#pragma unroll
      for (int j = 0; j < 8; ++j)
#pragma unroll
          for (int q = 0; q < 4; ++q)
#pragma unroll
              for (int e = 0; e < 4; ++e) { const int k = q * 256 + lane * 4 + e; wd[j][q * 4 + e] = Win[(size_t)k * 2056 + 1536 + j] * pw[k]; } }
    bf16_t* xb = (bf16_t*)(ws + WS_HB); float* rstd1 = (float*)(ws + WS_RSTD1); float* dtv = (float*)(ws + WS_DTV);
    const float* dtb = a.in[I_DTB];
    for (int row0 = 2 * gw; row0 < R; row0 += 2 * NGW) {
        f32x4 vv[2][4];
#pragma unroll
        for (int rr = 0; rr < 2; ++rr) { const int row = row0 + rr;
            const float* xr = row < RP ? a.in[I_XP] + (size_t)row * DM : a.in[I_XS] + (size_t)(row - RP) * DM;
#pragma unroll
            for (int q = 0; q < 4; ++q) vv[rr][q] = *(const f32x4*)(xr + q * 256 + lane * 4); }
#pragma unroll
        for (int rr = 0; rr < 2; ++rr) { const int row = row0 + rr;
            float ss = 0.f;
#pragma unroll
            for (int q = 0; q < 4; ++q) { const f32x4 v = vv[rr][q]; ss += (v[0] * v[0] + v[1] * v[1]) + (v[2] * v[2] + v[3] * v[3]); }
            ss = wave_sum(ss);
            const float rs = 1.f / sqrtf(ss * (1.f / DM) + EPS);
#pragma unroll
            for (int q = 0; q < 4; ++q) { const f32x4 v = vv[rr][q]; u32x2 w; w.x = pk2(v[0], v[1]); w.y = pk2(v[2], v[3]); *(u32x2*)(xb + (size_t)row * DM + q * 256 + lane * 4) = w; }
            float myd = 0.f;
#pragma unroll
            for (int j = 0; j < 8; ++j) { float d = 0.f;
#pragma unroll
                for (int q = 0; q < 4; ++q)
#pragma unroll
                    for (int e = 0; e < 4; ++e) d += vv[rr][q][e] * wd[j][q * 4 + e];
                d = wave_sum(d);
                if (lane == j) myd = d; }
            if (lane < 8) { const float xx = myd * rs + dtb[lane]; dtv[(size_t)row * 8 + lane] = xx > 20.f ? xx : log1pf(expf(xx)); }
            if (lane == 0) rstd1[row] = rs; }
    }
}

constexpr int XT_LD = 72, BN_LD = 136;
constexpr int L_XT = 0;
constexpr int L_BT = 36864;
constexpr int L_CN = L_BT + 18432;
constexpr int L_CS = L_CN + 17408;
constexpr int L_SSD_END = L_CS + 4 * 4 * 64 * 4;
constexpr int SUB_LDS = L_SSD_END + 64;
__device__ __forceinline__ void sub_barrier(LAS unsigned* cnt, unsigned& target, int lane) {
    asm volatile("s_waitcnt lgkmcnt(0)" ::: "memory");
    target += 4u;
    if (lane == 0) __hip_atomic_fetch_add(cnt, 1u, __ATOMIC_RELAXED, __HIP_MEMORY_SCOPE_WORKGROUP);
    for (;;) { const unsigned v = (unsigned)__builtin_amdgcn_readfirstlane((int)__hip_atomic_load(cnt, __ATOMIC_RELAXED, __HIP_MEMORY_SCOPE_WORKGROUP)); if ((int)(v - target) >= 0) break; __builtin_amdgcn_s_sleep(1); }
    asm volatile("" ::: "memory");
}

struct SeqInfo { int row0; int nreal; int pad; bool smp; int b; int slot; };
__device__ __forceinline__ SeqInfo ssd_unit(int ubc) {
    SeqInfo s;
    if (ubc < NBATCH * NCHUNK) { s.b = ubc >> 7; s.row0 = ubc * 64; s.pad = 0; s.smp = false; }
    else { s.b = ubc - NBATCH * NCHUNK; s.row0 = RP + s.b * DSEQ - 32; s.pad = 32; s.smp = true; }
    s.slot = ubc; s.nreal = 64 - s.pad; return s;
}

__device__ __forceinline__ void ssd_cs(const Args& a, LAS unsigned char* lds, const SeqInfo& si, int g, int lane, int mode, float* cdec) {
    LAS float* cs = (LAS float*)(lds + L_CS); LAS float* dtl = cs + 256; LAS float* aux = cs + 512;
    const float* dtv = (const float*)(a.ws + WS_DTV);
#pragma unroll
    for (int h4 = 0; h4 < 4; ++h4) {
        const int h = g * 4 + h4;
        float d = dtv[(size_t)(si.row0 + lane) * 8 + h]; d = lane >= si.pad ? d : 0.f;
        const float av = -__expf(a.in[I_ALOG][h]);
        float x = d * av;
#pragma unroll
        for (int o = 1; o < 64; o <<= 1) { const float y = __shfl_up(x, o); if (lane >= o) x += y; }
        const float ce = __shfl(x, 63);
        cs[h4 * 64 + lane] = x; dtl[h4 * 64 + lane] = d;
        aux[h4 * 64 + lane] = mode == 0 ? __expf(ce - x) * d : __expf(x);
        if (mode == 0 && lane == 0 && cdec) cdec[(size_t)si.slot * 8 + h] = __expf(ce);
    }
}

__device__ __forceinline__ void raw8(const Args& a, const SeqInfo& si, int tpos  , int tok  , int cch, float (&o)[8]) {
    const bf16_t* proj = (const bf16_t*)(a.ws + WS_PROJ);
    if (tpos >= 0) { const u32x4 w = *(const u32x4*)(proj + (size_t)(si.row0 + tok) * NPROJ + 512 + cch);
        o[0] = bf2f(w.x & 0xffff); o[1] = bf2f(w.x >> 16); o[2] = bf2f(w.y & 0xffff); o[3] = bf2f(w.y >> 16); o[4] = bf2f(w.z & 0xffff); o[5] = bf2f(w.z >> 16); o[6] = bf2f(w.w & 0xffff); o[7] = bf2f(w.w >> 16); }
    else if (si.smp && tpos >= -3) { const float* c = a.in[I_CSSD] + (size_t)(si.b * 3 + (tpos + 3)) * 1024 + cch;
#pragma unroll
        for (int e = 0; e < 8; ++e) o[e] = c[e]; }
    else {
#pragma unroll
        for (int e = 0; e < 8; ++e) o[e] = 0.f; }
}

__device__ __forceinline__ void rowvals(const Args& a, const SeqInfo& si, const u32x4 w, int tpos, int cch, float (&o)[8]) {
    o[0] = bf2f(w.x & 0xffff); o[1] = bf2f(w.x >> 16); o[2] = bf2f(w.y & 0xffff); o[3] = bf2f(w.y >> 16); o[4] = bf2f(w.z & 0xffff); o[5] = bf2f(w.z >> 16); o[6] = bf2f(w.w & 0xffff); o[7] = bf2f(w.w >> 16);
    if (tpos < 0) {
        if (si.smp && tpos >= -3) { const float* c = a.in[I_CSSD] + (size_t)(si.b * 3 + (tpos + 3)) * 1024 + cch;
#pragma unroll
            for (int e = 0; e < 8; ++e) o[e] = c[e]; }
        else {
#pragma unroll
            for (int e = 0; e < 8; ++e) o[e] = 0.f; }
    }
}
__device__ __forceinline__ void ssd_stage(const Args& a, LAS unsigned char* lds, const SeqInfo& si, int g, int c_in_seq, int tid, int mode) {
    const int cg8 = tid & 63;
    if (mode == 0 && cg8 >= 48) return;
    int cch, kind;
    if (cg8 < 32) { kind = 0; cch = g * 256 + cg8 * 8; } else if (cg8 < 48) { kind = 1; cch = 512 + g * 128 + (cg8 - 32) * 8; } else { kind = 2; cch = 768 + g * 128 + (cg8 - 48) * 8; }
    float w[4][8], bias[8];
#pragma unroll
    for (int k = 0; k < 4; ++k) { const f32x4 a0 = *(const f32x4*)(a.in[I_SCW] + k * 1024 + cch), a1 = *(const f32x4*)(a.in[I_SCW] + k * 1024 + cch + 4);
#pragma unroll
        for (int e = 0; e < 4; ++e) { w[k][e] = a0[e]; w[k][4 + e] = a1[e]; } }
    { const f32x4 a0 = *(const f32x4*)(a.in[I_SCB] + cch), a1 = *(const f32x4*)(a.in[I_SCB] + cch + 4);
#pragma unroll
      for (int e = 0; e < 4; ++e) { bias[e] = a0[e]; bias[4 + e] = a1[e]; } }
    const int seq0 = si.smp ? -32 : c_in_seq * 64;
#pragma unroll
    for (int tgi = 0; tgi < 2; ++tgi) {
    const int tg = __builtin_amdgcn_readfirstlane(tid >> 6) + 4 * tgi;
    const int t0 = 8 * tg;
    float r0[8], r1[8], r2[8], r3[8];
    u32x4 rw[11];
    { const bf16_t* pr = (const bf16_t*)(a.ws + WS_PROJ) + (size_t)(si.row0 + t0 - 3) * NPROJ + 512 + cch;
#pragma unroll
      for (int i = 0; i < 11; ++i) rw[i] = *(const u32x4*)(pr + (size_t)i * NPROJ); }
    rowvals(a, si, rw[0], seq0 + t0 - 3, cch, r0); rowvals(a, si, rw[1], seq0 + t0 - 2, cch, r1); rowvals(a, si, rw[2], seq0 + t0 - 1, cch, r2);
    unsigned pk[4][8]; float prev[8];
    const LAS float* aux = (const LAS float*)(lds + L_CS) + 512;
#pragma unroll
    for (int i = 0; i < 8; ++i) {
        rowvals(a, si, rw[3 + i], seq0 + t0 + i, cch, r3);
        const bool real = (t0 + i) >= si.pad;
        float sc = 1.f;
        if (mode == 0) { const float sv = aux[((cg8 >> 3) & 3) * 64 + t0 + i]; sc = kind == 0 ? sv : 1.f; }
#pragma unroll
        for (int e = 0; e < 8; ++e) { const float v = __builtin_fmaf(w[3][e], r3[e], __builtin_fmaf(w[2][e], r2[e], __builtin_fmaf(w[1][e], r1[e], __builtin_fmaf(w[0][e], r0[e], bias[e]))));
            const float ov = real ? silu_f(v) * sc : 0.f; r0[e] = r1[e]; r1[e] = r2[e]; r2[e] = r3[e];
            if (i & 1) pk[i >> 1][e] = pk2(prev[e], ov); else prev[e] = ov; }
    }
    const bool transposed = (kind == 0) || (mode == 0);
    if (transposed) {
        LAS bf16_t* base = kind == 0 ? (LAS bf16_t*)(lds + L_XT) + (cg8 * 8) * XT_LD : (LAS bf16_t*)(lds + L_BT) + ((cg8 - 32) * 8) * XT_LD;
#pragma unroll
        for (int e = 0; e < 8; ++e) { u32x4 o; o.x = pk[0][e]; o.y = pk[1][e]; o.z = pk[2][e]; o.w = pk[3][e];
            *(LAS u32x4*)(base + e * XT_LD + ((tg ^ (cg8 & 7)) << 3)) = o; }
    } else {
        LAS bf16_t* base = kind == 1 ? (LAS bf16_t*)(lds + L_BT) + (cg8 - 32) * 8 : (LAS bf16_t*)(lds + L_CN) + (cg8 - 48) * 8;
#pragma unroll
        for (int q = 0; q < 4; ++q) {
            u32x4 o0, o1;
#pragma unroll
            for (int c2 = 0; c2 < 4; ++c2) { const unsigned lo = pk[q][2 * c2], hi = pk[q][2 * c2 + 1];
                o0[c2] = (lo & 0xffffu) | (hi << 16); o1[c2] = (lo >> 16) | (hi & 0xffff0000u); }
            *(LAS u32x4*)(base + (t0 + 2 * q) * BN_LD) = o0; *(LAS u32x4*)(base + (t0 + 2 * q + 1) * BN_LD) = o1;
        }
    }
    }
}

#define MFMA32(a, b, c) __builtin_amdgcn_mfma_f32_32x32x16_bf16((a), (b), (c), 0, 0, 0)
__device__ __forceinline__ f32x16 zero16() { f32x16 z; for (int i = 0; i < 16; ++i) z[i] = 0.f; return z; }

__device__ __forceinline__ void ssd_passA_unit(const Args& a, LAS unsigned char* lds, int unit, int tid, int w4, int lane, LAS unsigned* bcnt, unsigned& btarget) {
    const int ubc = unit >> 1, g = unit & 1;
    const SeqInfo si = ssd_unit(ubc);
    sub_barrier(bcnt, btarget, lane);
    ssd_cs(a, lds, si, g, lane, 0, w4 == 0 ? (float*)(a.ws + WS_CDEC) : nullptr);
    ssd_stage(a, lds, si, g, ubc & 127, tid, 0);
    sub_barrier(bcnt, btarget, lane);
    const int h4 = w4, r = lane & 31, hf = lane >> 5;
    const LAS bf16_t* XT = (const LAS bf16_t*)(lds + L_XT); const LAS bf16_t* BT = (const LAS bf16_t*)(lds + L_BT);
    bf16_t* sst = (bf16_t*)(a.ws + WS_SST) + ((size_t)si.slot * 8 + g * 4 + h4) * 8192;
#pragma unroll 1
    for (int nh = 0; nh < 2; ++nh) {
        f32x16 acc[2][2]; acc[0][0] = zero16(); acc[0][1] = zero16(); acc[1][0] = zero16(); acc[1][1] = zero16();
#pragma unroll
        for (int ks = 0; ks < 4; ++ks) {
            bf16x8 af[2], bfr[2];
#pragma unroll
            for (int ni = 0; ni < 2; ++ni) af[ni] = *(const LAS bf16x8*)(BT + (nh * 64 + ni * 32 + r) * XT_LD + (((ks * 2 + hf) ^ ((ni * 4 + (r >> 3)) & 7)) << 3));
#pragma unroll
            for (int pj = 0; pj < 2; ++pj) bfr[pj] = *(const LAS bf16x8*)(XT + (h4 * 64 + pj * 32 + r) * XT_LD + (((ks * 2 + hf) ^ ((pj * 4 + (r >> 3)) & 7)) << 3));
#pragma unroll
            for (int ni = 0; ni < 2; ++ni)
#pragma unroll
                for (int pj = 0; pj < 2; ++pj) acc[ni][pj] = MFMA32(af[ni], bfr[pj], acc[ni][pj]);
        }
#pragma unroll
        for (int ni = 0; ni < 2; ++ni)
#pragma unroll
            for (int pj = 0; pj < 2; ++pj)
#pragma unroll
                for (int i = 0; i < 4; ++i) { const int p = pj * 32 + r, n = nh * 64 + ni * 32 + 8 * i + 4 * hf;
                    u32x2 w; w.x = pk2(acc[ni][pj][4 * i], acc[ni][pj][4 * i + 1]); w.y = pk2(acc[ni][pj][4 * i + 2], acc[ni][pj][4 * i + 3]);
                    *(u32x2*)(sst + p * 128 + n) = w; }
    }
}

__device__ __forceinline__ void ssd_passC_unit(const Args& a, LAS unsigned char* lds, int unit, int tid, int w4, int lane, LAS unsigned* bcnt, unsigned& btarget) {
    const int ubc = unit >> 1, g = unit & 1;
    const SeqInfo si = ssd_unit(ubc);
    sub_barrier(bcnt, btarget, lane);
    ssd_cs(a, lds, si, g, lane, 1, nullptr);
    ssd_stage(a, lds, si, g, ubc & 127, tid, 1);
    sub_barrier(bcnt, btarget, lane);
    const int h4 = w4, r = lane & 31, hf = lane >> 5, h = g * 4 + h4;
    const LAS bf16_t* XT = (const LAS bf16_t*)(lds + L_XT) + h4 * 64 * XT_LD; const LAS bf16_t* Bn = (const LAS bf16_t*)(lds + L_BT); const LAS bf16_t* Cn = (const LAS bf16_t*)(lds + L_CN);
    const LAS float* cs = (const LAS float*)(lds + L_CS) + h4 * 64; const LAS float* dtl = cs + 256; const LAS float* ecs = cs + 512; LAS float* red = (LAS float*)(lds + L_CS) + 768;
#pragma unroll 1
    for (int lh = 0; lh < 2; ++lh) {
    const int l = lh * 32 + r;
    const int row = si.row0 + l;
    const bool realtok = l >= si.pad;
    const bf16_t* zrow = (const bf16_t*)(a.ws + WS_PROJ) + (size_t)row * NPROJ + g * 256 + h4 * 64;
    u32x2 zq[2][4];
#pragma unroll
    for (int pt = 0; pt < 2; ++pt)
#pragma unroll
        for (int i = 0; i < 4; ++i) zq[pt][i] = *(const u32x2*)(zrow + pt * 32 + 8 * i + 4 * hf);
    bf16x8 cf[8];
#pragma unroll
    for (int ks = 0; ks < 8; ++ks) cf[ks] = *(const LAS bf16x8*)(Cn + l * BN_LD + ks * 16 + 8 * hf);
    f32x16 ya[2]; ya[0] = zero16(); ya[1] = zero16();
    const bf16_t* hp = (const bf16_t*)(a.ws + WS_SST) + ((size_t)si.slot * 8 + h) * 8192;
#pragma unroll
    for (int ks = 0; ks < 8; ++ks) {
#pragma unroll
        for (int pt = 0; pt < 2; ++pt) { const bf16x8 af = *(const bf16x8*)(hp + (pt * 32 + r) * 128 + ks * 16 + 8 * hf); ya[pt] = MFMA32(af, cf[ks], ya[pt]); }
    }
    { const float e = ecs[l];
#pragma unroll
      for (int pt = 0; pt < 2; ++pt)
#pragma unroll
          for (int i = 0; i < 16; ++i) ya[pt][i] *= e; }
    const float csl = cs[l];
#pragma unroll
    for (int st = 0; st < 2; ++st) {
        if (st <= lh) {
            f32x16 sa = zero16();
#pragma unroll
            for (int ks = 0; ks < 8; ++ks) { const bf16x8 af = *(const LAS bf16x8*)(Bn + (st * 32 + r) * BN_LD + ks * 16 + 8 * hf); sa = MFMA32(af, cf[ks], sa); }
#pragma unroll
            for (int i = 0; i < 16; ++i) { const int s = st * 32 + (i & 3) + 8 * (i >> 2) + 4 * hf;
                const float v = sa[i] * __expf(csl - cs[s]) * dtl[s]; sa[i] = (s <= l) ? v : 0.f; }
#pragma unroll
            for (int k2 = 0; k2 < 2; ++k2) {
                u32x4 gp; gp.x = pk2(sa[8 * k2 + 0], sa[8 * k2 + 1]); gp.y = pk2(sa[8 * k2 + 2], sa[8 * k2 + 3]); gp.z = pk2(sa[8 * k2 + 4], sa[8 * k2 + 5]); gp.w = pk2(sa[8 * k2 + 6], sa[8 * k2 + 7]);
                const bf16x8 gf = __builtin_bit_cast(bf16x8, gp);
#pragma unroll
                for (int pt = 0; pt < 2; ++pt) {
                    const LAS bf16_t* xr = XT + (pt * 32 + r) * XT_LD + 4 * hf; const int swz = (pt * 4 + (r >> 3)) & 7;
                    const u32x2 lo = *(const LAS u32x2*)(xr + (((st * 4 + 2 * k2) ^ swz) << 3)), hi = *(const LAS u32x2*)(xr + (((st * 4 + 2 * k2 + 1) ^ swz) << 3));
                    u32x4 xa; xa.x = lo.x; xa.y = lo.y; xa.z = hi.x; xa.w = hi.y;
                    ya[pt] = MFMA32(__builtin_bit_cast(bf16x8, xa), gf, ya[pt]);
                }
            }
        }
    }
    const float Dh = a.in[I_SSDD][h];
    float ssq = 0.f;
#pragma unroll
    for (int pt = 0; pt < 2; ++pt)
#pragma unroll
        for (int i = 0; i < 4; ++i) {
            const int p0 = pt * 32 + 8 * i + 4 * hf;
            const u32x2 zz = zq[pt][i];
            const float zv[4] = {bf2f(zz.x & 0xffff), bf2f(zz.x >> 16), bf2f(zz.y & 0xffff), bf2f(zz.y >> 16)};
#pragma unroll
            for (int j = 0; j < 4; ++j) { const float xv = bf2f(XT[(p0 + j) * XT_LD + ((((l >> 3) ^ ((pt * 4 + i) & 7)) << 3) | (l & 7))]); const float y = (ya[pt][4 * i + j] + Dh * xv) * silu_f(zv[j]); ya[pt][4 * i + j] = y; ssq += y * y; }
        }
    ssq += __shfl_xor(ssq, 32);
    if (hf == 0) red[h4 * 64 + l] = ssq;
    sub_barrier(bcnt, btarget, lane);
    const float* nw0 = a.in[I_SNW] + g * 256 + h4 * 64;
    const float tot = red[l] + red[64 + l] + red[128 + l] + red[192 + l];
    const float rs = 1.f / sqrtf(tot * (1.f / 256.f) + EPS);
    if (realtok) {
        bf16_t* orow = (bf16_t*)(a.ws + WS_MIXIN) + (size_t)row * DM + g * 256 + h4 * 64;
#pragma unroll
        for (int pt = 0; pt < 2; ++pt)
#pragma unroll
            for (int i = 0; i < 4; ++i) { const int p0 = pt * 32 + 8 * i + 4 * hf; const f32x4 nq = *(const f32x4*)(nw0 + p0);
                u32x2 w; w.x = pk2(ya[pt][4 * i] * rs * nq[0], ya[pt][4 * i + 1] * rs * nq[1]); w.y = pk2(ya[pt][4 * i + 2] * rs * nq[2], ya[pt][4 * i + 3] * rs * nq[3]);
                *(u32x2*)(orow + p0) = w; }
    }
    }
}

struct S5Consts { float lbr, lbi; bf16x8 bb[4]; };
__device__ __forceinline__ void s5_lambda(const Args& a, int g, int p, float& lbr, float& lbi, float& qr, float& qi) {
    const float lr = a.in[I_LRE][g * 64 + p], li = a.in[I_LIM][g * 64 + p], dt = expf(a.in[I_LDT][g]);
    const float mag = expf(lr * dt), ang = li * dt;
    lbr = mag * cosf(ang); lbi = mag * sinf(ang);
    const float den = lr * lr + li * li;
    qr = ((lbr - 1.f) * lr + lbi * li) / den; qi = (lbi * lr - (lbr - 1.f) * li) / den;
}
__device__ __forceinline__ void s5_consts(const Args& a, int g, int lane, S5Consts& c) {
    const int r = lane & 31, hf = lane >> 5;
    float lb0r, lb0i, q0r, q0i, lb1r, lb1i, q1r, q1i;
    s5_lambda(a, g, r, lb0r, lb0i, q0r, q0i); s5_lambda(a, g, 32 + r, lb1r, lb1i, q1r, q1i);
    c.lbr = hf ? lb1r : lb0r; c.lbi = hf ? lb1i : lb0i;
#pragma unroll
    for (int nb = 0; nb < 4; ++nb) {
        const int ps = r + 32 * (nb >> 1); const float qr = (nb >> 1) ? q1r : q0r, qi = (nb >> 1) ? q1i : q0i;
        const float* br = a.in[I_BRE] + (size_t)(g * 64 + ps) * 16 + 8 * hf; const float* bi = a.in[I_BIM] + (size_t)(g * 64 + ps) * 16 + 8 * hf;
        float v[8];
#pragma unroll
        for (int j = 0; j < 8; ++j) v[j] = (nb & 1) ? (qr * bi[j] + qi * br[j]) : (qr * br[j] - qi * bi[j]);
        u32x4 w; w.x = pk2(v[0], v[1]); w.y = pk2(v[2], v[3]); w.z = pk2(v[4], v[5]); w.w = pk2(v[6], v[7]);
        c.bb[nb] = __builtin_bit_cast(bf16x8, w);
    }
}
template <bool STORE>
__device__ __forceinline__ void s5_block(const Args& a, const S5Consts& c, const bf16x8 uf, int lane, float& hr, float& hi, LAS unsigned char* wl, const bf16_t* nxt, bf16x8& nuf) {
    f32x16 bu[4];
#pragma unroll
    for (int nb = 0; nb < 4; ++nb) bu[nb] = MFMA32(uf, c.bb[nb], zero16());
    asm volatile("" ::: "memory");
    nuf = *(const bf16x8*)nxt;
    asm volatile("" ::: "memory");
#pragma unroll
    for (int i = 0; i < 16; ++i) {
        auto s0 = __builtin_amdgcn_permlane32_swap(__float_as_uint(bu[0][i]), __float_as_uint(bu[2][i]), false, false);
        auto s1 = __builtin_amdgcn_permlane32_swap(__float_as_uint(bu[1][i]), __float_as_uint(bu[3][i]), false, false);
        bu[0][i] = __uint_as_float(s0[0]); bu[2][i] = __uint_as_float(s0[1]); bu[1][i] = __uint_as_float(s1[0]); bu[3][i] = __uint_as_float(s1[1]);
    }
    const float nlbi = -c.lbi;
#pragma unroll
    for (int ib = 0; ib < 4; ++ib) {
#pragma unroll
        for (int j = 0; j < 4; ++j) { const float nr = __builtin_fmaf(c.lbr, hr, __builtin_fmaf(nlbi, hi, bu[0][4 * ib + j])), ni = __builtin_fmaf(c.lbr, hi, __builtin_fmaf(c.lbi, hr, bu[1][4 * ib + j])); hr = nr; hi = ni; if (STORE) *(LAS unsigned*)(wl + (8 * ib + j) * 272 + lane * 4) = pk2(hr, hi); }
#pragma unroll
        for (int j = 0; j < 4; ++j) { const float nr = __builtin_fmaf(c.lbr, hr, __builtin_fmaf(nlbi, hi, bu[2][4 * ib + j])), ni = __builtin_fmaf(c.lbr, hi, __builtin_fmaf(c.lbi, hr, bu[3][4 * ib + j])); hr = nr; hi = ni; if (STORE) *(LAS unsigned*)(wl + (8 * ib + 4 + j) * 272 + lane * 4) = pk2(hr, hi); }
    }
}
__device__ __forceinline__ void s5_passA_item(const Args& a, int item, int lane) {
    const int b = item >> 8, g = (item >> 3) & 31, seg = item & 7;
    S5Consts c; s5_consts(a, g, lane, c);
    float hr = 0.f, hi = 0.f;
    const int row0 = b * SEQ + seg * 1024;
    const bf16_t* up_ = (const bf16_t*)(a.ws + WS_PROJ) + (size_t)(row0 + (lane & 31)) * NPROJ + 1536 + g * 16 + 8 * (lane >> 5);
    bf16x8 uf = *(const bf16x8*)up_;
    for (int blk = 0; blk < 32; ++blk) { const int nb = blk < 31 ? blk + 1 : 31; bf16x8 nuf; s5_block<false>(a, c, uf, lane, hr, hi, nullptr, up_ + (size_t)nb * 32 * NPROJ, nuf); uf = nuf; }
    float* loc = (float*)(a.ws + WS_S5LOC) + (size_t)item * 128;
    loc[lane] = hr; loc[64 + lane] = hi;
}
constexpr int S5_LD = 272;
__device__ __forceinline__ void s5_passC_run(const Args& a, LAS unsigned char* wlds, int row0, int nblk, int g, int lane, float& hr, float& hi) {
    S5Consts c; s5_consts(a, g, lane, c);
    const int r16 = lane & 15, q4 = lane >> 4;
    bf16x8 ca[4];
#pragma unroll
    for (int kb = 0; kb < 4; ++kb) { float v[8];
#pragma unroll
        for (int j = 0; j < 8; ++j) { const int comp = 32 * kb + 8 * q4 + j, p = comp >> 1; v[j] = (comp & 1) ? -a.in[I_CIM][(size_t)(g * 16 + r16) * 64 + p] : a.in[I_CRE][(size_t)(g * 16 + r16) * 64 + p]; }
        u32x4 w; w.x = pk2(v[0], v[1]); w.y = pk2(v[2], v[3]); w.z = pk2(v[4], v[5]); w.w = pk2(v[6], v[7]); ca[kb] = __builtin_bit_cast(bf16x8, w); }
    bf16x4 ga[2];
#pragma unroll
    for (int mb = 0; mb < 2; ++mb) { float v[4];
#pragma unroll
        for (int j = 0; j < 4; ++j) v[j] = a.in[I_GLUW][(size_t)(g * 16 + 4 * q4 + j) * 32 + mb * 16 + r16];
        u32x2 w; w.x = pk2(v[0], v[1]); w.y = pk2(v[2], v[3]); ga[mb] = __builtin_bit_cast(bf16x4, w); }
    f32x4 dD, gb0, gb1;
#pragma unroll
    for (int j = 0; j < 4; ++j) { dD[j] = a.in[I_S5D][g * 16 + 4 * q4 + j]; gb0[j] = a.in[I_GLUB][g * 32 + 4 * q4 + j]; gb1[j] = a.in[I_GLUB][g * 32 + 16 + 4 * q4 + j]; }
    const bf16_t* proj = (const bf16_t*)(a.ws + WS_PROJ);
    bf16_t* mixin = (bf16_t*)(a.ws + WS_MIXIN);
    const bf16_t* up_ = proj + (size_t)(row0 + (lane & 31)) * NPROJ + 1536 + g * 16 + 8 * (lane >> 5);
    bf16x8 uf = *(const bf16x8*)up_;
    u32x2 uus[2], uun[2];
#pragma unroll
    for (int sb = 0; sb < 2; ++sb) uus[sb] = *(const u32x2*)(proj + (size_t)(row0 + sb * 16 + r16) * NPROJ + 1536 + g * 16 + 4 * q4);
    for (int blk = 0; blk < nblk; ++blk) {
        const int rb = row0 + blk * 32;
        const int nb = blk < nblk - 1 ? blk + 1 : blk; bf16x8 nuf;
        s5_block<true>(a, c, uf, lane, hr, hi, wlds, up_ + (size_t)nb * 32 * NPROJ, nuf); uf = nuf;
#pragma unroll
        for (int sb = 0; sb < 2; ++sb) uun[sb] = *(const u32x2*)(proj + (size_t)(row0 + nb * 32 + sb * 16 + r16) * NPROJ + 1536 + g * 16 + 4 * q4);
        asm volatile("s_waitcnt lgkmcnt(0)" ::: "memory");
#pragma unroll
        for (int sb = 0; sb < 2; ++sb) {
            f32x4 y = (f32x4){0.f, 0.f, 0.f, 0.f};
#pragma unroll
            for (int kb = 0; kb < 4; ++kb) { const bf16x8 hb = *(const LAS bf16x8*)(wlds + (sb * 16 + r16) * S5_LD + (32 * kb + 8 * q4) * 2);
                y = __builtin_amdgcn_mfma_f32_16x16x32_bf16(ca[kb], hb, y, 0, 0, 0); }
            const int row = rb + sb * 16 + r16;
            const u32x2 uu = uus[sb];
            const float uv[4] = {bf2f(uu.x & 0xffff), bf2f(uu.x >> 16), bf2f(uu.y & 0xffff), bf2f(uu.y >> 16)};
            float ge[4];
#pragma unroll
            for (int j = 0; j < 4; ++j) ge[j] = gelu_tanh(y[j] + dD[j] * uv[j]);
            u32x2 gw; gw.x = pk2(ge[0], ge[1]); gw.y = pk2(ge[2], ge[3]);
            const bf16x4 gbf = __builtin_bit_cast(bf16x4, gw);
            const f32x4 o0 = __builtin_amdgcn_mfma_f32_16x16x16bf16_1k(ga[0], gbf, gb0, 0, 0, 0);
            const f32x4 o1 = __builtin_amdgcn_mfma_f32_16x16x16bf16_1k(ga[1], gbf, gb1, 0, 0, 0);
            float ov[4];
#pragma unroll
            for (int j = 0; j < 4; ++j) ov[j] = o0[j] * __builtin_amdgcn_rcpf(1.f + __builtin_amdgcn_exp2f(-1.4426950409f * o1[j]));
            u32x2 ow; ow.x = pk2(ov[0], ov[1]); ow.y = pk2(ov[2], ov[3]);
            *(u32x2*)(mixin + (size_t)row * DM + 512 + g * 16 + 4 * q4) = ow;
        }
        asm volatile("s_waitcnt lgkmcnt(0)" ::: "memory");
        uus[0] = uun[0]; uus[1] = uun[1];
    }
}

#define XB_TMO      128
#define XB_XCNT(j)  (256  + 64 * (j))
#define XB_XSUB(j)  (1280 + 64 * (j))
#define XB_XGEN(j)  (2304 + 64 * (j))
#define XB_TOP      3328
#define XB_TOPGEN   3392
#define XCD_BAR_WORDS 3456
#define XB_SPIN_CAP (1u << 18)

__device__ __forceinline__ unsigned xb_ld(unsigned* p)              { return __hip_atomic_load(p, __ATOMIC_RELAXED, __HIP_MEMORY_SCOPE_AGENT); }
__device__ __forceinline__ unsigned xb_add(unsigned* p, unsigned v) { return __hip_atomic_fetch_add(p, v, __ATOMIC_RELAXED, __HIP_MEMORY_SCOPE_AGENT); }
__device__ __forceinline__ unsigned xb_xcc_id() { return (unsigned)__builtin_amdgcn_s_getreg((3 << 11) | 20) & 0xFu; }
#define XB_SPIN(cond, bar) do { unsigned _sp = 0; while (cond) { __builtin_amdgcn_s_sleep(1); \
    if ((++_sp & 255u) == 0u) { if (xb_ld(&(bar)[XB_TMO])) break; if (_sp > XB_SPIN_CAP) { atomicAdd(&(bar)[XB_TMO], 1u); break; } } } } while (0)

struct XcdBarrier {
    unsigned* bar; unsigned x;
    volatile LAS unsigned* st;
};

__device__ __forceinline__ XcdBarrier xcd_barrier_post(unsigned* bar, volatile LAS unsigned* st) {
    XcdBarrier b; b.bar = bar; b.x = xb_xcc_id(); b.st = st;
    if (threadIdx.x == 0) (void)xb_add(&bar[XB_XCNT(b.x)], 1u);
    return b;
}
__device__ __forceinline__ void xcd_barrier_complete(unsigned* bar, unsigned x, unsigned& nloc, unsigned& nx) {
    const unsigned G = gridDim.x * gridDim.y * gridDim.z;
    unsigned sum, cnt, mine, sp = 0u;
    for (;;) {
        sum = 0u; cnt = 0u; mine = 0u;
#pragma unroll
        for (unsigned j = 0; j < 16; ++j) { const unsigned c = xb_ld(&bar[XB_XCNT(j)]); sum += c; cnt += (c > 0u) ? 1u : 0u; mine = (j == x) ? c : mine; }
        if (sum == G) break;
        __builtin_amdgcn_s_sleep(1);
        if ((++sp & 255u) == 0u) { if (xb_ld(&bar[XB_TMO])) break; if (sp > XB_SPIN_CAP) { atomicAdd(&bar[XB_TMO], 1u); break; } }
    }
    nloc = mine > 0u ? mine : 1u; nx = cnt > 0u ? cnt : 1u;
}

__device__ __forceinline__ void xcd_barrier(const XcdBarrier& b) {
    asm volatile("s_waitcnt vmcnt(0)" ::: "memory");
    __syncthreads();
    if (threadIdx.x == 0) {
        unsigned* bar = b.bar;
        __builtin_amdgcn_s_waitcnt(0);
        unsigned nloc = b.st[0], nx = b.st[1];
        if (nloc == 0u) { xcd_barrier_complete(bar, b.x, nloc, nx); b.st[0] = nloc; b.st[1] = nx; }
        const unsigned old = xb_add(&bar[XB_XSUB(b.x)], 1u);
        const unsigned gen = old / nloc;
        if (old + 1u == (gen + 1u) * nloc) {
            __builtin_amdgcn_fence(__ATOMIC_RELEASE, "agent");
            asm volatile("s_waitcnt vmcnt(0)" ::: "memory");
            const unsigned og = xb_add(&bar[XB_TOP], 1u);
            const unsigned tg = og / nx;
            if (og + 1u == (tg + 1u) * nx) xb_add(&bar[XB_TOPGEN], 1u);
            else XB_SPIN(xb_ld(&bar[XB_TOPGEN]) == tg, bar);
            __builtin_amdgcn_fence(__ATOMIC_ACQUIRE, "agent");
            xb_add(&bar[XB_XGEN(b.x)], 1u);
            asm volatile("s_waitcnt vmcnt(0)" ::: "memory");
        } else {
            XB_SPIN(xb_ld(&bar[XB_XGEN(b.x)]) == gen, bar);
            __builtin_amdgcn_fence(__ATOMIC_ACQUIRE, "agent");
            asm volatile("s_waitcnt vmcnt(0)" ::: "memory");
        }
    }
    __syncthreads();
}


constexpr int LDS_BYTES = 163840;
__global__ void __launch_bounds__(512, 2) fwd_kernel(Args a) {
    extern __shared__ __attribute__((aligned(16))) unsigned char lds_raw[];
    LAS unsigned char* lds = (LAS unsigned char*)lds_raw;
    const int tid = threadIdx.x, lane = tid & 63, wave = __builtin_amdgcn_readfirstlane(tid >> 6);
    const int G = gridDim.x, bx = blockIdx.x;
    const int gw = bx * 8 + wave, NGW = G * 8;
    unsigned char* ws = a.ws;
#if ONE_LAUNCH
    cg::grid_group grid = cg::this_grid();
    volatile LAS unsigned* bst = (volatile LAS unsigned*)(lds + LDS_BYTES - 16);
    if (tid < 4) bst[tid] = 0u;
    __syncthreads();
    XcdBarrier xbar = xcd_barrier_post((unsigned*)(ws + WS_BAR), bst);
#define GSYNC() xcd_barrier(xbar)
#else
#define GSYNC() do {} while (0)
#endif
#ifndef PHMASK
#define PHMASK 0x3ff
#endif
#define IN(k) (((PHMASK >> (k)) & 1) && a.ph_lo <= (k) && (k) < a.ph_hi)
#define SEAM(k) do { if (IN(k) && IN((k) + 1)) GSYNC(); } while (0)

    if (IN(0)) { p0_prologue(a, lds, gw, NGW, lane, wave); }
#if ONE_LAUNCH
    if (a.ph_hi > 1000) grid.sync();
#endif
    SEAM(0);
    if (IN(1)) {
        pg8::Gemm g{(const bf16_t*)(ws + WS_HB), (const bf16_t*)(ws + WS_WIN), RP / 256, NPROJ / 256, DM, 64};
        pg8::StaticOrder S; S.init(g.nM, g.nN, G, bx);
        EpiProj E{(bf16_t*)(ws + WS_PROJ), (const float*)(ws + WS_RSTD1), NPROJ};
        pg8::gemm_phase<EpiProj>(lds, g, S, E);
        mini_gemm<0>(lds, (const bf16_t*)(ws + WS_HB) + (size_t)RP * DM, (const bf16_t*)(ws + WS_WIN), DM, NPROJ, (bf16_t*)(ws + WS_PROJ) + (size_t)RP * NPROJ, NPROJ, (const float*)(ws + WS_RSTD1) + RP, nullptr, bx, G, tid, wave, lane);
    }
    SEAM(1);
    if (IN(2)) {
        {
            const int sb = wave >> 2, sid = tid & 255, w4 = wave & 3;
            LAS unsigned char* sl = lds + sb * SUB_LDS; LAS unsigned* bcnt = (LAS unsigned*)(sl + L_SSD_END);
            if (sid == 0) *bcnt = 0u;
            __syncthreads();
            unsigned btarget = 0u;
            const bool spread = (G == 256);
            const int ulim = spread ? NBATCH * NCHUNK * 2 : NUNITS_BC * 2, u0 = bx * 2 + sb;
            const int nk = u0 < ulim ? (ulim - u0 + 2 * G - 1) / (2 * G) : 0;
            const int sj = (spread && sb == 0 && (bx & 15) == 8) ? (bx >> 4) : -1;
            if (sb) __builtin_amdgcn_s_sleep(100);
            for (int k = 0; k < nk + (sj >= 0 ? 1 : 0); ++k) ssd_passA_unit(a, sl, k < nk ? u0 + k * 2 * G : NBATCH * NCHUNK * 2 + sj, sid, w4, lane, bcnt, btarget);
            __syncthreads();
        }
        for (int it = gw; it < NBATCH * 32 * 8; it += NGW) s5_passA_item(a, it, lane);
        const bf16_t* proj = (const bf16_t*)(ws + WS_PROJ);
        for (int i = bx * 512 + tid; i < 16 * 3 * 1024; i += G * 512) {
            const int sq = i / 3072, rem = i % 3072, k = rem >> 10, ch = rem & 1023;
            const int row = sq < 8 ? sq * SEQ + SEQ - 3 + k : RP + (sq - 8) * DSEQ + DSEQ - 3 + k;
            const float v = bf2f(proj[(size_t)row * NPROJ + 512 + ch]);
            if (sq < 8) a.out[O_CONVP + (size_t)(sq * 3 + k) * 1024 + ch] = v; else a.out[O_CONVS + (size_t)((sq - 8) * 3 + k) * 1024 + ch] = v;
        }
    }
    SEAM(2);
    if (IN(3)) {
        bf16_t* sst = (bf16_t*)(ws + WS_SST); const float* cdec = (const float*)(ws + WS_CDEC);
        for (int i = bx * 512 + tid; i < 16 * 8 * 2048; i += G * 512) {
            const int sq = i >> 14, h = (i >> 11) & 7, e4 = (i & 2047) * 4;
            const bool smp = sq >= 8; const int b = sq & 7;
            const int nch = smp ? 1 : NCHUNK, slot0 = smp ? NBATCH * NCHUNK + b : b * NCHUNK;
            f32x4 hc = (f32x4){0.f, 0.f, 0.f, 0.f};
            if (smp) hc = *(const f32x4*)(a.in[I_SSSD] + ((size_t)(b * 8 + h) * 8192 + e4));
            for (int c = 0; c < nch; ++c) {
                u32x2* p = (u32x2*)(sst + ((size_t)(slot0 + c) * 8 + h) * 8192 + e4);
                const u32x2 w = *p; const float d = cdec[(size_t)(slot0 + c) * 8 + h];
                u32x2 o; o.x = pk2(hc[0], hc[1]); o.y = pk2(hc[2], hc[3]); *p = o;
                hc[0] = hc[0] * d + bf2f(w.x & 0xffff); hc[1] = hc[1] * d + bf2f(w.x >> 16); hc[2] = hc[2] * d + bf2f(w.y & 0xffff); hc[3] = hc[3] * d + bf2f(w.y >> 16);
            }
            *(f32x4*)(a.out + (smp ? O_SSDS : O_SSDP) + ((size_t)(b * 8 + h) * 8192 + e4)) = hc;
        }
        for (int i = bx * 512 + tid; i < NBATCH * 32 * 64; i += G * 512) {
            const int b = i >> 11, g = (i >> 6) & 31, p = i & 63;
            float lbr, lbi, qr, qi; s5_lambda(a, g, p, lbr, lbi, qr, qi);
            float pr = lbr, pi = lbi;
            for (int k = 0; k < 10; ++k) { const float nr = pr * pr - pi * pi, ni = 2.f * pr * pi; pr = nr; pi = ni; }
            const float* loc = (const float*)(ws + WS_S5LOC) + (size_t)((b * 32 + g) * 8) * 128; float* hin = (float*)(ws + WS_S5HIN) + (size_t)((b * 32 + g) * 8) * 128;
            float hr = 0.f, hi = 0.f;
            for (int s = 0; s < 8; ++s) { hin[s * 128 + p] = hr; hin[s * 128 + 64 + p] = hi;
                const float nr = pr * hr - pi * hi + loc[s * 128 + p], ni = pr * hi + pi * hr + loc[s * 128 + 64 + p]; hr = nr; hi = ni; }
            a.out[O_S5REP + i] = hr; a.out[O_S5IMP + i] = hi;
        }
    }
    SEAM(3);
    if (IN(4)) {
        {
            const int sb = wave >> 2, sid = tid & 255, w4 = wave & 3;
            LAS unsigned char* sl = lds + sb * SUB_LDS; LAS unsigned* bcnt = (LAS unsigned*)(sl + L_SSD_END);
            if (sid == 0) *bcnt = 0u;
            __syncthreads();
            unsigned btarget = 0u;
            const bool spread = (G == 256);
            const int ulim = spread ? NBATCH * NCHUNK * 2 : NUNITS_BC * 2, u0 = bx * 2 + sb;
            const int nk = u0 < ulim ? (ulim - u0 + 2 * G - 1) / (2 * G) : 0;
            const int sj = (spread && sb == 0 && (bx & 15) == 8) ? (bx >> 4) : -1;
            if (sb) __builtin_amdgcn_s_sleep(100);
            for (int k = 0; k < nk + (sj >= 0 ? 1 : 0); ++k) ssd_passC_unit(a, sl, k < nk ? u0 + k * 2 * G : NBATCH * NCHUNK * 2 + sj, sid, w4, lane, bcnt, btarget);
        }
        __syncthreads();
        LAS unsigned char* wlds = lds + wave * (32 * S5_LD);
        for (int it = gw; it < NBATCH * 32 * 8 + NBATCH * 32; it += NGW) {
            if (it < NBATCH * 32 * 8) {
                const int b = it >> 8, g = (it >> 3) & 31, seg = it & 7;
                const float* hin = (const float*)(ws + WS_S5HIN) + (size_t)it * 128;
                float hr = hin[lane], hi = hin[64 + lane];
                s5_passC_run(a, wlds, b * SEQ + seg * 1024, 32, g, lane, hr, hi);
            } else {
                const int j = it - NBATCH * 32 * 8, b = j >> 5, g = j & 31;
                float hr = a.in[I_S5RE][(size_t)(b * 32 + g) * 64 + lane], hi = a.in[I_S5IM][(size_t)(b * 32 + g) * 64 + lane];
                s5_passC_run(a, wlds, RP + b * DSEQ, 1, g, lane, hr, hi);
                a.out[O_S5RES + (size_t)(b * 32 + g) * 64 + lane] = hr; a.out[O_S5IMS + (size_t)(b * 32 + g) * 64 + lane] = hi;
            }
        }
        __syncthreads();
    }
    SEAM(4);
    if (IN(5)) {
        pg8::Gemm g{(const bf16_t*)(ws + WS_MIXIN), (const bf16_t*)(ws + WS_WOUT), RP / 256, DM / 256, DM, 64};
        pg8::StaticOrder S; S.init(g.nM, g.nN, G, bx);
        EpiSq E{(bf16_t*)(ws + WS_MIX), (float*)(ws + WS_SUMSQ2), DM};
        pg8::gemm_phase<EpiSq>(lds, g, S, E);
        mini_gemm<1>(lds, (const bf16_t*)(ws + WS_MIXIN) + (size_t)RP * DM, (const bf16_t*)(ws + WS_WOUT), DM, DM, (bf16_t*)(ws + WS_MIX) + (size_t)RP * DM, DM, nullptr, (float*)(ws + WS_SUMSQ2) + RP, bx, G, tid, wave, lane);
    }
    SEAM(5);
    if (IN(6)) {
        const bf16_t* mix = (const bf16_t*)(ws + WS_MIX); const float* s2 = (const float*)(ws + WS_SUMSQ2); bf16_t* hb = (bf16_t*)(ws + WS_HB); float* rstd3 = (float*)(ws + WS_RSTD3);
        const float* pw = a.in[I_POSTMIX];
        f32x4 w4[4];
#pragma unroll
        for (int q = 0; q < 4; ++q) w4[q] = *(const f32x4*)(pw + q * 256 + lane * 4);
        for (int row0 = 2 * gw; row0 < R; row0 += 2 * NGW) {
            f32x4 xv[2][4]; u32x2 mm[2][4]; float rs[2];
#pragma unroll
            for (int rr = 0; rr < 2; ++rr) { const int row = row0 + rr;
                rs[rr] = s2[row];
#pragma unroll
                for (int q = 0; q < 4; ++q) { const u32x2 xx = *(const u32x2*)(hb + (size_t)row * DM + q * 256 + lane * 4);
                    xv[rr][q][0] = bf2f(xx.x & 0xffff); xv[rr][q][1] = bf2f(xx.x >> 16); xv[rr][q][2] = bf2f(xx.y & 0xffff); xv[rr][q][3] = bf2f(xx.y >> 16);
                    mm[rr][q] = *(const u32x2*)(mix + (size_t)row * DM + q * 256 + lane * 4); } }
#pragma unroll
            for (int rr = 0; rr < 2; ++rr) { const int row = row0 + rr;
                const float r_ = 1.f / sqrtf(rs[rr] * (1.f / DM) + EPS);
                float ss = 0.f; f32x4 hv[4];
#pragma unroll
                for (int q = 0; q < 4; ++q) { const u32x2 m2 = mm[rr][q];
                    hv[q][0] = xv[rr][q][0] + bf2f(m2.x & 0xffff) * r_ * w4[q][0]; hv[q][1] = xv[rr][q][1] + bf2f(m2.x >> 16) * r_ * w4[q][1]; hv[q][2] = xv[rr][q][2] + bf2f(m2.y & 0xffff) * r_ * w4[q][2]; hv[q][3] = xv[rr][q][3] + bf2f(m2.y >> 16) * r_ * w4[q][3];
                    ss += (hv[q][0] * hv[q][0] + hv[q][1] * hv[q][1]) + (hv[q][2] * hv[q][2] + hv[q][3] * hv[q][3]); }
                ss = wave_sum(ss);
#pragma unroll
                for (int q = 0; q < 4; ++q) { u32x2 w; w.x = pk2(hv[q][0], hv[q][1]); w.y = pk2(hv[q][2], hv[q][3]); *(u32x2*)(hb + (size_t)row * DM + q * 256 + lane * 4) = w; }
                if (lane == 0) rstd3[row] = 1.f / sqrtf(ss * (1.f / DM) + EPS); }
        }
    }
    SEAM(6);
    if (IN(7)) {
        constexpr int nM = (R + 247) / 248;
        pg8::Gemm g{(const bf16_t*)(ws + WS_HB) - 2 * DM, (const bf16_t*)(ws + WS_WUP), nM, NUP / 256, DM, 62};
        pg8::StaticOrder S; S.init(g.nM, g.nN, G, bx);
        const int nfull = (nM * (NUP / 256)) % G;
        EpiUp E{(bf16_t*)(ws + WS_ACT), (const float*)(ws + WS_RSTD3), a.in[I_FCW], a.in[I_FCB], a.in[I_CFFN], a.out + O_FFNP, a.out + O_FFNS, lds + 131072};
        pg8::gemm_phase<EpiUp>(lds, g, S, E);
        if (nfull == 0 || G - nfull < 8) up_fixup(a, lds, bx, G, tid, wave, lane);
        else if (bx >= nfull) up_fixup(a, lds, bx - nfull, G - nfull, tid, wave, lane);
    }
    SEAM(7);
    if (IN(8)) {
        pg8::Gemm g{(const bf16_t*)(ws + WS_ACT), (const bf16_t*)(ws + WS_WDOWN), RP / 256, DM / 256, DFF, 64};
        pg8::StaticOrder S; S.init(g.nM, g.nN, G, bx);
        EpiSq E{(bf16_t*)(ws + WS_FFN), (float*)(ws + WS_SUMSQ4), DM};
        pg8::gemm_phase<EpiSq>(lds, g, S, E);
        mini_gemm<1>(lds, (const bf16_t*)(ws + WS_ACT) + (size_t)RP * DFF, (const bf16_t*)(ws + WS_WDOWN), DFF, DM, (bf16_t*)(ws + WS_FFN) + (size_t)RP * DM, DM, nullptr, (float*)(ws + WS_SUMSQ4) + RP, bx, G, tid, wave, lane);
    }
    SEAM(8);
    if (IN(9)) {
        const bf16_t* ffn = (const bf16_t*)(ws + WS_FFN); const float* s4 = (const float*)(ws + WS_SUMSQ4); const bf16_t* hb = (const bf16_t*)(ws + WS_HB);
        const float* pw = a.in[I_POSTFFN];
        f32x4 w4[4];
#pragma unroll
        for (int q = 0; q < 4; ++q) w4[q] = *(const f32x4*)(pw + q * 256 + lane * 4);
        for (int row0 = 2 * gw; row0 < R; row0 += 2 * NGW) {
            u32x2 hh[2][4], mm[2][4]; float rs[2];
#pragma unroll
            for (int rr = 0; rr < 2; ++rr) { const int row = row0 + rr; rs[rr] = s4[row];
#pragma unroll
                for (int q = 0; q < 4; ++q) { hh[rr][q] = *(const u32x2*)(hb + (size_t)row * DM + q * 256 + lane * 4); mm[rr][q] = *(const u32x2*)(ffn + (size_t)row * DM + q * 256 + lane * 4); } }
#pragma unroll
            for (int rr = 0; rr < 2; ++rr) { const int row = row0 + rr;
                float* yr = row < RP ? a.out + O_YP + (size_t)row * DM : a.out + O_YS + (size_t)(row - RP) * DM;
                const float r_ = 1.f / sqrtf(rs[rr] * (1.f / DM) + EPS);
#pragma unroll
                for (int q = 0; q < 4; ++q) { const u32x2 h2 = hh[rr][q], m2 = mm[rr][q];
                    f32x4 o; o[0] = bf2f(h2.x & 0xffff) + bf2f(m2.x & 0xffff) * r_ * w4[q][0]; o[1] = bf2f(h2.x >> 16) + bf2f(m2.x >> 16) * r_ * w4[q][1];
                    o[2] = bf2f(h2.y & 0xffff) + bf2f(m2.y & 0xffff) * r_ * w4[q][2]; o[3] = bf2f(h2.y >> 16) + bf2f(m2.y >> 16) * r_ * w4[q][3];
                    __builtin_nontemporal_store(o, (f32x4*)(yr + q * 256 + lane * 4)); } }
        }
    }
}

constexpr int NPHASE = 10;
extern "C" void kernel_launch(void* const* d_in, const int* in_sizes, int n_in, void* d_out, int out_size, void* d_ws, size_t ws_size, hipStream_t stream) {
    static int grid = 0;
    if (grid == 0) {
        if (n_in != 33 || ws_size < WS_END) { fprintf(stderr, "kernel_launch: unexpected n_in %d / ws %zu\n", n_in, ws_size); grid = -1; return; }
        int dev = 0, cus = 0, per_cu = 0;
        hipGetDevice(&dev); hipDeviceGetAttribute(&cus, hipDeviceAttributeMultiprocessorCount, dev);
        hipFuncSetAttribute((const void*)fwd_kernel, hipFuncAttributeMaxDynamicSharedMemorySize, LDS_BYTES);
        hipOccupancyMaxActiveBlocksPerMultiprocessor(&per_cu, (const void*)fwd_kernel, 512, LDS_BYTES);
        (void)hipGetLastError();
        if (per_cu < 1) per_cu = 1;
        grid = cus * 1;
    }
    if (grid < 0) return;
    Args a{};
    for (int i = 0; i < 33; ++i) a.in[i] = (const float*)d_in[i];
    a.out = (float*)d_out; a.ws = (unsigned char*)d_ws;
#if ONE_LAUNCH
    (void)hipMemsetAsync((char*)d_ws + WS_BAR, 0, 16384, stream);
    a.ph_lo = 0; a.ph_hi = NPHASE;
    void* args[] = {&a};
    hipError_t e = hipLaunchCooperativeKernel((const void*)fwd_kernel, dim3(grid), dim3(512), args, LDS_BYTES, stream);
    if (e != hipSuccess) fprintf(stderr, "cooperative launch failed: %s (grid %d)\n", hipGetErrorString(e), grid);
#else
#ifndef DUPMASK
#define DUPMASK 0
#endif
    for (int p = 0; p < NPHASE; ++p) { a.ph_lo = p; a.ph_hi = p + 1; for (int rep = 0; rep < (((DUPMASK >> p) & 1) ? 2 : 1); ++rep) hipLaunchKernelGGL(fwd_kernel, dim3(grid), dim3(512), LDS_BYTES, stream, a); }
#endif
}
```

```cpp
#include <hip/hip_runtime.h>
#include <hip/hip_cooperative_groups.h>
#include <cstdio>
namespace cg = cooperative_groups;

#ifndef ONE_LAUNCH
#define ONE_LAUNCH 1
#endif

#define LAS __attribute__((address_space(3)))
typedef unsigned short bf16_t;
typedef short bf16x8 __attribute__((ext_vector_type(8)));
typedef short bf16x4 __attribute__((ext_vector_type(4)));
typedef float f32x4 __attribute__((ext_vector_type(4)));
typedef float f32x16 __attribute__((ext_vector_type(16)));
typedef unsigned u32x4 __attribute__((ext_vector_type(4)));
typedef unsigned u32x2 __attribute__((ext_vector_type(2)));

constexpr int DM = 1024, SEQ = 8192, NBATCH = 8, DSEQ = 32;
constexpr int RP = NBATCH * SEQ;
constexpr int RS = NBATCH * DSEQ;
constexpr int R = RP + RS;
constexpr int NPROJ = 2048;
constexpr int DFF = 2816, NUP = 5632;
constexpr int NCHUNK = 128;
constexpr int NUNITS_BC = NBATCH * NCHUNK + NBATCH;
constexpr float EPS = 1e-6f;

constexpr size_t MiB = 1u << 20;
constexpr size_t WS_BAR = 512 * 1024;
constexpr size_t WS_WDT = 0;
constexpr size_t WS_RSTD1 = 1 * MiB, WS_SUMSQ2 = 1 * MiB + 512 * 1024, WS_RSTD3 = 2 * MiB, WS_SUMSQ4 = 2 * MiB + 512 * 1024;
constexpr size_t WS_DTV = 3 * MiB;
constexpr size_t WS_CDEC = 6 * MiB;
constexpr size_t WS_S5LOC = 7 * MiB, WS_S5HIN = 8 * MiB;
constexpr size_t WS_WIN = 10 * MiB, WS_WOUT = 14 * MiB, WS_WUP = 16 * MiB, WS_WDOWN = 28 * MiB;
constexpr size_t WS_HB = 36 * MiB;
constexpr size_t WS_PROJ = 168 * MiB;
constexpr size_t WS_SST = 426 * MiB;
constexpr size_t WS_MIXIN = 556 * MiB;
constexpr size_t WS_MIX = 686 * MiB;
constexpr size_t WS_ACT = 168 * MiB;
constexpr size_t WS_FFN = 556 * MiB;
constexpr size_t WS_END = 816 * MiB;

constexpr size_t O_YP = 0, O_YS = O_YP + (size_t)RP * DM, O_CONVP = O_YS + (size_t)RS * DM, O_SSDP = O_CONVP + 8 * 3 * 1024,
                 O_S5REP = O_SSDP + 8 * 8 * 64 * 128, O_S5IMP = O_S5REP + 8 * 32 * 64, O_FFNP = O_S5IMP + 8 * 32 * 64,
                 O_CONVS = O_FFNP + 8 * 2 * NUP, O_SSDS = O_CONVS + 8 * 3 * 1024, O_S5RES = O_SSDS + 8 * 8 * 64 * 128,
                 O_S5IMS = O_S5RES + 8 * 32 * 64, O_FFNS = O_S5IMS + 8 * 32 * 64;

struct Args {
    const float* in[33];
    float* out; unsigned char* ws;
    int ph_lo, ph_hi;
};
enum { I_XP = 0, I_XS, I_CSSD, I_SSSD, I_S5RE, I_S5IM, I_CFFN, I_PREMIX, I_WIN, I_SCW, I_SCB, I_DTB, I_ALOG, I_SSDD, I_SNW,
       I_LRE, I_LIM, I_LDT, I_BRE, I_BIM, I_CRE, I_CIM, I_S5D, I_GLUW, I_GLUB, I_WOUT, I_POSTMIX, I_PREFFN, I_WUP, I_FCW, I_FCB, I_WDOWN, I_POSTFFN };

__device__ __forceinline__ float bf2f(unsigned v) { return __uint_as_float(v << 16); }
__device__ __forceinline__ unsigned f2bf(float f) { unsigned u = __float_as_uint(f); return (u + 0x7fffu + ((u >> 16) & 1u)) >> 16; }
typedef __bf16 hwbf2 __attribute__((ext_vector_type(2)));
typedef float f32x2 __attribute__((ext_vector_type(2)));
__device__ __forceinline__ unsigned pk2(float lo, float hi) { f32x2 v; v.x = lo; v.y = hi; return __builtin_bit_cast(unsigned, __builtin_convertvector(v, hwbf2)); }
template <int CTRL, int RM> __device__ __forceinline__ float dpp_get(float v) { return __builtin_bit_cast(float, __builtin_amdgcn_update_dpp(0, __builtin_bit_cast(int, v), CTRL, RM, 0xF, false)); }
__device__ __forceinline__ float wave_sum(float v) {
    v += dpp_get<0xB1, 0xF>(v);
    v += dpp_get<0x4E, 0xF>(v);
    v += dpp_get<0x141, 0xF>(v);
    v += dpp_get<0x140, 0xF>(v);
    v += dpp_get<0x142, 0xA>(v);
    v += dpp_get<0x143, 0xC>(v);
    return __builtin_bit_cast(float, __builtin_amdgcn_readlane(__builtin_bit_cast(int, v), 63));
}
__device__ __forceinline__ float silu_f(float v) { return v * __builtin_amdgcn_rcpf(1.f + __builtin_amdgcn_exp2f(-1.4426950409f * v)); }
__device__ __forceinline__ float gelu_tanh(float v) {
    const float w = v * (-2.3022082f + -0.1029432f * (v * v));
    return v * __builtin_amdgcn_rcpf(1.f + __builtin_amdgcn_exp2f(w));
}

namespace pg8 {
constexpr int BM = 256, BK = 64, HALF = 128, HTB = HALF * BK * 2, STAGE_BYTES = 8 * HTB, NXCD = 8, WGM = 8;
__host__ __device__ __forceinline__ int lds_byte(int r, int c) { const int st = (r >> 4) * 2 + (c >> 5), rr = r & 15, cc = c & 31, ob = rr * 64 + cc * 2; return st * 1024 + (ob ^ (((ob >> 9) & 1) << 5)); }
__host__ __device__ __forceinline__ void stage_rc(int b, int& R_, int& C) { const int st = b / 1024, sb = b % 1024, swz = sb ^ (((sb >> 9) & 1) << 5); R_ = (st >> 1) * 16 + swz / 64; C = (st & 1) * 32 + (swz % 64) / 2; }
__host__ __device__ __forceinline__ int perm32(int rho) { const int n = rho >> 4, i = rho & 15; return 8 * (i >> 2) + 4 * n + (i & 3); }
struct Unit { int pm, pn; };
struct Gemm { const bf16_t* A; const bf16_t* Bt; int nM, nN, K, rp64; };
struct StaticOrder {
    int nM, nN, nwg, G, c;
    __device__ void init(int nM_, int nN_, int G_, int c_) { nM = nM_; nN = nN_; nwg = nM * nN; G = G_; c = c_; }
    __device__ bool next(int i, Unit& u) const {
        const long L = (long)i * G + c; if (L >= nwg) return false;
        int wgid = (int)L; { const int q = nwg / NXCD, r = nwg % NXCD, xcd = wgid % NXCD, off = wgid / NXCD; wgid = (xcd < r ? xcd * (q + 1) : r * (q + 1) + (xcd - r) * q) + off; }
        const int nig = WGM * nN, gid = wgid / nig, fm = gid * WGM, gsz = (nM - fm) < WGM ? (nM - fm) : WGM;
        u.pm = fm + ((wgid % nig) % gsz); u.pn = (wgid % nig) / gsz; return true;
    }
};

template <class Epi>
__device__ __forceinline__ void gemm_phase(LAS unsigned char* lds, const Gemm g, const StaticOrder& S, const Epi& E) {
    const int tid = threadIdx.x, wid = __builtin_amdgcn_readfirstlane(tid >> 6), lane = tid & 63, wr = wid >> 2, wc = wid & 3, fr = lane & 15, fq = lane >> 4;
    const int K = g.K, nt = K / BK;
    unsigned voffA[2], voffB[2];
#pragma unroll
    for (int i = 0; i < 2; ++i) { int R_, C; stage_rc(tid * 16 + i * 8192, R_, C); const int Rb = Epi::PERM ? ((R_ & ~31) + perm32(R_ & 31)) : R_;
        const int Ra = (R_ >> 6) * g.rp64 + (R_ & 63);
        voffA[i] = (unsigned)(Ra * K + C) * 2u; voffB[i] = (unsigned)(Rb * K + C) * 2u; }
    const size_t kstep = (size_t)(BK * 2);
    const size_t hstepB = (size_t)HALF * K * 2, tstepB = 2 * hstepB;
    const size_t hstepA = (size_t)2 * g.rp64 * K * 2, tstepA = 2 * hstepA;
    const unsigned ldsw = (unsigned)wid * 1024u;
    const int aoff = lds_byte(wr * 64 + fr, fq * 8), boff = lds_byte(wc * 32 + fr, fq * 8);
#define PG8_SA(b, h) (((b) * 2 + (h)) * HTB)
#define PG8_SB(b, h) ((4 + (b) * 2 + (h)) * HTB)
#define PG8_STAGE(bufoff, gbase, voff) do { _Pragma("unroll") for (int _i = 0; _i < 2; ++_i) \
        __builtin_amdgcn_global_load_lds((const unsigned*)((const char*)(gbase) + (voff)[_i]), (LAS unsigned*)(lds + (bufoff) + ldsw + _i * 8192), 16, 0, 0); } while (0)
#define PG8_LDA(dst, b, h) do { _Pragma("unroll") for (int m = 0; m < 4; ++m) _Pragma("unroll") for (int k = 0; k < 2; ++k) dst[m][k] = *(const LAS bf16x8*)(lds + PG8_SA(b, h) + aoff + m * 2048 + k * 1024); } while (0)
#define PG8_LDB(dst, b, h) do { _Pragma("unroll") for (int n = 0; n < 2; ++n) _Pragma("unroll") for (int k = 0; k < 2; ++k) dst[n][k] = *(const LAS bf16x8*)(lds + PG8_SB(b, h) + boff + n * 2048 + k * 1024); } while (0)
#define PG8_MMA(ai, bj, At, Bt) do { __builtin_amdgcn_s_setprio(1); _Pragma("unroll") for (int m = 0; m < 4; ++m) _Pragma("unroll") for (int n = 0; n < 2; ++n) _Pragma("unroll") for (int k = 0; k < 2; ++k) \
        acc[ai][bj][m][n] = __builtin_amdgcn_mfma_f32_16x16x32_bf16(Bt[n][k], At[m][k], acc[ai][bj][m][n], 0, 0, 0); __builtin_amdgcn_s_setprio(0); } while (0)
#define PG8_WAIT_V(n) asm volatile("s_waitcnt vmcnt(" #n ")" ::: "memory")
#define PG8_WAIT_L(n) asm volatile("s_waitcnt lgkmcnt(" #n ")" ::: "memory")
#define PG8_BAR __builtin_amdgcn_s_barrier()
#define PG8_SCHED __builtin_amdgcn_sched_barrier(0)
    Unit cur, nxt; int ui = 0;
    if (!S.next(0, cur)) return;
    f32x4 acc[2][2][4][2];
#pragma unroll
    for (int a = 0; a < 2; ++a)
#pragma unroll
        for (int b = 0; b < 2; ++b)
#pragma unroll
            for (int m = 0; m < 4; ++m)
#pragma unroll
                for (int n = 0; n < 2; ++n) acc[a][b][m][n] = (f32x4){0.f, 0.f, 0.f, 0.f};
    bf16x8 At[4][2], B0[2][2], B1[2][2];
    const char* cA = (const char*)g.A + (size_t)cur.pm * tstepA; const char* cB = (const char*)g.Bt + (size_t)cur.pn * tstepB;
    PG8_STAGE(PG8_SB(0, 0), cB, voffB); PG8_STAGE(PG8_SA(0, 0), cA, voffA); PG8_STAGE(PG8_SB(0, 1), cB + hstepB, voffB); PG8_STAGE(PG8_SA(0, 1), cA + hstepA, voffA);
    if (wr == 1) PG8_BAR;
    PG8_WAIT_V(4); PG8_BAR;
    PG8_STAGE(PG8_SB(1, 0), cB + kstep, voffB); PG8_STAGE(PG8_SA(1, 0), cA + kstep, voffA); PG8_STAGE(PG8_SB(1, 1), cB + hstepB + kstep, voffB);
    PG8_WAIT_V(6); PG8_BAR;
    for (;;) {
        const bool has_next = S.next(ui + 1, nxt);
        const char* nA = has_next ? (const char*)g.A + (size_t)nxt.pm * tstepA : cA; const char* nB = has_next ? (const char*)g.Bt + (size_t)nxt.pn * tstepB : cB;
        for (int t = 0; t < nt; t += 2) {
            const bool last = (t == nt - 2);
            const char* a1 = cA + (size_t)(t + 1) * kstep;
            const char* a2 = last ? nA : cA + (size_t)(t + 2) * kstep; const char* b2 = last ? nB : cB + (size_t)(t + 2) * kstep;
            const char* a3 = a2 + kstep; const char* b3 = b2 + kstep;
            PG8_LDB(B0, 0, 0); PG8_SCHED; PG8_LDA(At, 0, 0); PG8_STAGE(PG8_SA(1, 1), a1 + hstepA, voffA);
            PG8_WAIT_L(8); PG8_BAR; PG8_WAIT_L(0); PG8_MMA(0, 0, At, B0); PG8_BAR; PG8_SCHED;
            PG8_LDB(B1, 0, 1); PG8_STAGE(PG8_SB(0, 0), b2, voffB);
            PG8_BAR; PG8_WAIT_L(0); PG8_MMA(0, 1, At, B1); PG8_BAR;
            PG8_LDA(At, 0, 1); PG8_STAGE(PG8_SA(0, 0), a2, voffA);
            PG8_BAR; PG8_WAIT_L(0); PG8_MMA(1, 0, At, B0); PG8_BAR; PG8_SCHED;
            PG8_STAGE(PG8_SB(0, 1), b2 + hstepB, voffB);
            PG8_WAIT_V(6); PG8_BAR; PG8_MMA(1, 1, At, B1); PG8_BAR;
            PG8_LDB(B0, 1, 0); PG8_SCHED; PG8_LDA(At, 1, 0); PG8_STAGE(PG8_SA(0, 1), a2 + hstepA, voffA);
            PG8_WAIT_L(8); PG8_BAR; PG8_WAIT_L(0); PG8_MMA(0, 0, At, B0); PG8_BAR; PG8_SCHED;
            PG8_LDB(B1, 1, 1); PG8_STAGE(PG8_SB(1, 0), b3, voffB);
            PG8_BAR; PG8_WAIT_L(0); PG8_MMA(0, 1, At, B1); PG8_BAR;
            PG8_LDA(At, 1, 1); PG8_STAGE(PG8_SA(1, 0), a3, voffA);
            PG8_BAR; PG8_WAIT_L(0); PG8_MMA(1, 0, At, B0); PG8_BAR; PG8_SCHED;
            PG8_STAGE(PG8_SB(1, 1), b3 + hstepB, voffB);
            PG8_WAIT_V(6); PG8_BAR; PG8_MMA(1, 1, At, B1); PG8_BAR;
        }
        E(acc, cur, wr, wc, fr, fq);
        if (!has_next) break;
#pragma unroll
        for (int a = 0; a < 2; ++a)
#pragma unroll
            for (int b = 0; b < 2; ++b)
#pragma unroll
                for (int m = 0; m < 4; ++m)
#pragma unroll
                    for (int n = 0; n < 2; ++n) acc[a][b][m][n] = (f32x4){0.f, 0.f, 0.f, 0.f};
        cur = nxt; cA = nA; cB = nB; ++ui;
    }
    PG8_WAIT_V(0);
    if (wr == 0) PG8_BAR;
    PG8_BAR;
#undef PG8_SA
#undef PG8_SB
#undef PG8_STAGE
#undef PG8_LDA
#undef PG8_LDB
#undef PG8_MMA
#undef PG8_WAIT_V
#undef PG8_WAIT_L
#undef PG8_BAR
#undef PG8_SCHED
}
}

struct EpiProj {
    static constexpr bool PERM = true;
    bf16_t* O; const float* rstd; int ldc;
    __device__ __forceinline__ void operator()(const f32x4 (&acc)[2][2][4][2], const pg8::Unit& u, int wr, int wc, int fr, int fq) const {
        const int row0 = u.pm * 256 + wr * 64 + fr, col0 = u.pn * 256 + wc * 32 + 8 * fq;
#pragma unroll
        for (int ai = 0; ai < 2; ++ai)
#pragma unroll
            for (int m = 0; m < 4; ++m) { const int row = row0 + ai * 128 + m * 16; const float s = rstd[row]; bf16_t* rowp = O + (size_t)row * ldc + col0;
#pragma unroll
                for (int bj = 0; bj < 2; ++bj) { const f32x4 v0 = acc[ai][bj][m][0] * s, v1 = acc[ai][bj][m][1] * s;
                    u32x4 w; w.x = pk2(v0[0], v0[1]); w.y = pk2(v0[2], v0[3]); w.z = pk2(v1[0], v1[1]); w.w = pk2(v1[2], v1[3]);
                    *(u32x4*)(rowp + bj * 128) = w; } }
    }
};
struct EpiSq {
    static constexpr bool PERM = true;
    bf16_t* O; float* sumsq; int ldc;
    __device__ __forceinline__ void operator()(const f32x4 (&acc)[2][2][4][2], const pg8::Unit& u, int wr, int wc, int fr, int fq) const {
        const int row0 = u.pm * 256 + wr * 64 + fr, col0 = u.pn * 256 + wc * 32 + 8 * fq;
#pragma unroll
        for (int ai = 0; ai < 2; ++ai)
#pragma unroll
            for (int m = 0; m < 4; ++m) { const int row = row0 + ai * 128 + m * 16; bf16_t* rowp = O + (size_t)row * ldc + col0; float ss = 0.f;
#pragma unroll
                for (int bj = 0; bj < 2; ++bj) { const f32x4 v0 = acc[ai][bj][m][0], v1 = acc[ai][bj][m][1];
                    ss += (v0[0] * v0[0] + v0[1] * v0[1]) + (v0[2] * v0[2] + v0[3] * v0[3]) + (v1[0] * v1[0] + v1[1] * v1[1]) + (v1[2] * v1[2] + v1[3] * v1[3]);
                    u32x4 w; w.x = pk2(v0[0], v0[1]); w.y = pk2(v0[2], v0[3]); w.z = pk2(v1[0], v1[1]); w.w = pk2(v1[2], v1[3]);
                    *(u32x4*)(rowp + bj * 128) = w; }
                ss += __shfl_xor(ss, 16); ss += __shfl_xor(ss, 32);
                if (fq == 0) atomicAdd(sumsq + row, ss); }
    }
};
constexpr int SLAB_LD = 40, SLAB_BYTES = 64 * SLAB_LD;
struct EpiUp {
    static constexpr bool PERM = true;
    bf16_t* act; const float* rstd3; const float* cw; const float* cb; const float* cache; float* outp; float* outs; LAS unsigned char* xl;
    __device__ __forceinline__ void operator()(const f32x4 (&acc)[2][2][4][2], const pg8::Unit& u, int wr, int wc, int fr_, int fq_) const {
        int fr = fr_, fq = fq_; asm volatile("" : "+v"(fr), "+v"(fq));
        LAS unsigned char* slab = xl + (wr * 4 + wc) * SLAB_BYTES;
        const int lane = fq * 16 + fr, cq = lane & 3, rs = lane >> 2;
        const int j0 = u.pn * 128 + wc * 32 + 8 * cq;
        float sc[2][4];
#pragma unroll
        for (int ai = 0; ai < 2; ++ai)
#pragma unroll
            for (int m = 0; m < 4; ++m) { const int row = 248 * u.pm + 62 * (2 * ai + wr) - 2 + 16 * m + fr; sc[ai][m] = (row >= 0 && row < R) ? rstd3[row] : 0.f; }
        f32x4 wn[4];
        { const int colb = j0; wn[0] = *(const f32x4*)(cw + colb); wn[1] = *(const f32x4*)(cw + NUP + colb); wn[2] = *(const f32x4*)(cw + 2 * NUP + colb); wn[3] = *(const f32x4*)(cb + colb); }
        float cgv[4][4];
#pragma unroll
        for (int sp = 0; sp < 8; ++sp) {
            const int ai = sp >> 2, n = (sp >> 1) & 1, bj = sp & 1;
            const int rowbase = 248 * u.pm + 62 * (2 * ai + wr) - 2;
            const f32x4 w0 = wn[0], w1 = wn[1], w2 = wn[2], bb = wn[3];
            if (sp < 7) { const int sq = sp + 1, n2 = (sq >> 1) & 1, bj2 = sq & 1, colb = bj2 * DFF + j0 + 4 * n2;
                wn[0] = *(const f32x4*)(cw + colb); wn[1] = *(const f32x4*)(cw + NUP + colb); wn[2] = *(const f32x4*)(cw + 2 * NUP + colb); wn[3] = *(const f32x4*)(cb + colb); }
#pragma unroll
            for (int m = 0; m < 4; ++m) { const f32x4 v = acc[ai][bj][m][n] * sc[ai][m];
                u32x2 w; w.x = pk2(v[0], v[1]); w.y = pk2(v[2], v[3]); *(LAS u32x2*)(slab + (16 * m + fr) * SLAB_LD + fq * 8) = w; }
            f32x4 p2 = (f32x4){0.f, 0.f, 0.f, 0.f}, p1 = p2;
            if (rs > 0) { const u32x2 q1 = *(const LAS u32x2*)(slab + (4 * rs - 1) * SLAB_LD + cq * 8), q2 = *(const LAS u32x2*)(slab + (4 * rs - 2) * SLAB_LD + cq * 8);
                p1[0] = bf2f(q1.x & 0xffff); p1[1] = bf2f(q1.x >> 16); p1[2] = bf2f(q1.y & 0xffff); p1[3] = bf2f(q1.y >> 16);
                p2[0] = bf2f(q2.x & 0xffff); p2[1] = bf2f(q2.x >> 16); p2[2] = bf2f(q2.y & 0xffff); p2[3] = bf2f(q2.y >> 16); }
#pragma unroll
            for (int i = 0; i < 4; ++i) {
                const int lr = 4 * rs + i, row = rowbase + lr;
                const u32x2 q0 = *(const LAS u32x2*)(slab + lr * SLAB_LD + cq * 8);
                f32x4 cur; cur[0] = bf2f(q0.x & 0xffff); cur[1] = bf2f(q0.x >> 16); cur[2] = bf2f(q0.y & 0xffff); cur[3] = bf2f(q0.y >> 16);
                const bool smp = row >= RP;
                const int t = smp ? ((row - RP) & (DSEQ - 1)) : (row & (SEQ - 1));
                const bool valid = (lr >= 2) && (row < R) && (t >= 2);
                const f32x4 cv = bb + w0 * p2 + w1 * p1 + w2 * cur;
                p2 = p1; p1 = cur;
                if (bj == 0) { cgv[i][0] = cv[0]; cgv[i][1] = cv[1]; cgv[i][2] = cv[2]; cgv[i][3] = cv[3]; }
                else { u32x2 w; w.x = pk2(gelu_tanh(cgv[i][0]) * cv[0], gelu_tanh(cgv[i][1]) * cv[1]); w.y = pk2(gelu_tanh(cgv[i][2]) * cv[2], gelu_tanh(cgv[i][3]) * cv[3]); if (valid) *(u32x2*)(act + (size_t)row * DFF + j0 + 4 * n) = w; }
            }
        }
    }
};

template <int MODE>
__device__ __forceinline__ void mini_gemm(LAS unsigned char* lds, const bf16_t* A, const bf16_t* Bt, int K, int N, bf16_t* O, int ldc, const float* rstd, float* sumsq, int bx, int G, int tid, int wave, int lane) {
    const int r = lane & 31, hf = lane >> 5, ntn = N >> 5, ntiles = 8 * ntn, kw = K >> 3;
    LAS float* red = (LAS float*)lds;
    for (int tile = bx; tile < ntiles; tile += G) {
        const int m0 = (tile / ntn) * 32, n0 = (tile % ntn) * 32;
        const bf16_t* ap = A + (size_t)(m0 + r) * K + wave * kw + 8 * hf; const bf16_t* bp = Bt + (size_t)(n0 + r) * K + wave * kw + 8 * hf;
        f32x16 acc; for (int i = 0; i < 16; ++i) acc[i] = 0.f;
        for (int k = 0; k < kw; k += 16) { const bf16x8 af = *(const bf16x8*)(ap + k), bf = *(const bf16x8*)(bp + k); acc = __builtin_amdgcn_mfma_f32_32x32x16_bf16(af, bf, acc, 0, 0, 0); }
        __syncthreads();
#pragma unroll
        for (int i = 0; i < 16; ++i) red[(wave * 16 + i) * 64 + lane] = acc[i];
        __syncthreads();
#pragma unroll
        for (int h2 = 0; h2 < 2; ++h2) {
            const int e = tid + h2 * 512, i = e >> 6, ln = e & 63;
            float v = 0.f;
#pragma unroll
            for (int w = 0; w < 8; ++w) v += red[(w * 16 + i) * 64 + ln];
            const int row = m0 + (i & 3) + 8 * (i >> 2) + 4 * (ln >> 5), col = n0 + (ln & 31);
            if (MODE == 0) { O[(size_t)row * ldc + col] = (bf16_t)f2bf(v * rstd[row]); }
            else { O[(size_t)row * ldc + col] = (bf16_t)f2bf(v); float ss = v * v;
#pragma unroll
                for (int o = 1; o < 32; o <<= 1) ss += __shfl_xor(ss, o);
                if ((ln & 31) == 0) atomicAdd(sumsq + row, ss); }
        }
    }
    __syncthreads();
}

__device__ __forceinline__ int fix_row(int m) { const int sq = m >> 2, k4 = m & 3; return sq < 8 ? sq * SEQ + (k4 < 2 ? k4 : SEQ - 4 + k4) : RP + (sq - 8) * DSEQ + (k4 < 2 ? k4 : DSEQ - 4 + k4); }
__device__ __forceinline__ void up_fixup(const Args& a, LAS unsigned char* lds, int bx, int G, int tid, int wave, int lane) {
    const int r = lane & 31, hf = lane >> 5;
    LAS float* red = (LAS float*)lds;
    LAS float* tile = (LAS float*)(lds + 65536);
    const bf16_t* hb = (const bf16_t*)(a.ws + WS_HB); const bf16_t* W = (const bf16_t*)(a.ws + WS_WUP); const float* rstd3 = (const float*)(a.ws + WS_RSTD3);
    for (int item = bx; item < 176; item += G) {
        const int mt = item / 88, cp = item % 88, pn = cp >> 2, sub = cp & 3;
        const bf16_t* ap = hb + (size_t)fix_row(mt * 32 + r) * DM + wave * 128 + 8 * hf;
        const bf16_t* bg = W + (size_t)(256 * pn + 32 * sub + r) * DM + wave * 128 + 8 * hf; const bf16_t* bv = bg + (size_t)128 * DM;
        f32x16 ag, av; for (int i = 0; i < 16; ++i) { ag[i] = 0.f; av[i] = 0.f; }
#pragma unroll
        for (int k = 0; k < 128; k += 16) { const bf16x8 af = *(const bf16x8*)(ap + k); ag = __builtin_amdgcn_mfma_f32_32x32x16_bf16(af, *(const bf16x8*)(bg + k), ag, 0, 0, 0); av = __builtin_amdgcn_mfma_f32_32x32x16_bf16(af, *(const bf16x8*)(bv + k), av, 0, 0, 0); }
        __syncthreads();
#pragma unroll
        for (int i = 0; i < 16; ++i) { red[((wave * 2 + 0) * 16 + i) * 64 + lane] = ag[i]; red[((wave * 2 + 1) * 16 + i) * 64 + lane] = av[i]; }
        __syncthreads();
#pragma unroll
        for (int h4 = 0; h4 < 4; ++h4) {
            const int e = tid + h4 * 512, gv = e >> 10, i = (e >> 6) & 15, ln = e & 63;
            float v = 0.f;
#pragma unroll
            for (int w = 0; w < 8; ++w) v += red[((w * 2 + gv) * 16 + i) * 64 + ln];
            const int ml = (i & 3) + 8 * (i >> 2) + 4 * (ln >> 5);
            tile[(gv * 32 + ml) * 32 + (ln & 31)] = v * rstd3[fix_row(mt * 32 + ml)];
        }
        __syncthreads();
        {
            const int q = tid >> 6, c = tid & 31, part = (tid >> 5) & 1, m0 = 4 * q, b = q;
            const int j = 128 * pn + 32 * sub + c;
            if (part == 0) {
                const float* cw = a.in[I_FCW]; const float* cb = a.in[I_FCB];
                const float ug0 = tile[(m0) * 32 + c], ug1 = tile[(m0 + 1) * 32 + c], uv0 = tile[(32 + m0) * 32 + c], uv1 = tile[(32 + m0 + 1) * 32 + c];
                float hg0 = 0.f, hg1 = 0.f, hv0 = 0.f, hv1 = 0.f;
                if (mt) { const float* ch = a.in[I_CFFN] + (size_t)(b * 2) * NUP; hg0 = ch[j]; hg1 = ch[NUP + j]; hv0 = ch[DFF + j]; hv1 = ch[NUP + DFF + j]; }
                const float wg0 = cw[j], wg1 = cw[NUP + j], wg2 = cw[2 * NUP + j], bgg = cb[j], wv0 = cw[DFF + j], wv1 = cw[NUP + DFF + j], wv2 = cw[2 * NUP + DFF + j], bvv = cb[DFF + j];
                const float cg0 = bgg + wg0 * hg0 + wg1 * hg1 + wg2 * ug0, cv0 = bvv + wv0 * hv0 + wv1 * hv1 + wv2 * uv0;
                const float cg1 = bgg + wg0 * hg1 + wg1 * ug0 + wg2 * ug1, cv1 = bvv + wv0 * hv1 + wv1 * uv0 + wv2 * uv1;
                bf16_t* act = (bf16_t*)(a.ws + WS_ACT);
                const int row0 = fix_row(mt * 32 + m0);
                act[(size_t)row0 * DFF + j] = (bf16_t)f2bf(gelu_tanh(cg0) * cv0); act[(size_t)(row0 + 1) * DFF + j] = (bf16_t)f2bf(gelu_tanh(cg1) * cv1);
            } else {
                float* op = (mt ? a.out + O_FFNS : a.out + O_FFNP) + (size_t)(b * 2) * NUP;
                op[j] = tile[(m0 + 2) * 32 + c]; op[NUP + j] = tile[(m0 + 3) * 32 + c]; op[DFF + j] = tile[(32 + m0 + 2) * 32 + c]; op[NUP + DFF + j] = tile[(32 + m0 + 3) * 32 + c];
            }
        }
    }
    __syncthreads();
}

__device__ __forceinline__ void transpose_item(const float* W, int ldw, int K, bf16_t* WT, const float* kscale, LAS float* scr, int k0, int srccol0, int dstrow0, int lane) {
#pragma unroll 8
    for (int i = 0; i < 32; ++i) { const int kk = 2 * i + (lane >> 5); float v = W[(size_t)(k0 + kk) * ldw + srccol0 + (lane & 31)]; if (kscale) v *= kscale[k0 + kk]; scr[kk * 33 + (lane & 31)] = v; }
    asm volatile("s_waitcnt lgkmcnt(0)" ::: "memory");
    const int c = lane & 7;
#pragma unroll
    for (int j = 0; j < 4; ++j) { const int n = (lane >> 3) + 8 * j; const LAS float* s = scr + (8 * c) * 33 + n;
        u32x4 o; o.x = pk2(s[0 * 33], s[1 * 33]); o.y = pk2(s[2 * 33], s[3 * 33]); o.z = pk2(s[4 * 33], s[5 * 33]); o.w = pk2(s[6 * 33], s[7 * 33]);
        *(u32x4*)(WT + (size_t)(dstrow0 + n) * K + k0 + 8 * c) = o; }
    asm volatile("s_waitcnt lgkmcnt(0)" ::: "memory");
}

__device__ __forceinline__ void p0_prologue(const Args& a, LAS unsigned char* lds, int gw, int NGW, int lane, int wave) {
    unsigned char* ws = a.ws;
    LAS float* scr = (LAS float*)(lds + wave * 16384);
    bf16_t* WinT = (bf16_t*)(ws + WS_WIN); bf16_t* WoutT = (bf16_t*)(ws + WS_WOUT); bf16_t* WupT = (bf16_t*)(ws + WS_WUP); bf16_t* WdownT = (bf16_t*)(ws + WS_WDOWN);
    constexpr int I_IN = 16 * 64, I_OUT = 16 * 32, I_UP = 16 * 176, I_DOWN = 44 * 32, NIT = I_IN + I_OUT + I_UP + I_DOWN;
    for (int it = gw; it < NIT; it += NGW) {
        int r = it;
        if (r < I_IN) { const int kb = r / 64, nb = r % 64; const int dst = nb * 32; const int src = dst < 1536 ? dst : dst + 8;
            transpose_item(a.in[I_WIN], 2056, 1024, WinT, a.in[I_PREMIX], scr, kb * 64, src, dst, lane); continue; }
        r -= I_IN;
        if (r < I_OUT) { const int kb = r / 32, nb = r % 32; transpose_item(a.in[I_WOUT], 1024, 1024, WoutT, nullptr, scr, kb * 64, nb * 32, nb * 32, lane); continue; }
        r -= I_OUT;
        if (r < I_UP) { const int kb = r / 176, nb = r % 176; const int dst = nb * 32; const int pn = dst >> 8, i = dst & 255; const int src = i < 128 ? pn * 128 + i : DFF + pn * 128 + (i - 128);
            transpose_item(a.in[I_WUP], NUP, 1024, WupT, a.in[I_PREFFN], scr, kb * 64, src, dst, lane); continue; }
        r -= I_UP;
        { const int kb = r / 32, nb = r % 32; transpose_item(a.in[I_WDOWN], 1024, DFF, WdownT, nullptr, scr, kb * 64, nb * 32, nb * 32, lane); }
    }
    { float* s2 = (float*)(ws + WS_SUMSQ2); float* s4 = (float*)(ws + WS_SUMSQ4);
      for (int i = gw * 64 + lane; i < R; i += NGW * 64) { s2[i] = 0.f; s4[i] = 0.f; } }
    float wd[8][16];
    { const float* Win = a.in[I_WIN]; const float* pw = a.in[I_PREMIX];
#pragma unroll
      for (int j = 0; j < 8; ++j)
#pragma unroll
          for (int q = 0; q < 4; ++q)
#pragma unroll
              for (int e = 0; e < 4; ++e) { const int k = q * 256 + lane * 4 + e; wd[j][q * 4 + e] = Win[(size_t)k * 2056 + 1536 + j] * pw[k]; } }
    bf16_t* xb = (bf16_t*)(ws + WS_HB); float* rstd1 = (float*)(ws + WS_RSTD1); float* dtv = (float*)(ws + WS_DTV);
    const float* dtb = a.in[I_DTB];
    for (int row0 = 2 * gw; row0 < R; row0 += 2 * NGW) {
        f32x4 vv[2][4];
#pragma unroll
        for (int rr = 0; rr < 2; ++rr) { const int row = row0 + rr;
            const float* xr = row < RP ? a.in[I_XP] + (size_t)row * DM : a.in[I_XS] + (size_t)(row - RP) * DM;
#pragma unroll
            for (int q = 0; q < 4; ++q) vv[rr][q] = *(const f32x4*)(xr + q * 256 + lane * 4); }
#pragma unroll
        for (int rr = 0; rr < 2; ++rr) { const int row = row0 + rr;
            float ss = 0.f;
#pragma unroll
            for (int q = 0; q < 4; ++q) { const f32x4 v = vv[rr][q]; ss += (v[0] * v[0] + v[1] * v[1]) + (v[2] * v[2] + v[3] * v[3]); }
            ss = wave_sum(ss);
            const float rs = 1.f / sqrtf(ss * (1.f / DM) + EPS);
#pragma unroll
            for (int q = 0; q < 4; ++q) { const f32x4 v = vv[rr][q]; u32x2 w; w.x = pk2(v[0], v[1]); w.y = pk2(v[2], v[3]); *(u32x2*)(xb + (size_t)row * DM + q * 256 + lane * 4) = w; }
            float myd = 0.f;
#pragma unroll
            for (int j = 0; j < 8; ++j) { float d = 0.f;
#pragma unroll
                for (int q = 0; q < 4; ++q)
#pragma unroll
                    for (int e = 0; e < 4; ++e) d += vv[rr][q][e] * wd[j][q * 4 + e];
                d = wave_sum(d);
                if (lane == j) myd = d; }
            if (lane < 8) { const float xx = myd * rs + dtb[lane]; dtv[(size_t)row * 8 + lane] = xx > 20.f ? xx : log1pf(expf(xx)); }
            if (lane == 0) rstd1[row] = rs; }
    }
}

constexpr int XT_LD = 72, BN_LD = 136;
constexpr int L_XT = 0;
constexpr int L_BT = 36864;
constexpr int L_CN = L_BT + 18432;
constexpr int L_CS = L_CN + 17408;
constexpr int L_SSD_END = L_CS + 4 * 4 * 64 * 4;
constexpr int SUB_LDS = L_SSD_END + 64;
__device__ __forceinline__ void sub_barrier(LAS unsigned* cnt, unsigned& target, int lane) {
    asm volatile("s_waitcnt lgkmcnt(0)" ::: "memory");
    target += 4u;
    if (lane == 0) __hip_atomic_fetch_add(cnt, 1u, __ATOMIC_RELAXED, __HIP_MEMORY_SCOPE_WORKGROUP);
    for (;;) { const unsigned v = (unsigned)__builtin_amdgcn_readfirstlane((int)__hip_atomic_load(cnt, __ATOMIC_RELAXED, __HIP_MEMORY_SCOPE_WORKGROUP)); if ((int)(v - target) >= 0) break; __builtin_amdgcn_s_sleep(1); }
    asm volatile("" ::: "memory");
}

struct SeqInfo { int row0; int nreal; int pad; bool smp; int b; int slot; };
__device__ __forceinline__ SeqInfo ssd_unit(int ubc) {
    SeqInfo s;
    if (ubc < NBATCH * NCHUNK) { s.b = ubc >> 7; s.row0 = ubc * 64; s.pad = 0; s.smp = false; }
    else { s.b = ubc - NBATCH * NCHUNK; s.row0 = RP + s.b * DSEQ - 32; s.pad = 32; s.smp = true; }
    s.slot = ubc; s.nreal = 64 - s.pad; return s;
}

__device__ __forceinline__ void ssd_cs(const Args& a, LAS unsigned char* lds, const SeqInfo& si, int g, int lane, int mode, float* cdec) {
    LAS float* cs = (LAS float*)(lds + L_CS); LAS float* dtl = cs + 256; LAS float* aux = cs + 512;
    const float* dtv = (const float*)(a.ws + WS_DTV);
#pragma unroll
    for (int h4 = 0; h4 < 4; ++h4) {
        const int h = g * 4 + h4;
        float d = dtv[(size_t)(si.row0 + lane) * 8 + h]; d = lane >= si.pad ? d : 0.f;
        const float av = -__expf(a.in[I_ALOG][h]);
        float x = d * av;
#pragma unroll
        for (int o = 1; o < 64; o <<= 1) { const float y = __shfl_up(x, o); if (lane >= o) x += y; }
        const float ce = __shfl(x, 63);
        cs[h4 * 64 + lane] = x; dtl[h4 * 64 + lane] = d;
        aux[h4 * 64 + lane] = mode == 0 ? __expf(ce - x) * d : __expf(x);
        if (mode == 0 && lane == 0 && cdec) cdec[(size_t)si.slot * 8 + h] = __expf(ce);
    }
}

__device__ __forceinline__ void raw8(const Args& a, const SeqInfo& si, int tpos  , int tok  , int cch, float (&o)[8]) {
    const bf16_t* proj = (const bf16_t*)(a.ws + WS_PROJ);
    if (tpos >= 0) { const u32x4 w = *(const u32x4*)(proj + (size_t)(si.row0 + tok) * NPROJ + 512 + cch);
        o[0] = bf2f(w.x & 0xffff); o[1] = bf2f(w.x >> 16); o[2] = bf2f(w.y & 0xffff); o[3] = bf2f(w.y >> 16); o[4] = bf2f(w.z & 0xffff); o[5] = bf2f(w.z >> 16); o[6] = bf2f(w.w & 0xffff); o[7] = bf2f(w.w >> 16); }
    else if (si.smp && tpos >= -3) { const float* c = a.in[I_CSSD] + (size_t)(si.b * 3 + (tpos + 3)) * 1024 + cch;
#pragma unroll
        for (int e = 0; e < 8; ++e) o[e] = c[e]; }
    else {
#pragma unroll
        for (int e = 0; e < 8; ++e) o[e] = 0.f; }
}

__device__ __forceinline__ void rowvals(const Args& a, const SeqInfo& si, const u32x4 w, int tpos, int cch, float (&o)[8]) {
    o[0] = bf2f(w.x & 0xffff); o[1] = bf2f(w.x >> 16); o[2] = bf2f(w.y & 0xffff); o[3] = bf2f(w.y >> 16); o[4] = bf2f(w.z & 0xffff); o[5] = bf2f(w.z >> 16); o[6] = bf2f(w.w & 0xffff); o[7] = bf2f(w.w >> 16);
    if (tpos < 0) {
        if (si.smp && tpos >= -3) { const float* c = a.in[I_CSSD] + (size_t)(si.b * 3 + (tpos + 3)) * 1024 + cch;
#pragma unroll
            for (int e = 0; e < 8; ++e) o[e] = c[e]; }
        else {
#pragma unroll
            for (int e = 0; e < 8; ++e) o[e] = 0.f; }
    }
}
__device__ __forceinline__ void ssd_stage(const Args& a, LAS unsigned char* lds, const SeqInfo& si, int g, int c_in_seq, int tid, int mode) {
    const int cg8 = tid & 63;
    if (mode == 0 && cg8 >= 48) return;
    int cch, kind;
    if (cg8 < 32) { kind = 0; cch = g * 256 + cg8 * 8; } else if (cg8 < 48) { kind = 1; cch = 512 + g * 128 + (cg8 - 32) * 8; } else { kind = 2; cch = 768 + g * 128 + (cg8 - 48) * 8; }
    float w[4][8], bias[8];
#pragma unroll
    for (int k = 0; k < 4; ++k) { const f32x4 a0 = *(const f32x4*)(a.in[I_SCW] + k * 1024 + cch), a1 = *(const f32x4*)(a.in[I_SCW] + k * 1024 + cch + 4);
#pragma unroll
        for (int e = 0; e < 4; ++e) { w[k][e] = a0[e]; w[k][4 + e] = a1[e]; } }
    { const f32x4 a0 = *(const f32x4*)(a.in[I_SCB] + cch), a1 = *(const f32x4*)(a.in[I_SCB] + cch + 4);
#pragma unroll
      for (int e = 0; e < 4; ++e) { bias[e] = a0[e]; bias[4 + e] = a1[e]; } }
    const int seq0 = si.smp ? -32 : c_in_seq * 64;
#pragma unroll
    for (int tgi = 0; tgi < 2; ++tgi) {
    const int tg = __builtin_amdgcn_readfirstlane(tid >> 6) + 4 * tgi;
    const int t0 = 8 * tg;
    float r0[8], r1[8], r2[8], r3[8];
    u32x4 rw[11];
    { const bf16_t* pr = (const bf16_t*)(a.ws + WS_PROJ) + (size_t)(si.row0 + t0 - 3) * NPROJ + 512 + cch;
#pragma unroll
      for (int i = 0; i < 11; ++i) rw[i] = *(const u32x4*)(pr + (size_t)i * NPROJ); }
    rowvals(a, si, rw[0], seq0 + t0 - 3, cch, r0); rowvals(a, si, rw[1], seq0 + t0 - 2, cch, r1); rowvals(a, si, rw[2], seq0 + t0 - 1, cch, r2);
    unsigned pk[4][8]; float prev[8];
    const LAS float* aux = (const LAS float*)(lds + L_CS) + 512;
#pragma unroll
    for (int i = 0; i < 8; ++i) {
        rowvals(a, si, rw[3 + i], seq0 + t0 + i, cch, r3);
        const bool real = (t0 + i) >= si.pad;
        float sc = 1.f;
        if (mode == 0 && kind == 0) sc = aux[(cg8 >> 3) * 64 + t0 + i];
#pragma unroll
        for (int e = 0; e < 8; ++e) { const float v = __builtin_fmaf(w[3][e], r3[e], __builtin_fmaf(w[2][e], r2[e], __builtin_fmaf(w[1][e], r1[e], __builtin_fmaf(w[0][e], r0[e], bias[e]))));
            const float ov = real ? silu_f(v) * sc : 0.f; r0[e] = r1[e]; r1[e] = r2[e]; r2[e] = r3[e];
            if (i & 1) pk[i >> 1][e] = pk2(prev[e], ov); else prev[e] = ov; }
    }
    const bool transposed = (kind == 0) || (mode == 0);
    if (transposed) {
        LAS bf16_t* base = kind == 0 ? (LAS bf16_t*)(lds + L_XT) + (cg8 * 8) * XT_LD : (LAS bf16_t*)(lds + L_BT) + ((cg8 - 32) * 8) * XT_LD;
#pragma unroll
        for (int e = 0; e < 8; ++e) { u32x4 o; o.x = pk[0][e]; o.y = pk[1][e]; o.z = pk[2][e]; o.w = pk[3][e];
            *(LAS u32x4*)(base + e * XT_LD + ((tg ^ (cg8 & 7)) << 3)) = o; }
    } else {
        LAS bf16_t* base = kind == 1 ? (LAS bf16_t*)(lds + L_BT) + (cg8 - 32) * 8 : (LAS bf16_t*)(lds + L_CN) + (cg8 - 48) * 8;
#pragma unroll
        for (int q = 0; q < 4; ++q) {
            u32x4 o0, o1;
#pragma unroll
            for (int c2 = 0; c2 < 4; ++c2) { const unsigned lo = pk[q][2 * c2], hi = pk[q][2 * c2 + 1];
                o0[c2] = (lo & 0xffffu) | (hi << 16); o1[c2] = (lo >> 16) | (hi & 0xffff0000u); }
            *(LAS u32x4*)(base + (t0 + 2 * q) * BN_LD) = o0; *(LAS u32x4*)(base + (t0 + 2 * q + 1) * BN_LD) = o1;
        }
    }
    }
}

#define MFMA32(a, b, c) __builtin_amdgcn_mfma_f32_32x32x16_bf16((a), (b), (c), 0, 0, 0)
__device__ __forceinline__ f32x16 zero16() { f32x16 z; for (int i = 0; i < 16; ++i) z[i] = 0.f; return z; }

__device__ __forceinline__ void ssd_passA_unit(const Args& a, LAS unsigned char* lds, int unit, int tid, int w4, int lane, LAS unsigned* bcnt, unsigned& btarget) {
    const int ubc = unit >> 1, g = unit & 1;
    const SeqInfo si = ssd_unit(ubc);
    sub_barrier(bcnt, btarget, lane);
    ssd_cs(a, lds, si, g, lane, 0, w4 == 0 ? (float*)(a.ws + WS_CDEC) : nullptr);
    ssd_stage(a, lds, si, g, ubc & 127, tid, 0);
    sub_barrier(bcnt, btarget, lane);
    const int h4 = w4, r = lane & 31, hf = lane >> 5;
    const LAS bf16_t* XT = (const LAS bf16_t*)(lds + L_XT); const LAS bf16_t* BT = (const LAS bf16_t*)(lds + L_BT);
    bf16_t* sst = (bf16_t*)(a.ws + WS_SST) + ((size_t)si.slot * 8 + g * 4 + h4) * 8192;
#pragma unroll 1
    for (int nh = 0; nh < 2; ++nh) {
        f32x16 acc[2][2]; acc[0][0] = zero16(); acc[0][1] = zero16(); acc[1][0] = zero16(); acc[1][1] = zero16();
#pragma unroll
        for (int ks = 0; ks < 4; ++ks) {
            bf16x8 af[2], bfr[2];
#pragma unroll
            for (int ni = 0; ni < 2; ++ni) af[ni] = *(const LAS bf16x8*)(BT + (nh * 64 + ni * 32 + r) * XT_LD + (((ks * 2 + hf) ^ ((ni * 4 + (r >> 3)) & 7)) << 3));
#pragma unroll
            for (int pj = 0; pj < 2; ++pj) bfr[pj] = *(const LAS bf16x8*)(XT + (h4 * 64 + pj * 32 + r) * XT_LD + (((ks * 2 + hf) ^ ((pj * 4 + (r >> 3)) & 7)) << 3));
#pragma unroll
            for (int ni = 0; ni < 2; ++ni)
#pragma unroll
                for (int pj = 0; pj < 2; ++pj) acc[ni][pj] = MFMA32(af[ni], bfr[pj], acc[ni][pj]);
        }
#pragma unroll
        for (int ni = 0; ni < 2; ++ni)
#pragma unroll
            for (int pj = 0; pj < 2; ++pj)
#pragma unroll
                for (int i = 0; i < 4; ++i) { const int p = pj * 32 + r, n = nh * 64 + ni * 32 + 8 * i + 4 * hf;
                    u32x2 w; w.x = pk2(acc[ni][pj][4 * i], acc[ni][pj][4 * i + 1]); w.y = pk2(acc[ni][pj][4 * i + 2], acc[ni][pj][4 * i + 3]);
                    *(u32x2*)(sst + p * 128 + n) = w; }
    }
}

__device__ __forceinline__ void ssd_passC_unit(const Args& a, LAS unsigned char* lds, int unit, int tid, int w4, int lane, LAS unsigned* bcnt, unsigned& btarget) {
    const int ubc = unit >> 1, g = unit & 1;
    const SeqInfo si = ssd_unit(ubc);
    sub_barrier(bcnt, btarget, lane);
    ssd_cs(a, lds, si, g, lane, 1, nullptr);
    ssd_stage(a, lds, si, g, ubc & 127, tid, 1);
    sub_barrier(bcnt, btarget, lane);
    const int h4 = w4, r = lane & 31, hf = lane >> 5, h = g * 4 + h4;
    const LAS bf16_t* XT = (const LAS bf16_t*)(lds + L_XT) + h4 * 64 * XT_LD; const LAS bf16_t* Bn = (const LAS bf16_t*)(lds + L_BT); const LAS bf16_t* Cn = (const LAS bf16_t*)(lds + L_CN);
    const LAS float* cs = (const LAS float*)(lds + L_CS) + h4 * 64; const LAS float* dtl = cs + 256; const LAS float* ecs = cs + 512; LAS float* red = (LAS float*)(lds + L_CS) + 768;
#pragma unroll 1
    for (int lh = 0; lh < 2; ++lh) {
    const int l = lh * 32 + r;
    const int row = si.row0 + l;
    const bool realtok = l >= si.pad;
    const bf16_t* zrow = (const bf16_t*)(a.ws + WS_PROJ) + (size_t)row * NPROJ + g * 256 + h4 * 64;
    u32x2 zq[2][4];
#pragma unroll
    for (int pt = 0; pt < 2; ++pt)
#pragma unroll
        for (int i = 0; i < 4; ++i) zq[pt][i] = *(const u32x2*)(zrow + pt * 32 + 8 * i + 4 * hf);
    bf16x8 cf[8];
#pragma unroll
    for (int ks = 0; ks < 8; ++ks) cf[ks] = *(const LAS bf16x8*)(Cn + l * BN_LD + ks * 16 + 8 * hf);
    f32x16 ya[2]; ya[0] = zero16(); ya[1] = zero16();
    const bf16_t* hp = (const bf16_t*)(a.ws + WS_SST) + ((size_t)si.slot * 8 + h) * 8192;
#pragma unroll
    for (int ks = 0; ks < 8; ++ks) {
#pragma unroll
        for (int pt = 0; pt < 2; ++pt) { const bf16x8 af = *(const bf16x8*)(hp + (pt * 32 + r) * 128 + ks * 16 + 8 * hf); ya[pt] = MFMA32(af, cf[ks], ya[pt]); }
    }
    { const float e = ecs[l];
#pragma unroll
      for (int pt = 0; pt < 2; ++pt)
#pragma unroll
          for (int i = 0; i < 16; ++i) ya[pt][i] *= e; }
    const float csl = cs[l];
#pragma unroll
    for (int st = 0; st < 2; ++st) {
        if (st <= lh) {
            f32x16 sa = zero16();
#pragma unroll
            for (int ks = 0; ks < 8; ++ks) { const bf16x8 af = *(const LAS bf16x8*)(Bn + (st * 32 + r) * BN_LD + ks * 16 + 8 * hf); sa = MFMA32(af, cf[ks], sa); }
#pragma unroll
            for (int i = 0; i < 16; ++i) { const int s = st * 32 + (i & 3) + 8 * (i >> 2) + 4 * hf;
                const float v = sa[i] * __expf(csl - cs[s]) * dtl[s]; sa[i] = (s <= l) ? v : 0.f; }
#pragma unroll
            for (int k2 = 0; k2 < 2; ++k2) {
                u32x4 gp; gp.x = pk2(sa[8 * k2 + 0], sa[8 * k2 + 1]); gp.y = pk2(sa[8 * k2 + 2], sa[8 * k2 + 3]); gp.z = pk2(sa[8 * k2 + 4], sa[8 * k2 + 5]); gp.w = pk2(sa[8 * k2 + 6], sa[8 * k2 + 7]);
                const bf16x8 gf = __builtin_bit_cast(bf16x8, gp);
#pragma unroll
                for (int pt = 0; pt < 2; ++pt) {
                    const LAS bf16_t* xr = XT + (pt * 32 + r) * XT_LD + 4 * hf; const int swz = (pt * 4 + (r >> 3)) & 7;
                    const u32x2 lo = *(const LAS u32x2*)(xr + (((st * 4 + 2 * k2) ^ swz) << 3)), hi = *(const LAS u32x2*)(xr + (((st * 4 + 2 * k2 + 1) ^ swz) << 3));
                    u32x4 xa; xa.x = lo.x; xa.y = lo.y; xa.z = hi.x; xa.w = hi.y;
                    ya[pt] = MFMA32(__builtin_bit_cast(bf16x8, xa), gf, ya[pt]);
                }
            }
        }
    }
    const float Dh = a.in[I_SSDD][h];
    float ssq = 0.f;
#pragma unroll
    for (int pt = 0; pt < 2; ++pt)
#pragma unroll
        for (int i = 0; i < 4; ++i) {
            const int p0 = pt * 32 + 8 * i + 4 * hf;
            const u32x2 zz = zq[pt][i];
            const float zv[4] = {bf2f(zz.x & 0xffff), bf2f(zz.x >> 16), bf2f(zz.y & 0xffff), bf2f(zz.y >> 16)};
#pragma unroll
            for (int j = 0; j < 4; ++j) { const float xv = bf2f(XT[(p0 + j) * XT_LD + ((((l >> 3) ^ ((pt * 4 + i) & 7)) << 3) | (l & 7))]); const float y = (ya[pt][4 * i + j] + Dh * xv) * silu_f(zv[j]); ya[pt][4 * i + j] = y; ssq += y * y; }
        }
    ssq += __shfl_xor(ssq, 32);
    if (hf == 0) red[h4 * 64 + l] = ssq;
    sub_barrier(bcnt, btarget, lane);
    const float* nw0 = a.in[I_SNW] + g * 256 + h4 * 64;
    const float tot = red[l] + red[64 + l] + red[128 + l] + red[192 + l];
    const float rs = 1.f / sqrtf(tot * (1.f / 256.f) + EPS);
    if (realtok) {
        bf16_t* orow = (bf16_t*)(a.ws + WS_MIXIN) + (size_t)row * DM + g * 256 + h4 * 64;
#pragma unroll
        for (int pt = 0; pt < 2; ++pt)
#pragma unroll
            for (int i = 0; i < 4; ++i) { const int p0 = pt * 32 + 8 * i + 4 * hf; const f32x4 nq = *(const f32x4*)(nw0 + p0);
                u32x2 w; w.x = pk2(ya[pt][4 * i] * rs * nq[0], ya[pt][4 * i + 1] * rs * nq[1]); w.y = pk2(ya[pt][4 * i + 2] * rs * nq[2], ya[pt][4 * i + 3] * rs * nq[3]);
                *(u32x2*)(orow + p0) = w; }
    }
    }
}

struct S5Consts { float lbr, lbi; bf16x8 bb[4]; };
__device__ __forceinline__ void s5_lambda(const Args& a, int g, int p, float& lbr, float& lbi, float& qr, float& qi) {
    const float lr = a.in[I_LRE][g * 64 + p], li = a.in[I_LIM][g * 64 + p], dt = expf(a.in[I_LDT][g]);
    const float mag = expf(lr * dt), ang = li * dt;
    lbr = mag * cosf(ang); lbi = mag * sinf(ang);
    const float den = lr * lr + li * li;
    qr = ((lbr - 1.f) * lr + lbi * li) / den; qi = (lbi * lr - (lbr - 1.f) * li) / den;
}
__device__ __forceinline__ void s5_consts(const Args& a, int g, int lane, S5Consts& c) {
    const int r = lane & 31, hf = lane >> 5;
    float lb0r, lb0i, q0r, q0i, lb1r, lb1i, q1r, q1i;
    s5_lambda(a, g, r, lb0r, lb0i, q0r, q0i); s5_lambda(a, g, 32 + r, lb1r, lb1i, q1r, q1i);
    c.lbr = hf ? lb1r : lb0r; c.lbi = hf ? lb1i : lb0i;
#pragma unroll
    for (int nb = 0; nb < 4; ++nb) {
        const int ps = r + 32 * (nb >> 1); const float qr = (nb >> 1) ? q1r : q0r, qi = (nb >> 1) ? q1i : q0i;
        const float* br = a.in[I_BRE] + (size_t)(g * 64 + ps) * 16 + 8 * hf; const float* bi = a.in[I_BIM] + (size_t)(g * 64 + ps) * 16 + 8 * hf;
        float v[8];
#pragma unroll
        for (int j = 0; j < 8; ++j) v[j] = (nb & 1) ? (qr * bi[j] + qi * br[j]) : (qr * br[j] - qi * bi[j]);
        u32x4 w; w.x = pk2(v[0], v[1]); w.y = pk2(v[2], v[3]); w.z = pk2(v[4], v[5]); w.w = pk2(v[6], v[7]);
        c.bb[nb] = __builtin_bit_cast(bf16x8, w);
    }
}
template <bool STORE>
__device__ __forceinline__ void s5_block(const Args& a, const S5Consts& c, const bf16x8 uf, int lane, float& hr, float& hi, LAS unsigned char* wl, const bf16_t* nxt, bf16x8& nuf) {
    f32x16 bu[4];
#pragma unroll
    for (int nb = 0; nb < 4; ++nb) bu[nb] = MFMA32(uf, c.bb[nb], zero16());
    asm volatile("" ::: "memory");
    nuf = *(const bf16x8*)nxt;
    asm volatile("" ::: "memory");
#pragma unroll
    for (int i = 0; i < 16; ++i) {
        auto s0 = __builtin_amdgcn_permlane32_swap(__float_as_uint(bu[0][i]), __float_as_uint(bu[2][i]), false, false);
        auto s1 = __builtin_amdgcn_permlane32_swap(__float_as_uint(bu[1][i]), __float_as_uint(bu[3][i]), false, false);
        bu[0][i] = __uint_as_float(s0[0]); bu[2][i] = __uint_as_float(s0[1]); bu[1][i] = __uint_as_float(s1[0]); bu[3][i] = __uint_as_float(s1[1]);
    }
    const float nlbi = -c.lbi;
#pragma unroll
    for (int ib = 0; ib < 4; ++ib) {
#pragma unroll
        for (int j = 0; j < 4; ++j) { const float nr = __builtin_fmaf(c.lbr, hr, __builtin_fmaf(nlbi, hi, bu[0][4 * ib + j])), ni = __builtin_fmaf(c.lbr, hi, __builtin_fmaf(c.lbi, hr, bu[1][4 * ib + j])); hr = nr; hi = ni; if (STORE) *(LAS unsigned*)(wl + (8 * ib + j) * 272 + lane * 4) = pk2(hr, hi); }
#pragma unroll
        for (int j = 0; j < 4; ++j) { const float nr = __builtin_fmaf(c.lbr, hr, __builtin_fmaf(nlbi, hi, bu[2][4 * ib + j])), ni = __builtin_fmaf(c.lbr, hi, __builtin_fmaf(c.lbi, hr, bu[3][4 * ib + j])); hr = nr; hi = ni; if (STORE) *(LAS unsigned*)(wl + (8 * ib + 4 + j) * 272 + lane * 4) = pk2(hr, hi); }
    }
}
__device__ __forceinline__ void s5_passA_item(const Args& a, int item, int lane) {
    const int b = item >> 8, g = (item >> 3) & 31, seg = item & 7;
    S5Consts c; s5_consts(a, g, lane, c);
    float hr = 0.f, hi = 0.f;
    const int row0 = b * SEQ + seg * 1024;
    const bf16_t* up_ = (const bf16_t*)(a.ws + WS_PROJ) + (size_t)(row0 + (lane & 31)) * NPROJ + 1536 + g * 16 + 8 * (lane >> 5);
    bf16x8 uf = *(const bf16x8*)up_;
    for (int blk = 0; blk < 32; ++blk) { const int nb = blk < 31 ? blk + 1 : 31; bf16x8 nuf; s5_block<false>(a, c, uf, lane, hr, hi, nullptr, up_ + (size_t)nb * 32 * NPROJ, nuf); uf = nuf; }
    float* loc = (float*)(a.ws + WS_S5LOC) + (size_t)item * 128;
    loc[lane] = hr; loc[64 + lane] = hi;
}
constexpr int S5_LD = 272;
__device__ __forceinline__ void s5_passC_run(const Args& a, LAS unsigned char* wlds, int row0, int nblk, int g, int lane, float& hr, float& hi) {
    S5Consts c; s5_consts(a, g, lane, c);
    const int r16 = lane & 15, q4 = lane >> 4;
    bf16x8 ca[4];
#pragma unroll
    for (int kb = 0; kb < 4; ++kb) { float v[8];
#pragma unroll
        for (int j = 0; j < 8; ++j) { const int comp = 32 * kb + 8 * q4 + j, p = comp >> 1; v[j] = (comp & 1) ? -a.in[I_CIM][(size_t)(g * 16 + r16) * 64 + p] : a.in[I_CRE][(size_t)(g * 16 + r16) * 64 + p]; }
        u32x4 w; w.x = pk2(v[0], v[1]); w.y = pk2(v[2], v[3]); w.z = pk2(v[4], v[5]); w.w = pk2(v[6], v[7]); ca[kb] = __builtin_bit_cast(bf16x8, w); }
    bf16x4 ga[2];
#pragma unroll
    for (int mb = 0; mb < 2; ++mb) { float v[4];
#pragma unroll
        for (int j = 0; j < 4; ++j) v[j] = a.in[I_GLUW][(size_t)(g * 16 + 4 * q4 + j) * 32 + mb * 16 + r16];
        u32x2 w; w.x = pk2(v[0], v[1]); w.y = pk2(v[2], v[3]); ga[mb] = __builtin_bit_cast(bf16x4, w); }
    f32x4 dD, gb0, gb1;
#pragma unroll
    for (int j = 0; j < 4; ++j) { dD[j] = a.in[I_S5D][g * 16 + 4 * q4 + j]; gb0[j] = a.in[I_GLUB][g * 32 + 4 * q4 + j]; gb1[j] = a.in[I_GLUB][g * 32 + 16 + 4 * q4 + j]; }
    const bf16_t* proj = (const bf16_t*)(a.ws + WS_PROJ);
    bf16_t* mixin = (bf16_t*)(a.ws + WS_MIXIN);
    const bf16_t* up_ = proj + (size_t)(row0 + (lane & 31)) * NPROJ + 1536 + g * 16 + 8 * (lane >> 5);
    bf16x8 uf = *(const bf16x8*)up_;
    u32x2 uus[2], uun[2];
#pragma unroll
    for (int sb = 0; sb < 2; ++sb) uus[sb] = *(const u32x2*)(proj + (size_t)(row0 + sb * 16 + r16) * NPROJ + 1536 + g * 16 + 4 * q4);
    for (int blk = 0; blk < nblk; ++blk) {
        const int rb = row0 + blk * 32;
        const int nb = blk < nblk - 1 ? blk + 1 : blk; bf16x8 nuf;
        s5_block<true>(a, c, uf, lane, hr, hi, wlds, up_ + (size_t)nb * 32 * NPROJ, nuf); uf = nuf;
#pragma unroll
        for (int sb = 0; sb < 2; ++sb) uun[sb] = *(const u32x2*)(proj + (size_t)(row0 + nb * 32 + sb * 16 + r16) * NPROJ + 1536 + g * 16 + 4 * q4);
        asm volatile("s_waitcnt lgkmcnt(0)" ::: "memory");
#pragma unroll
        for (int sb = 0; sb < 2; ++sb) {
            f32x4 y = (f32x4){0.f, 0.f, 0.f, 0.f};
#pragma unroll
            for (int kb = 0; kb < 4; ++kb) { const bf16x8 hb = *(const LAS bf16x8*)(wlds + (sb * 16 + r16) * S5_LD + (32 * kb + 8 * q4) * 2);
                y = __builtin_amdgcn_mfma_f32_16x16x32_bf16(ca[kb], hb, y, 0, 0, 0); }
            const int row = rb + sb * 16 + r16;
            const u32x2 uu = uus[sb];
            const float uv[4] = {bf2f(uu.x & 0xffff), bf2f(uu.x >> 16), bf2f(uu.y & 0xffff), bf2f(uu.y >> 16)};
            float ge[4];
#pragma unroll
            for (int j = 0; j < 4; ++j) ge[j] = gelu_tanh(y[j] + dD[j] * uv[j]);
            u32x2 gw; gw.x = pk2(ge[0], ge[1]); gw.y = pk2(ge[2], ge[3]);
            const bf16x4 gbf = __builtin_bit_cast(bf16x4, gw);
            const f32x4 o0 = __builtin_amdgcn_mfma_f32_16x16x16bf16_1k(ga[0], gbf, gb0, 0, 0, 0);
            const f32x4 o1 = __builtin_amdgcn_mfma_f32_16x16x16bf16_1k(ga[1], gbf, gb1, 0, 0, 0);
            float ov[4];
#pragma unroll
            for (int j = 0; j < 4; ++j) ov[j] = o0[j] * __builtin_amdgcn_rcpf(1.f + __builtin_amdgcn_exp2f(-1.4426950409f * o1[j]));
            u32x2 ow; ow.x = pk2(ov[0], ov[1]); ow.y = pk2(ov[2], ov[3]);
            *(u32x2*)(mixin + (size_t)row * DM + 512 + g * 16 + 4 * q4) = ow;
        }
        asm volatile("s_waitcnt lgkmcnt(0)" ::: "memory");
        uus[0] = uun[0]; uus[1] = uun[1];
    }
}

#define XB_TMO      128
#define XB_XCNT(j)  (256  + 64 * (j))
#define XB_XSUB(j)  (1280 + 64 * (j))
#define XB_XGEN(j)  (2304 + 64 * (j))
#define XB_TOP      3328
#define XB_TOPGEN   3392
#define XCD_BAR_WORDS 3456
#define XB_SPIN_CAP (1u << 18)

__device__ __forceinline__ unsigned xb_ld(unsigned* p)              { return __hip_atomic_load(p, __ATOMIC_RELAXED, __HIP_MEMORY_SCOPE_AGENT); }
__device__ __forceinline__ unsigned xb_add(unsigned* p, unsigned v) { return __hip_atomic_fetch_add(p, v, __ATOMIC_RELAXED, __HIP_MEMORY_SCOPE_AGENT); }
__device__ __forceinline__ unsigned xb_xcc_id() { return (unsigned)__builtin_amdgcn_s_getreg((3 << 11) | 20) & 0xFu; }
#define XB_SPIN(cond, bar) do { unsigned _sp = 0; while (cond) { __builtin_amdgcn_s_sleep(1); \
    if ((++_sp & 255u) == 0u) { if (xb_ld(&(bar)[XB_TMO])) break; if (_sp > XB_SPIN_CAP) { atomicAdd(&(bar)[XB_TMO], 1u); break; } } } } while (0)

struct XcdBarrier {
    unsigned* bar; unsigned x;
    volatile LAS unsigned* st;
};

__device__ __forceinline__ XcdBarrier xcd_barrier_post(unsigned* bar, volatile LAS unsigned* st) {
    XcdBarrier b; b.bar = bar; b.x = xb_xcc_id(); b.st = st;
    if (threadIdx.x == 0) (void)xb_add(&bar[XB_XCNT(b.x)], 1u);
    return b;
}
__device__ __forceinline__ void xcd_barrier_complete(unsigned* bar, unsigned x, unsigned& nloc, unsigned& nx) {
    const unsigned G = gridDim.x * gridDim.y * gridDim.z;
    unsigned sum, cnt, mine, sp = 0u;
    for (;;) {
        sum = 0u; cnt = 0u; mine = 0u;
#pragma unroll
        for (unsigned j = 0; j < 16; ++j) { const unsigned c = xb_ld(&bar[XB_XCNT(j)]); sum += c; cnt += (c > 0u) ? 1u : 0u; mine = (j == x) ? c : mine; }
        if (sum == G) break;
        __builtin_amdgcn_s_sleep(1);
        if ((++sp & 255u) == 0u) { if (xb_ld(&bar[XB_TMO])) break; if (sp > XB_SPIN_CAP) { atomicAdd(&bar[XB_TMO], 1u); break; } }
    }
    nloc = mine > 0u ? mine : 1u; nx = cnt > 0u ? cnt : 1u;
}

__device__ __forceinline__ void xcd_barrier(const XcdBarrier& b) {
    asm volatile("s_waitcnt vmcnt(0)" ::: "memory");
    __syncthreads();
    if (threadIdx.x == 0) {
        unsigned* bar = b.bar;
        __builtin_amdgcn_s_waitcnt(0);
        unsigned nloc = b.st[0], nx = b.st[1];
        if (nloc == 0u) { xcd_barrier_complete(bar, b.x, nloc, nx); b.st[0] = nloc; b.st[1] = nx; }
        const unsigned old = xb_add(&bar[XB_XSUB(b.x)], 1u);
        const unsigned gen = old / nloc;
        if (old + 1u == (gen + 1u) * nloc) {
            __builtin_amdgcn_fence(__ATOMIC_RELEASE, "agent");
            asm volatile("s_waitcnt vmcnt(0)" ::: "memory");
            const unsigned og = xb_add(&bar[XB_TOP], 1u);
            const unsigned tg = og / nx;
            if (og + 1u == (tg + 1u) * nx) xb_add(&bar[XB_TOPGEN], 1u);
            else XB_SPIN(xb_ld(&bar[XB_TOPGEN]) == tg, bar);
            __builtin_amdgcn_fence(__ATOMIC_ACQUIRE, "agent");
            xb_add(&bar[XB_XGEN(b.x)], 1u);
            asm volatile("s_waitcnt vmcnt(0)" ::: "memory");
        } else {
            XB_SPIN(xb_ld(&bar[XB_XGEN(b.x)]) == gen, bar);
            __builtin_amdgcn_fence(__ATOMIC_ACQUIRE, "agent");
            asm volatile("s_waitcnt vmcnt(0)" ::: "memory");
        }
    }
    __syncthreads();
}


constexpr int LDS_BYTES = 163840;
__global__ void __launch_bounds__(512, 2) fwd_kernel(Args a) {
    extern __shared__ __attribute__((aligned(16))) unsigned char lds_raw[];
    LAS unsigned char* lds = (LAS unsigned char*)lds_raw;
    const int tid = threadIdx.x, lane = tid & 63, wave = __builtin_amdgcn_readfirstlane(tid >> 6);
    const int G = gridDim.x, bx = blockIdx.x;
    const int gw = bx * 8 + wave, NGW = G * 8;
    unsigned char* ws = a.ws;
#if ONE_LAUNCH
    cg::grid_group grid = cg::this_grid();
    volatile LAS unsigned* bst = (volatile LAS unsigned*)(lds + LDS_BYTES - 16);
    if (tid < 4) bst[tid] = 0u;
    __syncthreads();
    XcdBarrier xbar = xcd_barrier_post((unsigned*)(ws + WS_BAR), bst);
#define GSYNC() xcd_barrier(xbar)
#else
#define GSYNC() do {} while (0)
#endif
#ifndef PHMASK
#define PHMASK 0x3ff
#endif
#define IN(k) (((PHMASK >> (k)) & 1) && a.ph_lo <= (k) && (k) < a.ph_hi)
#define SEAM(k) do { if (IN(k) && IN((k) + 1)) GSYNC(); } while (0)

    if (IN(0)) { p0_prologue(a, lds, gw, NGW, lane, wave); }
#if ONE_LAUNCH
    if (a.ph_hi > 1000) grid.sync();
#endif
    SEAM(0);
    if (IN(1)) {
        pg8::Gemm g{(const bf16_t*)(ws + WS_HB), (const bf16_t*)(ws + WS_WIN), RP / 256, NPROJ / 256, DM, 64};
        pg8::StaticOrder S; S.init(g.nM, g.nN, G, bx);
        EpiProj E{(bf16_t*)(ws + WS_PROJ), (const float*)(ws + WS_RSTD1), NPROJ};
        pg8::gemm_phase<EpiProj>(lds, g, S, E);
        mini_gemm<0>(lds, (const bf16_t*)(ws + WS_HB) + (size_t)RP * DM, (const bf16_t*)(ws + WS_WIN), DM, NPROJ, (bf16_t*)(ws + WS_PROJ) + (size_t)RP * NPROJ, NPROJ, (const float*)(ws + WS_RSTD1) + RP, nullptr, bx, G, tid, wave, lane);
    }
    SEAM(1);
    if (IN(2)) {
        {
            const int sb = wave >> 2, sid = tid & 255, w4 = wave & 3;
            LAS unsigned char* sl = lds + sb * SUB_LDS; LAS unsigned* bcnt = (LAS unsigned*)(sl + L_SSD_END);
            if (sid == 0) *bcnt = 0u;
            __syncthreads();
            unsigned btarget = 0u;
            const bool spread = (G == 256);
            const int ulim = spread ? NBATCH * NCHUNK * 2 : NUNITS_BC * 2, u0 = bx * 2 + sb;
            const int nk = u0 < ulim ? (ulim - u0 + 2 * G - 1) / (2 * G) : 0;
            const int sj = (spread && sb == 0 && (bx & 15) == 8) ? (bx >> 4) : -1;
            if (sb) __builtin_amdgcn_s_sleep(100);
            for (int k = 0; k < nk + (sj >= 0 ? 1 : 0); ++k) ssd_passA_unit(a, sl, k < nk ? u0 + k * 2 * G : NBATCH * NCHUNK * 2 + sj, sid, w4, lane, bcnt, btarget);
            __syncthreads();
        }
        for (int it = gw; it < NBATCH * 32 * 8; it += NGW) s5_passA_item(a, it, lane);
        const bf16_t* proj = (const bf16_t*)(ws + WS_PROJ);
        for (int i = bx * 512 + tid; i < 16 * 3 * 1024; i += G * 512) {
            const int sq = i / 3072, rem = i % 3072, k = rem >> 10, ch = rem & 1023;
            const int row = sq < 8 ? sq * SEQ + SEQ - 3 + k : RP + (sq - 8) * DSEQ + DSEQ - 3 + k;
            const float v = bf2f(proj[(size_t)row * NPROJ + 512 + ch]);
            if (sq < 8) a.out[O_CONVP + (size_t)(sq * 3 + k) * 1024 + ch] = v; else a.out[O_CONVS + (size_t)((sq - 8) * 3 + k) * 1024 + ch] = v;
        }
    }
    SEAM(2);
    if (IN(3)) {
        bf16_t* sst = (bf16_t*)(ws + WS_SST); const float* cdec = (const float*)(ws + WS_CDEC);
        for (int i = bx * 512 + tid; i < 16 * 8 * 2048; i += G * 512) {
            const int sq = i >> 14, h = (i >> 11) & 7, e4 = (i & 2047) * 4;
            const bool smp = sq >= 8; const int b = sq & 7;
            const int nch = smp ? 1 : NCHUNK, slot0 = smp ? NBATCH * NCHUNK + b : b * NCHUNK;
            f32x4 hc = (f32x4){0.f, 0.f, 0.f, 0.f};
            if (smp) hc = *(const f32x4*)(a.in[I_SSSD] + ((size_t)(b * 8 + h) * 8192 + e4));
            for (int c = 0; c < nch; ++c) {
                u32x2* p = (u32x2*)(sst + ((size_t)(slot0 + c) * 8 + h) * 8192 + e4);
                const u32x2 w = *p; const float d = cdec[(size_t)(slot0 + c) * 8 + h];
                u32x2 o; o.x = pk2(hc[0], hc[1]); o.y = pk2(hc[2], hc[3]); *p = o;
                hc[0] = hc[0] * d + bf2f(w.x & 0xffff); hc[1] = hc[1] * d + bf2f(w.x >> 16); hc[2] = hc[2] * d + bf2f(w.y & 0xffff); hc[3] = hc[3] * d + bf2f(w.y >> 16);
            }
            *(f32x4*)(a.out + (smp ? O_SSDS : O_SSDP) + ((size_t)(b * 8 + h) * 8192 + e4)) = hc;
        }
        for (int i = bx * 512 + tid; i < NBATCH * 32 * 64; i += G * 512) {
            const int b = i >> 11, g = (i >> 6) & 31, p = i & 63;
            float lbr, lbi, qr, qi; s5_lambda(a, g, p, lbr, lbi, qr, qi);
            float pr = lbr, pi = lbi;
            for (int k = 0; k < 10; ++k) { const float nr = pr * pr - pi * pi, ni = 2.f * pr * pi; pr = nr; pi = ni; }
            const float* loc = (const float*)(ws + WS_S5LOC) + (size_t)((b * 32 + g) * 8) * 128; float* hin = (float*)(ws + WS_S5HIN) + (size_t)((b * 32 + g) * 8) * 128;
            float hr = 0.f, hi = 0.f;
            for (int s = 0; s < 8; ++s) { hin[s * 128 + p] = hr; hin[s * 128 + 64 + p] = hi;
                const float nr = pr * hr - pi * hi + loc[s * 128 + p], ni = pr * hi + pi * hr + loc[s * 128 + 64 + p]; hr = nr; hi = ni; }
            a.out[O_S5REP + i] = hr; a.out[O_S5IMP + i] = hi;
        }
    }
    SEAM(3);
    if (IN(4)) {
        {
            const int sb = wave >> 2, sid = tid & 255, w4 = wave & 3;
            LAS unsigned char* sl = lds + sb * SUB_LDS; LAS unsigned* bcnt = (LAS unsigned*)(sl + L_SSD_END);
            if (sid == 0) *bcnt = 0u;
            __syncthreads();
            unsigned btarget = 0u;
            const bool spread = (G == 256);
            const int ulim = spread ? NBATCH * NCHUNK * 2 : NUNITS_BC * 2, u0 = bx * 2 + sb;
            const int nk = u0 < ulim ? (ulim - u0 + 2 * G - 1) / (2 * G) : 0;
            const int sj = (spread && sb == 0 && (bx & 15) == 8) ? (bx >> 4) : -1;
            if (sb) __builtin_amdgcn_s_sleep(100);
            for (int k = 0; k < nk + (sj >= 0 ? 1 : 0); ++k) ssd_passC_unit(a, sl, k < nk ? u0 + k * 2 * G : NBATCH * NCHUNK * 2 + sj, sid, w4, lane, bcnt, btarget);
        }
        __syncthreads();
        LAS unsigned char* wlds = lds + wave * (32 * S5_LD);
        for (int it = gw; it < NBATCH * 32 * 8 + NBATCH * 32; it += NGW) {
            if (it < NBATCH * 32 * 8) {
                const int b = it >> 8, g = (it >> 3) & 31, seg = it & 7;
                const float* hin = (const float*)(ws + WS_S5HIN) + (size_t)it * 128;
                float hr = hin[lane], hi = hin[64 + lane];
                s5_passC_run(a, wlds, b * SEQ + seg * 1024, 32, g, lane, hr, hi);
            } else {
                const int j = it - NBATCH * 32 * 8, b = j >> 5, g = j & 31;
                float hr = a.in[I_S5RE][(size_t)(b * 32 + g) * 64 + lane], hi = a.in[I_S5IM][(size_t)(b * 32 + g) * 64 + lane];
                s5_passC_run(a, wlds, RP + b * DSEQ, 1, g, lane, hr, hi);
                a.out[O_S5RES + (size_t)(b * 32 + g) * 64 + lane] = hr; a.out[O_S5IMS + (size_t)(b * 32 + g) * 64 + lane] = hi;
            }
        }
        __syncthreads();
    }
    SEAM(4);
    if (IN(5)) {
        pg8::Gemm g{(const bf16_t*)(ws + WS_MIXIN), (const bf16_t*)(ws + WS_WOUT), RP / 256, DM / 256, DM, 64};
        pg8::StaticOrder S; S.init(g.nM, g.nN, G, bx);
        EpiSq E{(bf16_t*)(ws + WS_MIX), (float*)(ws + WS_SUMSQ2), DM};
        pg8::gemm_phase<EpiSq>(lds, g, S, E);
        mini_gemm<1>(lds, (const bf16_t*)(ws + WS_MIXIN) + (size_t)RP * DM, (const bf16_t*)(ws + WS_WOUT), DM, DM, (bf16_t*)(ws + WS_MIX) + (size_t)RP * DM, DM, nullptr, (float*)(ws + WS_SUMSQ2) + RP, bx, G, tid, wave, lane);
    }
    SEAM(5);
    if (IN(6)) {
        const bf16_t* mix = (const bf16_t*)(ws + WS_MIX); const float* s2 = (const float*)(ws + WS_SUMSQ2); bf16_t* hb = (bf16_t*)(ws + WS_HB); float* rstd3 = (float*)(ws + WS_RSTD3);
        const float* pw = a.in[I_POSTMIX];
        f32x4 w4[4];
#pragma unroll
        for (int q = 0; q < 4; ++q) w4[q] = *(const f32x4*)(pw + q * 256 + lane * 4);
        for (int row0 = 2 * gw; row0 < R; row0 += 2 * NGW) {
            f32x4 xv[2][4]; u32x2 mm[2][4]; float rs[2];
#pragma unroll
            for (int rr = 0; rr < 2; ++rr) { const int row = row0 + rr;
                rs[rr] = s2[row];
#pragma unroll
                for (int q = 0; q < 4; ++q) { const u32x2 xx = *(const u32x2*)(hb + (size_t)row * DM + q * 256 + lane * 4);
                    xv[rr][q][0] = bf2f(xx.x & 0xffff); xv[rr][q][1] = bf2f(xx.x >> 16); xv[rr][q][2] = bf2f(xx.y & 0xffff); xv[rr][q][3] = bf2f(xx.y >> 16);
                    mm[rr][q] = *(const u32x2*)(mix + (size_t)row * DM + q * 256 + lane * 4); } }
#pragma unroll
            for (int rr = 0; rr < 2; ++rr) { const int row = row0 + rr;
                const float r_ = 1.f / sqrtf(rs[rr] * (1.f / DM) + EPS);
                float ss = 0.f; f32x4 hv[4];
#pragma unroll
                for (int q = 0; q < 4; ++q) { const u32x2 m2 = mm[rr][q];
                    hv[q][0] = xv[rr][q][0] + bf2f(m2.x & 0xffff) * r_ * w4[q][0]; hv[q][1] = xv[rr][q][1] + bf2f(m2.x >> 16) * r_ * w4[q][1]; hv[q][2] = xv[rr][q][2] + bf2f(m2.y & 0xffff) * r_ * w4[q][2]; hv[q][3] = xv[rr][q][3] + bf2f(m2.y >> 16) * r_ * w4[q][3];
                    ss += (hv[q][0] * hv[q][0] + hv[q][1] * hv[q][1]) + (hv[q][2] * hv[q][2] + hv[q][3] * hv[q][3]); }
                ss = wave_sum(ss);
#pragma unroll
                for (int q = 0; q < 4; ++q) { u32x2 w; w.x = pk2(hv[q][0], hv[q][1]); w.y = pk2(hv[q][2], hv[q][3]); *(u32x2*)(hb + (size_t)row * DM + q * 256 + lane * 4) = w; }
                if (lane == 0) rstd3[row] = 1.f / sqrtf(ss * (1.f / DM) + EPS); }
        }
    }
    SEAM(6);
    if (IN(7)) {
        constexpr int nM = (R + 247) / 248;
        pg8::Gemm g{(const bf16_t*)(ws + WS_HB) - 2 * DM, (const bf16_t*)(ws + WS_WUP), nM, NUP / 256, DM, 62};
        pg8::StaticOrder S; S.init(g.nM, g.nN, G, bx);
        const int nfull = (nM * (NUP / 256)) % G;
        EpiUp E{(bf16_t*)(ws + WS_ACT), (const float*)(ws + WS_RSTD3), a.in[I_FCW], a.in[I_FCB], a.in[I_CFFN], a.out + O_FFNP, a.out + O_FFNS, lds + 131072};
        pg8::gemm_phase<EpiUp>(lds, g, S, E);
        if (nfull == 0 || G - nfull < 8) up_fixup(a, lds, bx, G, tid, wave, lane);
        else if (bx >= nfull) up_fixup(a, lds, bx - nfull, G - nfull, tid, wave, lane);
    }
    SEAM(7);
    if (IN(8)) {
        pg8::Gemm g{(const bf16_t*)(ws + WS_ACT), (const bf16_t*)(ws + WS_WDOWN), RP / 256, DM / 256, DFF, 64};
        pg8::StaticOrder S; S.init(g.nM, g.nN, G, bx);
        EpiSq E{(bf16_t*)(ws + WS_FFN), (float*)(ws + WS_SUMSQ4), DM};
        pg8::gemm_phase<EpiSq>(lds, g, S, E);
        mini_gemm<1>(lds, (const bf16_t*)(ws + WS_ACT) + (size_t)RP * DFF, (const bf16_t*)(ws + WS_WDOWN), DFF, DM, (bf16_t*)(ws + WS_FFN) + (size_t)RP * DM, DM, nullptr, (float*)(ws + WS_SUMSQ4) + RP, bx, G, tid, wave, lane);
    }
    SEAM(8);
    if (IN(9)) {
        const bf16_t* ffn = (const bf16_t*)(ws + WS_FFN); const float* s4 = (const float*)(ws + WS_SUMSQ4); const bf16_t* hb = (const bf16_t*)(ws + WS_HB);
        const float* pw = a.in[I_POSTFFN];
        f32x4 w4[4];
#pragma unroll
        for (int q = 0; q < 4; ++q) w4[q] = *(const f32x4*)(pw + q * 256 + lane * 4);
        for (int row0 = 2 * gw; row0 < R; row0 += 2 * NGW) {
            u32x2 hh[2][4], mm[2][4]; float rs[2];
#pragma unroll
            for (int rr = 0; rr < 2; ++rr) { const int row = row0 + rr; rs[rr] = s4[row];
#pragma unroll
                for (int q = 0; q < 4; ++q) { hh[rr][q] = *(const u32x2*)(hb + (size_t)row * DM + q * 256 + lane * 4); mm[rr][q] = *(const u32x2*)(ffn + (size_t)row * DM + q * 256 + lane * 4); } }
#pragma unroll
            for (int rr = 0; rr < 2; ++rr) { const int row = row0 + rr;
                float* yr = row < RP ? a.out + O_YP + (size_t)row * DM : a.out + O_YS + (size_t)(row - RP) * DM;
                const float r_ = 1.f / sqrtf(rs[rr] * (1.f / DM) + EPS);
#pragma unroll
                for (int q = 0; q < 4; ++q) { const u32x2 h2 = hh[rr][q], m2 = mm[rr][q];
                    f32x4 o; o[0] = bf2f(h2.x & 0xffff) + bf2f(m2.x & 0xffff) * r_ * w4[q][0]; o[1] = bf2f(h2.x >> 16) + bf2f(m2.x >> 16) * r_ * w4[q][1];
                    o[2] = bf2f(h2.y & 0xffff) + bf2f(m2.y & 0xffff) * r_ * w4[q][2]; o[3] = bf2f(h2.y >> 16) + bf2f(m2.y >> 16) * r_ * w4[q][3];
                    __builtin_nontemporal_store(o, (f32x4*)(yr + q * 256 + lane * 4)); } }
        }
    }
}

constexpr int NPHASE = 10;
extern "C" void kernel_launch(void* const* d_in, const int* in_sizes, int n_in, void* d_out, int out_size, void* d_ws, size_t ws_size, hipStream_t stream) {
    static int grid = 0;
    if (grid == 0) {
        if (n_in != 33 || ws_size < WS_END) { fprintf(stderr, "kernel_launch: unexpected n_in %d / ws %zu\n", n_in, ws_size); grid = -1; return; }
        int dev = 0, cus = 0, per_cu = 0;
        hipGetDevice(&dev); hipDeviceGetAttribute(&cus, hipDeviceAttributeMultiprocessorCount, dev);
        hipFuncSetAttribute((const void*)fwd_kernel, hipFuncAttributeMaxDynamicSharedMemorySize, LDS_BYTES);
        hipOccupancyMaxActiveBlocksPerMultiprocessor(&per_cu, (const void*)fwd_kernel, 512, LDS_BYTES);
        (void)hipGetLastError();
        if (per_cu < 1) per_cu = 1;
        grid = cus * 1;
    }
    if (grid < 0) return;
    Args a{};
    for (int i = 0; i < 33; ++i) a.in[i] = (const float*)d_in[i];
    a.out = (float*)d_out; a.ws = (unsigned char*)d_ws;
#if ONE_LAUNCH
    (void)hipMemsetAsync((char*)d_ws + WS_BAR, 0, 16384, stream);
    a.ph_lo = 0; a.ph_hi = NPHASE;
    void* args[] = {&a};
    hipError_t e = hipLaunchCooperativeKernel((const void*)fwd_kernel, dim3(grid), dim3(512), args, LDS_BYTES, stream);
    if (e != hipSuccess) fprintf(stderr, "cooperative launch failed: %s (grid %d)\n", hipGetErrorString(e), grid);
#else
#ifndef DUPMASK
#define DUPMASK 0
#endif
    for (int p = 0; p < NPHASE; ++p) { a.ph_lo = p; a.ph_hi = p + 1; for (int rep = 0; rep < (((DUPMASK >> p) & 1) ? 2 : 1); ++rep) hipLaunchKernelGGL(fwd_kernel, dim3(grid), dim3(512), LDS_BYTES, stream, a); }
#endif
}
```

```cpp
#include <hip/hip_runtime.h>
#include <hip/hip_cooperative_groups.h>
#include <cstdio>
namespace cg = cooperative_groups;

#ifndef ONE_LAUNCH
#define ONE_LAUNCH 1
#endif

#define LAS __attribute__((address_space(3)))
typedef unsigned short bf16_t;
typedef short bf16x8 __attribute__((ext_vector_type(8)));
typedef short bf16x4 __attribute__((ext_vector_type(4)));
typedef float f32x4 __attribute__((ext_vector_type(4)));
typedef float f32x16 __attribute__((ext_vector_type(16)));
typedef unsigned u32x4 __attribute__((ext_vector_type(4)));
typedef unsigned u32x2 __attribute__((ext_vector_type(2)));

constexpr int DM = 1024, SEQ = 8192, NBATCH = 8, DSEQ = 32;
constexpr int RP = NBATCH * SEQ;
constexpr int RS = NBATCH * DSEQ;
constexpr int R = RP + RS;
constexpr int NPROJ = 2048;
constexpr int DFF = 2816, NUP = 5632;
constexpr int NCHUNK = 128;
constexpr int NUNITS_BC = NBATCH * NCHUNK + NBATCH;
constexpr float EPS = 1e-6f;

constexpr size_t MiB = 1u << 20;
constexpr size_t WS_BAR = 512 * 1024;
constexpr size_t WS_WDT = 0;
constexpr size_t WS_RSTD1 = 1 * MiB, WS_SUMSQ2 = 1 * MiB + 512 * 1024, WS_RSTD3 = 2 * MiB, WS_SUMSQ4 = 2 * MiB + 512 * 1024;
constexpr size_t WS_DTV = 3 * MiB;
constexpr size_t WS_CDEC = 6 * MiB;
constexpr size_t WS_S5LOC = 7 * MiB, WS_S5HIN = 8 * MiB;
constexpr size_t WS_WIN = 10 * MiB, WS_WOUT = 14 * MiB, WS_WUP = 16 * MiB, WS_WDOWN = 28 * MiB;
constexpr size_t WS_HB = 36 * MiB;
constexpr size_t WS_PROJ = 168 * MiB;
constexpr size_t WS_SST = 426 * MiB;
constexpr size_t WS_MIXIN = 556 * MiB;
constexpr size_t WS_MIX = 686 * MiB;
constexpr size_t WS_ACT = 168 * MiB;
constexpr size_t WS_FFN = 556 * MiB;
constexpr size_t WS_END = 816 * MiB;

constexpr size_t O_YP = 0, O_YS = O_YP + (size_t)RP * DM, O_CONVP = O_YS + (size_t)RS * DM, O_SSDP = O_CONVP + 8 * 3 * 1024,
                 O_S5REP = O_SSDP + 8 * 8 * 64 * 128, O_S5IMP = O_S5REP + 8 * 32 * 64, O_FFNP = O_S5IMP + 8 * 32 * 64,
                 O_CONVS = O_FFNP + 8 * 2 * NUP, O_SSDS = O_CONVS + 8 * 3 * 1024, O_S5RES = O_SSDS + 8 * 8 * 64 * 128,
                 O_S5IMS = O_S5RES + 8 * 32 * 64, O_FFNS = O_S5IMS + 8 * 32 * 64;

struct Args {
    const float* in[33];
    float* out; unsigned char* ws;
    int ph_lo, ph_hi;
};
enum { I_XP = 0, I_XS, I_CSSD, I_SSSD, I_S5RE, I_S5IM, I_CFFN, I_PREMIX, I_WIN, I_SCW, I_SCB, I_DTB, I_ALOG, I_SSDD, I_SNW,
       I_LRE, I_LIM, I_LDT, I_BRE, I_BIM, I_CRE, I_CIM, I_S5D, I_GLUW, I_GLUB, I_WOUT, I_POSTMIX, I_PREFFN, I_WUP, I_FCW, I_FCB, I_WDOWN, I_POSTFFN };

__device__ __forceinline__ float bf2f(unsigned v) { return __uint_as_float(v << 16); }
__device__ __forceinline__ unsigned f2bf(float f) { unsigned u = __float_as_uint(f); return (u + 0x7fffu + ((u >> 16) & 1u)) >> 16; }
typedef __bf16 hwbf2 __attribute__((ext_vector_type(2)));
typedef float f32x2 __attribute__((ext_vector_type(2)));
__device__ __forceinline__ unsigned pk2(float lo, float hi) { f32x2 v; v.x = lo; v.y = hi; return __builtin_bit_cast(unsigned, __builtin_convertvector(v, hwbf2)); }
template <int CTRL, int RM> __device__ __forceinline__ float dpp_get(float v) { return __builtin_bit_cast(float, __builtin_amdgcn_update_dpp(0, __builtin_bit_cast(int, v), CTRL, RM, 0xF, false)); }
__device__ __forceinline__ float wave_sum(float v) {
    v += dpp_get<0xB1, 0xF>(v);
    v += dpp_get<0x4E, 0xF>(v);
    v += dpp_get<0x141, 0xF>(v);
    v += dpp_get<0x140, 0xF>(v);
    v += dpp_get<0x142, 0xA>(v);
    v += dpp_get<0x143, 0xC>(v);
    return __builtin_bit_cast(float, __builtin_amdgcn_readlane(__builtin_bit_cast(int, v), 63));
}
__device__ __forceinline__ float silu_f(float v) { return v * __builtin_amdgcn_rcpf(1.f + __builtin_amdgcn_exp2f(-1.4426950409f * v)); }
__device__ __forceinline__ float gelu_tanh(float v) {
    const float w = v * (-2.3022082f + -0.1029432f * (v * v));
    return v * __builtin_amdgcn_rcpf(1.f + __builtin_amdgcn_exp2f(w));
}

namespace pg8 {
constexpr int BM = 256, BK = 64, HALF = 128, HTB = HALF * BK * 2, STAGE_BYTES = 8 * HTB, NXCD = 8, WGM = 8;
__host__ __device__ __forceinline__ int lds_byte(int r, int c) { const int st = (r >> 4) * 2 + (c >> 5), rr = r & 15, cc = c & 31, ob = rr * 64 + cc * 2; return st * 1024 + (ob ^ (((ob >> 9) & 1) << 5)); }
__host__ __device__ __forceinline__ void stage_rc(int b, int& R_, int& C) { const int st = b / 1024, sb = b % 1024, swz = sb ^ (((sb >> 9) & 1) << 5); R_ = (st >> 1) * 16 + swz / 64; C = (st & 1) * 32 + (swz % 64) / 2; }
__host__ __device__ __forceinline__ int perm32(int rho) { const int n = rho >> 4, i = rho & 15; return 8 * (i >> 2) + 4 * n + (i & 3); }
struct Unit { int pm, pn; };
struct Gemm { const bf16_t* A; const bf16_t* Bt; int nM, nN, K, rp64; };
struct StaticOrder {
    int nM, nN, nwg, G, c;
    __device__ void init(int nM_, int nN_, int G_, int c_) { nM = nM_; nN = nN_; nwg = nM * nN; G = G_; c = c_; }
    __device__ bool next(int i, Unit& u) const {
        const long L = (long)i * G + c; if (L >= nwg) return false;
        int wgid = (int)L; { const int q = nwg / NXCD, r = nwg % NXCD, xcd = wgid % NXCD, off = wgid / NXCD; wgid = (xcd < r ? xcd * (q + 1) : r * (q + 1) + (xcd - r) * q) + off; }
        const int nig = WGM * nN, gid = wgid / nig, fm = gid * WGM, gsz = (nM - fm) < WGM ? (nM - fm) : WGM;
        u.pm = fm + ((wgid % nig) % gsz); u.pn = (wgid % nig) / gsz; return true;
    }
};

template <class Epi>
__device__ __forceinline__ void gemm_phase(LAS unsigned char* lds, const Gemm g, const StaticOrder& S, const Epi& E) {
    const int tid = threadIdx.x, wid = __builtin_amdgcn_readfirstlane(tid >> 6), lane = tid & 63, wr = wid >> 2, wc = wid & 3, fr = lane & 15, fq = lane >> 4;
    const int K = g.K, nt = K / BK;
    unsigned voffA[2], voffB[2];
#pragma unroll
    for (int i = 0; i < 2; ++i) { int R_, C; stage_rc(tid * 16 + i * 8192, R_, C); const int Rb = Epi::PERM ? ((R_ & ~31) + perm32(R_ & 31)) : R_;
        const int Ra = (R_ >> 6) * g.rp64 + (R_ & 63);
        voffA[i] = (unsigned)(Ra * K + C) * 2u; voffB[i] = (unsigned)(Rb * K + C) * 2u; }
    const size_t kstep = (size_t)(BK * 2);
    const size_t hstepB = (size_t)HALF * K * 2, tstepB = 2 * hstepB;
    const size_t hstepA = (size_t)2 * g.rp64 * K * 2, tstepA = 2 * hstepA;
    const unsigned ldsw = (unsigned)wid * 1024u;
    const int aoff = lds_byte(wr * 64 + fr, fq * 8), boff = lds_byte(wc * 32 + fr, fq * 8);
#define PG8_SA(b, h) (((b) * 2 + (h)) * HTB)
#define PG8_SB(b, h) ((4 + (b) * 2 + (h)) * HTB)
#define PG8_STAGE(bufoff, gbase, voff) do { _Pragma("unroll") for (int _i = 0; _i < 2; ++_i) \
        __builtin_amdgcn_global_load_lds((const unsigned*)((const char*)(gbase) + (voff)[_i]), (LAS unsigned*)(lds + (bufoff) + ldsw + _i * 8192), 16, 0, 0); } while (0)
#define PG8_LDA(dst, b, h) do { _Pragma("unroll") for (int m = 0; m < 4; ++m) _Pragma("unroll") for (int k = 0; k < 2; ++k) dst[m][k] = *(const LAS bf16x8*)(lds + PG8_SA(b, h) + aoff + m * 2048 + k * 1024); } while (0)
#define PG8_LDB(dst, b, h) do { _Pragma("unroll") for (int n = 0; n < 2; ++n) _Pragma("unroll") for (int k = 0; k < 2; ++k) dst[n][k] = *(const LAS bf16x8*)(lds + PG8_SB(b, h) + boff + n * 2048 + k * 1024); } while (0)
#define PG8_MMA(ai, bj, At, Bt) do { __builtin_amdgcn_s_setprio(1); _Pragma("unroll") for (int m = 0; m < 4; ++m) _Pragma("unroll") for (int n = 0; n < 2; ++n) _Pragma("unroll") for (int k = 0; k < 2; ++k) \
        acc[ai][bj][m][n] = __builtin_amdgcn_mfma_f32_16x16x32_bf16(Bt[n][k], At[m][k], acc[ai][bj][m][n], 0, 0, 0); __builtin_amdgcn_s_setprio(0); } while (0)
#define PG8_WAIT_V(n) asm volatile("s_waitcnt vmcnt(" #n ")" ::: "memory")
#define PG8_WAIT_L(n) asm volatile("s_waitcnt lgkmcnt(" #n ")" ::: "memory")
#define PG8_BAR __builtin_amdgcn_s_barrier()
#define PG8_SCHED __builtin_amdgcn_sched_barrier(0)
    Unit cur, nxt; int ui = 0;
    if (!S.next(0, cur)) return;
    f32x4 acc[2][2][4][2];
#pragma unroll
    for (int a = 0; a < 2; ++a)
#pragma unroll
        for (int b = 0; b < 2; ++b)
#pragma unroll
            for (int m = 0; m < 4; ++m)
#pragma unroll
                for (int n = 0; n < 2; ++n) acc[a][b][m][n] = (f32x4){0.f, 0.f, 0.f, 0.f};
    bf16x8 At[4][2], B0[2][2], B1[2][2];
    const char* cA = (const char*)g.A + (size_t)cur.pm * tstepA; const char* cB = (const char*)g.Bt + (size_t)cur.pn * tstepB;
    PG8_STAGE(PG8_SB(0, 0), cB, voffB); PG8_STAGE(PG8_SA(0, 0), cA, voffA); PG8_STAGE(PG8_SB(0, 1), cB + hstepB, voffB); PG8_STAGE(PG8_SA(0, 1), cA + hstepA, voffA);
    if (wr == 1) PG8_BAR;
    PG8_WAIT_V(4); PG8_BAR;
    PG8_STAGE(PG8_SB(1, 0), cB + kstep, voffB); PG8_STAGE(PG8_SA(1, 0), cA + kstep, voffA); PG8_STAGE(PG8_SB(1, 1), cB + hstepB + kstep, voffB);
    PG8_WAIT_V(6); PG8_BAR;
    for (;;) {
        const bool has_next = S.next(ui + 1, nxt);
        const char* nA = has_next ? (const char*)g.A + (size_t)nxt.pm * tstepA : cA; const char* nB = has_next ? (const char*)g.Bt + (size_t)nxt.pn * tstepB : cB;
        for (int t = 0; t < nt; t += 2) {
            const bool last = (t == nt - 2);
            const char* a1 = cA + (size_t)(t + 1) * kstep;
            const char* a2 = last ? nA : cA + (size_t)(t + 2) * kstep; const char* b2 = last ? nB : cB + (size_t)(t + 2) * kstep;
            const char* a3 = a2 + kstep; const char* b3 = b2 + kstep;
            PG8_LDB(B0, 0, 0); PG8_SCHED; PG8_LDA(At, 0, 0); PG8_STAGE(PG8_SA(1, 1), a1 + hstepA, voffA);
            PG8_WAIT_L(8); PG8_BAR; PG8_WAIT_L(0); PG8_MMA(0, 0, At, B0); PG8_BAR; PG8_SCHED;
            PG8_LDB(B1, 0, 1); PG8_STAGE(PG8_SB(0, 0), b2, voffB);
            PG8_BAR; PG8_WAIT_L(0); PG8_MMA(0, 1, At, B1); PG8_BAR;
            PG8_LDA(At, 0, 1); PG8_STAGE(PG8_SA(0, 0), a2, voffA);
            PG8_BAR; PG8_WAIT_L(0); PG8_MMA(1, 0, At, B0); PG8_BAR; PG8_SCHED;
            PG8_STAGE(PG8_SB(0, 1), b2 + hstepB, voffB);
            PG8_WAIT_V(6); PG8_BAR; PG8_MMA(1, 1, At, B1); PG8_BAR;
            PG8_LDB(B0, 1, 0); PG8_SCHED; PG8_LDA(At, 1, 0); PG8_STAGE(PG8_SA(0, 1), a2 + hstepA, voffA);
            PG8_WAIT_L(8); PG8_BAR; PG8_WAIT_L(0); PG8_MMA(0, 0, At, B0); PG8_BAR; PG8_SCHED;
            PG8_LDB(B1, 1, 1); PG8_STAGE(PG8_SB(1, 0), b3, voffB);
            PG8_BAR; PG8_WAIT_L(0); PG8_MMA(0, 1, At, B1); PG8_BAR;
            PG8_LDA(At, 1, 1); PG8_STAGE(PG8_SA(1, 0), a3, voffA);
            PG8_BAR; PG8_WAIT_L(0); PG8_MMA(1, 0, At, B0); PG8_BAR; PG8_SCHED;
            PG8_STAGE(PG8_SB(1, 1), b3 + hstepB, voffB);
            PG8_WAIT_V(6); PG8_BAR; PG8_MMA(1, 1, At, B1); PG8_BAR;
        }
        E(acc, cur, wr, wc, fr, fq);
        if (!has_next) break;
#pragma unroll
        for (int a = 0; a < 2; ++a)
#pragma unroll
            for (int b = 0; b < 2; ++b)
#pragma unroll
                for (int m = 0; m < 4; ++m)
#pragma unroll
                    for (int n = 0; n < 2; ++n) acc[a][b][m][n] = (f32x4){0.f, 0.f, 0.f, 0.f};
        cur = nxt; cA = nA; cB = nB; ++ui;
    }
    PG8_WAIT_V(0);
    if (wr == 0) PG8_BAR;
    PG8_BAR;
#undef PG8_SA
#undef PG8_SB
#undef PG8_STAGE
#undef PG8_LDA
#undef PG8_LDB
#undef PG8_MMA
#undef PG8_WAIT_V
#undef PG8_WAIT_L
#undef PG8_BAR
#undef PG8_SCHED
}
}

struct EpiProj {
    static constexpr bool PERM = true;
    bf16_t* O; const float* rstd; int ldc;
    __device__ __forceinline__ void operator()(const f32x4 (&acc)[2][2][4][2], const pg8::Unit& u, int wr, int wc, int fr, int fq) const {
        const int row0 = u.pm * 256 + wr * 64 + fr, col0 = u.pn * 256 + wc * 32 + 8 * fq;
#pragma unroll
        for (int ai = 0; ai < 2; ++ai)
#pragma unroll
            for (int m = 0; m < 4; ++m) { const int row = row0 + ai * 128 + m * 16; const float s = rstd[row]; bf16_t* rowp = O + (size_t)row * ldc + col0;
#pragma unroll
                for (int bj = 0; bj < 2; ++bj) { const f32x4 v0 = acc[ai][bj][m][0] * s, v1 = acc[ai][bj][m][1] * s;
                    u32x4 w; w.x = pk2(v0[0], v0[1]); w.y = pk2(v0[2], v0[3]); w.z = pk2(v1[0], v1[1]); w.w = pk2(v1[2], v1[3]);
                    *(u32x4*)(rowp + bj * 128) = w; } }
    }
};
struct EpiSq {
    static constexpr bool PERM = true;
    bf16_t* O; float* sumsq; int ldc;
    __device__ __forceinline__ void operator()(const f32x4 (&acc)[2][2][4][2], const pg8::Unit& u, int wr, int wc, int fr, int fq) const {
        const int row0 = u.pm * 256 + wr * 64 + fr, col0 = u.pn * 256 + wc * 32 + 8 * fq;
#pragma unroll
        for (int ai = 0; ai < 2; ++ai)
#pragma unroll
            for (int m = 0; m < 4; ++m) { const int row = row0 + ai * 128 + m * 16; bf16_t* rowp = O + (size_t)row * ldc + col0; float ss = 0.f;
#pragma unroll
                for (int bj = 0; bj < 2; ++bj) { const f32x4 v0 = acc[ai][bj][m][0], v1 = acc[ai][bj][m][1];
                    ss += (v0[0] * v0[0] + v0[1] * v0[1]) + (v0[2] * v0[2] + v0[3] * v0[3]) + (v1[0] * v1[0] + v1[1] * v1[1]) + (v1[2] * v1[2] + v1[3] * v1[3]);
                    u32x4 w; w.x = pk2(v0[0], v0[1]); w.y = pk2(v0[2], v0[3]); w.z = pk2(v1[0], v1[1]); w.w = pk2(v1[2], v1[3]);
                    *(u32x4*)(rowp + bj * 128) = w; }
                ss += __shfl_xor(ss, 16); ss += __shfl_xor(ss, 32);
                if (fq == 0) atomicAdd(sumsq + row, ss); }
    }
};
constexpr int SLAB_LD = 40, SLAB_BYTES = 64 * SLAB_LD;
struct EpiUp {
    static constexpr bool PERM = true;
    bf16_t* act; const float* rstd3; const float* cw; const float* cb; const float* cache; float* outp; float* outs; LAS unsigned char* xl;
    __device__ __forceinline__ void operator()(const f32x4 (&acc)[2][2][4][2], const pg8::Unit& u, int wr, int wc, int fr_, int fq_) const {
        int fr = fr_, fq = fq_; asm volatile("" : "+v"(fr), "+v"(fq));
        LAS unsigned char* slab = xl + (wr * 4 + wc) * SLAB_BYTES;
        const int lane = fq * 16 + fr, cq = lane & 3, rs = lane >> 2;
        const int j0 = u.pn * 128 + wc * 32 + 8 * cq;
        float sc[2][4];
#pragma unroll
        for (int ai = 0; ai < 2; ++ai)
#pragma unroll
            for (int m = 0; m < 4; ++m) { const int row = 248 * u.pm + 62 * (2 * ai + wr) - 2 + 16 * m + fr; sc[ai][m] = (row >= 0 && row < R) ? rstd3[row] : 0.f; }
        f32x4 wn[4];
        { const int colb = j0; wn[0] = *(const f32x4*)(cw + colb); wn[1] = *(const f32x4*)(cw + NUP + colb); wn[2] = *(const f32x4*)(cw + 2 * NUP + colb); wn[3] = *(const f32x4*)(cb + colb); }
        float cgv[4][4];
#pragma unroll
        for (int sp = 0; sp < 8; ++sp) {
            const int ai = sp >> 2, n = (sp >> 1) & 1, bj = sp & 1;
            const int rowbase = 248 * u.pm + 62 * (2 * ai + wr) - 2;
            const f32x4 w0 = wn[0], w1 = wn[1], w2 = wn[2], bb = wn[3];
            if (sp < 7) { const int sq = sp + 1, n2 = (sq >> 1) & 1, bj2 = sq & 1, colb = bj2 * DFF + j0 + 4 * n2;
                wn[0] = *(const f32x4*)(cw + colb); wn[1] = *(const f32x4*)(cw + NUP + colb); wn[2] = *(const f32x4*)(cw + 2 * NUP + colb); wn[3] = *(const f32x4*)(cb + colb); }
#pragma unroll
            for (int m = 0; m < 4; ++m) { const f32x4 v = acc[ai][bj][m][n] * sc[ai][m];
                u32x2 w; w.x = pk2(v[0], v[1]); w.y = pk2(v[2], v[3]); *(LAS u32x2*)(slab + (16 * m + fr) * SLAB_LD + fq * 8) = w; }
            f32x4 p2, p1;
            { const int h1 = rs > 0 ? 4 * rs - 1 : 0, h2 = rs > 0 ? 4 * rs - 2 : 0;
                const u32x2 q1 = *(const LAS u32x2*)(slab + h1 * SLAB_LD + cq * 8), q2 = *(const LAS u32x2*)(slab + h2 * SLAB_LD + cq * 8);
                p1[0] = bf2f(q1.x & 0xffff); p1[1] = bf2f(q1.x >> 16); p1[2] = bf2f(q1.y & 0xffff); p1[3] = bf2f(q1.y >> 16);
                p2[0] = bf2f(q2.x & 0xffff); p2[1] = bf2f(q2.x >> 16); p2[2] = bf2f(q2.y & 0xffff); p2[3] = bf2f(q2.y >> 16); }
#pragma unroll
            for (int i = 0; i < 4; ++i) {
                const int lr = 4 * rs + i, row = rowbase + lr;
                const u32x2 q0 = *(const LAS u32x2*)(slab + lr * SLAB_LD + cq * 8);
                f32x4 cur; cur[0] = bf2f(q0.x & 0xffff); cur[1] = bf2f(q0.x >> 16); cur[2] = bf2f(q0.y & 0xffff); cur[3] = bf2f(q0.y >> 16);
                const bool smp = row >= RP;
                const int t = smp ? ((row - RP) & (DSEQ - 1)) : (row & (SEQ - 1));
                const bool valid = (lr >= 2) && (row < R) && (t >= 2);
                const f32x4 cv = bb + w0 * p2 + w1 * p1 + w2 * cur;
                p2 = p1; p1 = cur;
                if (bj == 0) { cgv[i][0] = cv[0]; cgv[i][1] = cv[1]; cgv[i][2] = cv[2]; cgv[i][3] = cv[3]; }
                else { u32x2 w; w.x = pk2(gelu_tanh(cgv[i][0]) * cv[0], gelu_tanh(cgv[i][1]) * cv[1]); w.y = pk2(gelu_tanh(cgv[i][2]) * cv[2], gelu_tanh(cgv[i][3]) * cv[3]); if (valid) *(u32x2*)(act + (size_t)row * DFF + j0 + 4 * n) = w; }
            }
        }
    }
};

template <int MODE>
__device__ __forceinline__ void mini_gemm(LAS unsigned char* lds, const bf16_t* A, const bf16_t* Bt, int K, int N, bf16_t* O, int ldc, const float* rstd, float* sumsq, int bx, int G, int tid, int wave, int lane) {
    const int r = lane & 31, hf = lane >> 5, ntn = N >> 5, ntiles = 8 * ntn, kw = K >> 3;
    LAS float* red = (LAS float*)lds;
    for (int tile = bx; tile < ntiles; tile += G) {
        const int m0 = (tile / ntn) * 32, n0 = (tile % ntn) * 32;
        const bf16_t* ap = A + (size_t)(m0 + r) * K + wave * kw + 8 * hf; const bf16_t* bp = Bt + (size_t)(n0 + r) * K + wave * kw + 8 * hf;
        f32x16 acc; for (int i = 0; i < 16; ++i) acc[i] = 0.f;
        for (int k = 0; k < kw; k += 16) { const bf16x8 af = *(const bf16x8*)(ap + k), bf = *(const bf16x8*)(bp + k); acc = __builtin_amdgcn_mfma_f32_32x32x16_bf16(af, bf, acc, 0, 0, 0); }
        __syncthreads();
#pragma unroll
        for (int i = 0; i < 16; ++i) red[(wave * 16 + i) * 64 + lane] = acc[i];
        __syncthreads();
#pragma unroll
        for (int h2 = 0; h2 < 2; ++h2) {
            const int e = tid + h2 * 512, i = e >> 6, ln = e & 63;
            float v = 0.f;
#pragma unroll
            for (int w = 0; w < 8; ++w) v += red[(w * 16 + i) * 64 + ln];
            const int row = m0 + (i & 3) + 8 * (i >> 2) + 4 * (ln >> 5), col = n0 + (ln & 31);
            if (MODE == 0) { O[(size_t)row * ldc + col] = (bf16_t)f2bf(v * rstd[row]); }
            else { O[(size_t)row * ldc + col] = (bf16_t)f2bf(v); float ss = v * v;
#pragma unroll
                for (int o = 1; o < 32; o <<= 1) ss += __shfl_xor(ss, o);
                if ((ln & 31) == 0) atomicAdd(sumsq + row, ss); }
        }
    }
    __syncthreads();
}

__device__ __forceinline__ int fix_row(int m) { const int sq = m >> 2, k4 = m & 3; return sq < 8 ? sq * SEQ + (k4 < 2 ? k4 : SEQ - 4 + k4) : RP + (sq - 8) * DSEQ + (k4 < 2 ? k4 : DSEQ - 4 + k4); }
__device__ __forceinline__ void up_fixup(const Args& a, LAS unsigned char* lds, int bx, int G, int tid, int wave, int lane) {
    const int r = lane & 31, hf = lane >> 5;
    LAS float* red = (LAS float*)lds;
    LAS float* tile = (LAS float*)(lds + 65536);
    const bf16_t* hb = (const bf16_t*)(a.ws + WS_HB); const bf16_t* W = (const bf16_t*)(a.ws + WS_WUP); const float* rstd3 = (const float*)(a.ws + WS_RSTD3);
    for (int item = bx; item < 176; item += G) {
        const int mt = item / 88, cp = item % 88, pn = cp >> 2, sub = cp & 3;
        const bf16_t* ap = hb + (size_t)fix_row(mt * 32 + r) * DM + wave * 128 + 8 * hf;
        const bf16_t* bg = W + (size_t)(256 * pn + 32 * sub + r) * DM + wave * 128 + 8 * hf; const bf16_t* bv = bg + (size_t)128 * DM;
        f32x16 ag, av; for (int i = 0; i < 16; ++i) { ag[i] = 0.f; av[i] = 0.f; }
#pragma unroll
        for (int k = 0; k < 128; k += 16) { const bf16x8 af = *(const bf16x8*)(ap + k); ag = __builtin_amdgcn_mfma_f32_32x32x16_bf16(af, *(const bf16x8*)(bg + k), ag, 0, 0, 0); av = __builtin_amdgcn_mfma_f32_32x32x16_bf16(af, *(const bf16x8*)(bv + k), av, 0, 0, 0); }
        __syncthreads();
#pragma unroll
        for (int i = 0; i < 16; ++i) { red[((wave * 2 + 0) * 16 + i) * 64 + lane] = ag[i]; red[((wave * 2 + 1) * 16 + i) * 64 + lane] = av[i]; }
        __syncthreads();
#pragma unroll
        for (int h4 = 0; h4 < 4; ++h4) {
            const int e = tid + h4 * 512, gv = e >> 10, i = (e >> 6) & 15, ln = e & 63;
            float v = 0.f;
#pragma unroll
            for (int w = 0; w < 8; ++w) v += red[((w * 2 + gv) * 16 + i) * 64 + ln];
            const int ml = (i & 3) + 8 * (i >> 2) + 4 * (ln >> 5);
            tile[(gv * 32 + ml) * 32 + (ln & 31)] = v * rstd3[fix_row(mt * 32 + ml)];
        }
        __syncthreads();
        {
            const int q = tid >> 6, c = tid & 31, part = (tid >> 5) & 1, m0 = 4 * q, b = q;
            const int j = 128 * pn + 32 * sub + c;
            if (part == 0) {
                const float* cw = a.in[I_FCW]; const float* cb = a.in[I_FCB];
                const float ug0 = tile[(m0) * 32 + c], ug1 = tile[(m0 + 1) * 32 + c], uv0 = tile[(32 + m0) * 32 + c], uv1 = tile[(32 + m0 + 1) * 32 + c];
                float hg0 = 0.f, hg1 = 0.f, hv0 = 0.f, hv1 = 0.f;
                if (mt) { const float* ch = a.in[I_CFFN] + (size_t)(b * 2) * NUP; hg0 = ch[j]; hg1 = ch[NUP + j]; hv0 = ch[DFF + j]; hv1 = ch[NUP + DFF + j]; }
                const float wg0 = cw[j], wg1 = cw[NUP + j], wg2 = cw[2 * NUP + j], bgg = cb[j], wv0 = cw[DFF + j], wv1 = cw[NUP + DFF + j], wv2 = cw[2 * NUP + DFF + j], bvv = cb[DFF + j];
                const float cg0 = bgg + wg0 * hg0 + wg1 * hg1 + wg2 * ug0, cv0 = bvv + wv0 * hv0 + wv1 * hv1 + wv2 * uv0;
                const float cg1 = bgg + wg0 * hg1 + wg1 * ug0 + wg2 * ug1, cv1 = bvv + wv0 * hv1 + wv1 * uv0 + wv2 * uv1;
                bf16_t* act = (bf16_t*)(a.ws + WS_ACT);
                const int row0 = fix_row(mt * 32 + m0);
                act[(size_t)row0 * DFF + j] = (bf16_t)f2bf(gelu_tanh(cg0) * cv0); act[(size_t)(row0 + 1) * DFF + j] = (bf16_t)f2bf(gelu_tanh(cg1) * cv1);
            } else {
                float* op = (mt ? a.out + O_FFNS : a.out + O_FFNP) + (size_t)(b * 2) * NUP;
                op[j] = tile[(m0 + 2) * 32 + c]; op[NUP + j] = tile[(m0 + 3) * 32 + c]; op[DFF + j] = tile[(32 + m0 + 2) * 32 + c]; op[NUP + DFF + j] = tile[(32 + m0 + 3) * 32 + c];
            }
        }
    }
    __syncthreads();
}

__device__ __forceinline__ void transpose_item(const float* W, int ldw, int K, bf16_t* WT, const float* kscale, LAS float* scr, int k0, int srccol0, int dstrow0, int lane) {
#pragma unroll 8
    for (int i = 0; i < 32; ++i) { const int kk = 2 * i + (lane >> 5); float v = W[(size_t)(k0 + kk) * ldw + srccol0 + (lane & 31)]; if (kscale) v *= kscale[k0 + kk]; scr[kk * 33 + (lane & 31)] = v; }
    asm volatile("s_waitcnt lgkmcnt(0)" ::: "memory");
    const int c = lane & 7;
#pragma unroll
    for (int j = 0; j < 4; ++j) { const int n = (lane >> 3) + 8 * j; const LAS float* s = scr + (8 * c) * 33 + n;
        u32x4 o; o.x = pk2(s[0 * 33], s[1 * 33]); o.y = pk2(s[2 * 33], s[3 * 33]); o.z = pk2(s[4 * 33], s[5 * 33]); o.w = pk2(s[6 * 33], s[7 * 33]);
        *(u32x4*)(WT + (size_t)(dstrow0 + n) * K + k0 + 8 * c) = o; }
    asm volatile("s_waitcnt lgkmcnt(0)" ::: "memory");
}

__device__ __forceinline__ void p0_prologue(const Args& a, LAS unsigned char* lds, int gw, int NGW, int lane, int wave) {
    unsigned char* ws = a.ws;
    LAS float* scr = (LAS float*)(lds + wave * 16384);
    bf16_t* WinT = (bf16_t*)(ws + WS_WIN); bf16_t* WoutT = (bf16_t*)(ws + WS_WOUT); bf16_t* WupT = (bf16_t*)(ws + WS_WUP); bf16_t* WdownT = (bf16_t*)(ws + WS_WDOWN);
    constexpr int I_IN = 16 * 64, I_OUT = 16 * 32, I_UP = 16 * 176, I_DOWN = 44 * 32, NIT = I_IN + I_OUT + I_UP + I_DOWN;
    for (int it = gw; it < NIT; it += NGW) {
        int r = it;
        if (r < I_IN) { const int kb = r / 64, nb = r % 64; const int dst = nb * 32; const int src = dst < 1536 ? dst : dst + 8;
            transpose_item(a.in[I_WIN], 2056, 1024, WinT, a.in[I_PREMIX], scr, kb * 64, src, dst, lane); continue; }
        r -= I_IN;
        if (r < I_OUT) { const int kb = r / 32, nb = r % 32; transpose_item(a.in[I_WOUT], 1024, 1024, WoutT, nullptr, scr, kb * 64, nb * 32, nb * 32, lane); continue; }
        r -= I_OUT;
        if (r < I_UP) { const int kb = r / 176, nb = r % 176; const int dst = nb * 32; const int pn = dst >> 8, i = dst & 255; const int src = i < 128 ? pn * 128 + i : DFF + pn * 128 + (i - 128);
            transpose_item(a.in[I_WUP], NUP, 1024, WupT, a.in[I_PREFFN], scr, kb * 64, src, dst, lane); continue; }
        r -= I_UP;
        { const int kb = r / 32, nb = r % 32; transpose_item(a.in[I_WDOWN], 1024, DFF, WdownT, nullptr, scr, kb * 64, nb * 32, nb * 32, lane); }
    }
    { float* s2 = (float*)(ws + WS_SUMSQ2); float* s4 = (float*)(ws + WS_SUMSQ4);
      for (int i = gw * 64 + lane; i < R; i += NGW * 64) { s2[i] = 0.f; s4[i] = 0.f; } }
    float wd[8][16];
    { const float* Win = a.in[I_WIN]; const float* pw = a.in[I_PREMIX];
#pragma unroll
      for (int j = 0; j < 8; ++j)
#pragma unroll
          for (int q = 0; q < 4; ++q)
#pragma unroll
              for (int e = 0; e < 4; ++e) { const int k = q * 256 + lane * 4 + e; wd[j][q * 4 + e] = Win[(size_t)k * 2056 + 1536 + j] * pw[k]; } }
    bf16_t* xb = (bf16_t*)(ws + WS_HB); float* rstd1 = (float*)(ws + WS_RSTD1); float* dtv = (float*)(ws + WS_DTV);
    const float* dtb = a.in[I_DTB];
    for (int row0 = 2 * gw; row0 < R; row0 += 2 * NGW) {
        f32x4 vv[2][4];
#pragma unroll
        for (int rr = 0; rr < 2; ++rr) { const int row = row0 + rr;
            const float* xr = row < RP ? a.in[I_XP] + (size_t)row * DM : a.in[I_XS] + (size_t)(row - RP) * DM;
#pragma unroll
            for (int q = 0; q < 4; ++q) vv[rr][q] = *(const f32x4*)(xr + q * 256 + lane * 4); }
#pragma unroll
        for (int rr = 0; rr < 2; ++rr) { const int row = row0 + rr;
            float ss = 0.f;
#pragma unroll
            for (int q = 0; q < 4; ++q) { const f32x4 v = vv[rr][q]; ss += (v[0] * v[0] + v[1] * v[1]) + (v[2] * v[2] + v[3] * v[3]); }
            ss = wave_sum(ss);
            const float rs = 1.f / sqrtf(ss * (1.f / DM) + EPS);
#pragma unroll
            for (int q = 0; q < 4; ++q) { const f32x4 v = vv[rr][q]; u32x2 w; w.x = pk2(v[0], v[1]); w.y = pk2(v[2], v[3]); *(u32x2*)(xb + (size_t)row * DM + q * 256 + lane * 4) = w; }
            float myd = 0.f;
#pragma unroll
            for (int j = 0; j < 8; ++j) { float d = 0.f;
#pragma unroll
                for (int q = 0; q < 4; ++q)
#pragma unroll
                    for (int e = 0; e < 4; ++e) d += vv[rr][q][e] * wd[j][q * 4 + e];
                d = wave_sum(d);
                if (lane == j) myd = d; }
            if (lane < 8) { const float xx = myd * rs + dtb[lane]; dtv[(size_t)row * 8 + lane] = xx > 20.f ? xx : log1pf(expf(xx)); }
            if (lane == 0) rstd1[row] = rs; }
    }
}

constexpr int XT_LD = 72, BN_LD = 136;
constexpr int L_XT = 0;
constexpr int L_BT = 36864;
constexpr int L_CN = L_BT + 18432;
constexpr int L_CS = L_CN + 17408;
constexpr int L_SSD_END = L_CS + 4 * 4 * 64 * 4;
constexpr int SUB_LDS = L_SSD_END + 64;
__device__ __forceinline__ void sub_barrier(LAS unsigned* cnt, unsigned& target, int lane) {
    asm volatile("s_waitcnt lgkmcnt(0)" ::: "memory");
    target += 4u;
    if (lane == 0) __hip_atomic_fetch_add(cnt, 1u, __ATOMIC_RELAXED, __HIP_MEMORY_SCOPE_WORKGROUP);
    for (;;) { const unsigned v = (unsigned)__builtin_amdgcn_readfirstlane((int)__hip_atomic_load(cnt, __ATOMIC_RELAXED, __HIP_MEMORY_SCOPE_WORKGROUP)); if ((int)(v - target) >= 0) break; __builtin_amdgcn_s_sleep(1); }
    asm volatile("" ::: "memory");
}

struct SeqInfo { int row0; int nreal; int pad; bool smp; int b; int slot; };
__device__ __forceinline__ SeqInfo ssd_unit(int ubc) {
    SeqInfo s;
    if (ubc < NBATCH * NCHUNK) { s.b = ubc >> 7; s.row0 = ubc * 64; s.pad = 0; s.smp = false; }
    else { s.b = ubc - NBATCH * NCHUNK; s.row0 = RP + s.b * DSEQ - 32; s.pad = 32; s.smp = true; }
    s.slot = ubc; s.nreal = 64 - s.pad; return s;
}

__device__ __forceinline__ void ssd_cs(const Args& a, LAS unsigned char* lds, const SeqInfo& si, int g, int lane, int mode, float* cdec) {
    LAS float* cs = (LAS float*)(lds + L_CS); LAS float* dtl = cs + 256; LAS float* aux = cs + 512;
    const float* dtv = (const float*)(a.ws + WS_DTV);
#pragma unroll
    for (int h4 = 0; h4 < 4; ++h4) {
        const int h = g * 4 + h4;
        float d = dtv[(size_t)(si.row0 + lane) * 8 + h]; d = lane >= si.pad ? d : 0.f;
        const float av = -__expf(a.in[I_ALOG][h]);
        float x = d * av;
#pragma unroll
        for (int o = 1; o < 64; o <<= 1) { const float y = __shfl_up(x, o); if (lane >= o) x += y; }
        const float ce = __shfl(x, 63);
        cs[h4 * 64 + lane] = x; dtl[h4 * 64 + lane] = d;
        aux[h4 * 64 + lane] = mode == 0 ? __expf(ce - x) * d : __expf(x);
        if (mode == 0 && lane == 0 && cdec) cdec[(size_t)si.slot * 8 + h] = __expf(ce);
    }
}

__device__ __forceinline__ void raw8(const Args& a, const SeqInfo& si, int tpos  , int tok  , int cch, float (&o)[8]) {
    const bf16_t* proj = (const bf16_t*)(a.ws + WS_PROJ);
    if (tpos >= 0) { const u32x4 w = *(const u32x4*)(proj + (size_t)(si.row0 + tok) * NPROJ + 512 + cch);
        o[0] = bf2f(w.x & 0xffff); o[1] = bf2f(w.x >> 16); o[2] = bf2f(w.y & 0xffff); o[3] = bf2f(w.y >> 16); o[4] = bf2f(w.z & 0xffff); o[5] = bf2f(w.z >> 16); o[6] = bf2f(w.w & 0xffff); o[7] = bf2f(w.w >> 16); }
    else if (si.smp && tpos >= -3) { const float* c = a.in[I_CSSD] + (size_t)(si.b * 3 + (tpos + 3)) * 1024 + cch;
#pragma unroll
        for (int e = 0; e < 8; ++e) o[e] = c[e]; }
    else {
#pragma unroll
        for (int e = 0; e < 8; ++e) o[e] = 0.f; }
}

__device__ __forceinline__ void rowvals(const Args& a, const SeqInfo& si, const u32x4 w, int tpos, int cch, float (&o)[8]) {
    o[0] = bf2f(w.x & 0xffff); o[1] = bf2f(w.x >> 16); o[2] = bf2f(w.y & 0xffff); o[3] = bf2f(w.y >> 16); o[4] = bf2f(w.z & 0xffff); o[5] = bf2f(w.z >> 16); o[6] = bf2f(w.w & 0xffff); o[7] = bf2f(w.w >> 16);
    if (tpos < 0) {
        if (si.smp && tpos >= -3) { const float* c = a.in[I_CSSD] + (size_t)(si.b * 3 + (tpos + 3)) * 1024 + cch;
#pragma unroll
            for (int e = 0; e < 8; ++e) o[e] = c[e]; }
        else {
#pragma unroll
            for (int e = 0; e < 8; ++e) o[e] = 0.f; }
    }
}
__device__ __forceinline__ void ssd_stage(const Args& a, LAS unsigned char* lds, const SeqInfo& si, int g, int c_in_seq, int tid, int mode) {
    const int cg8 = tid & 63;
    if (mode == 0 && cg8 >= 48) return;
    int cch, kind;
    if (cg8 < 32) { kind = 0; cch = g * 256 + cg8 * 8; } else if (cg8 < 48) { kind = 1; cch = 512 + g * 128 + (cg8 - 32) * 8; } else { kind = 2; cch = 768 + g * 128 + (cg8 - 48) * 8; }
    float w[4][8], bias[8];
#pragma unroll
    for (int k = 0; k < 4; ++k) { const f32x4 a0 = *(const f32x4*)(a.in[I_SCW] + k * 1024 + cch), a1 = *(const f32x4*)(a.in[I_SCW] + k * 1024 + cch + 4);
#pragma unroll
        for (int e = 0; e < 4; ++e) { w[k][e] = a0[e]; w[k][4 + e] = a1[e]; } }
    { const f32x4 a0 = *(const f32x4*)(a.in[I_SCB] + cch), a1 = *(const f32x4*)(a.in[I_SCB] + cch + 4);
#pragma unroll
      for (int e = 0; e < 4; ++e) { bias[e] = a0[e]; bias[4 + e] = a1[e]; } }
    const int seq0 = si.smp ? -32 : c_in_seq * 64;
#pragma unroll
    for (int tgi = 0; tgi < 2; ++tgi) {
    const int tg = __builtin_amdgcn_readfirstlane(tid >> 6) + 4 * tgi;
    const int t0 = 8 * tg;
    float r0[8], r1[8], r2[8], r3[8];
    u32x4 rw[11];
    { const bf16_t* pr = (const bf16_t*)(a.ws + WS_PROJ) + (size_t)(si.row0 + t0 - 3) * NPROJ + 512 + cch;
#pragma unroll
      for (int i = 0; i < 11; ++i) rw[i] = *(const u32x4*)(pr + (size_t)i * NPROJ); }
    rowvals(a, si, rw[0], seq0 + t0 - 3, cch, r0); rowvals(a, si, rw[1], seq0 + t0 - 2, cch, r1); rowvals(a, si, rw[2], seq0 + t0 - 1, cch, r2);
    unsigned pk[4][8]; float prev[8];
    const LAS float* aux = (const LAS float*)(lds + L_CS) + 512;
#pragma unroll
    for (int i = 0; i < 8; ++i) {
        rowvals(a, si, rw[3 + i], seq0 + t0 + i, cch, r3);
        const bool real = (t0 + i) >= si.pad;
        float sc = 1.f;
        if (mode == 0) { const float sv = aux[((cg8 >> 3) & 3) * 64 + t0 + i]; sc = kind == 0 ? sv : 1.f; }
#pragma unroll
        for (int e = 0; e < 8; ++e) { const float v = __builtin_fmaf(w[3][e], r3[e], __builtin_fmaf(w[2][e], r2[e], __builtin_fmaf(w[1][e], r1[e], __builtin_fmaf(w[0][e], r0[e], bias[e]))));
            const float ov = real ? silu_f(v) * sc : 0.f; r0[e] = r1[e]; r1[e] = r2[e]; r2[e] = r3[e];
            if (i & 1) pk[i >> 1][e] = pk2(prev[e], ov); else prev[e] = ov; }
    }
    const bool transposed = (kind == 0) || (mode == 0);
    if (transposed) {
        LAS bf16_t* base = kind == 0 ? (LAS bf16_t*)(lds + L_XT) + (cg8 * 8) * XT_LD : (LAS bf16_t*)(lds + L_BT) + ((cg8 - 32) * 8) * XT_LD;
#pragma unroll
        for (int e = 0; e < 8; ++e) { u32x4 o; o.x = pk[0][e]; o.y = pk[1][e]; o.z = pk[2][e]; o.w = pk[3][e];
            *(LAS u32x4*)(base + e * XT_LD + ((tg ^ (cg8 & 7)) << 3)) = o; }
    } else {
        LAS bf16_t* base = kind == 1 ? (LAS bf16_t*)(lds + L_BT) + (cg8 - 32) * 8 : (LAS bf16_t*)(lds + L_CN) + (cg8 - 48) * 8;
#pragma unroll
        for (int q = 0; q < 4; ++q) {
            u32x4 o0, o1;
#pragma unroll
            for (int c2 = 0; c2 < 4; ++c2) { const unsigned lo = pk[q][2 * c2], hi = pk[q][2 * c2 + 1];
                o0[c2] = (lo & 0xffffu) | (hi << 16); o1[c2] = (lo >> 16) | (hi & 0xffff0000u); }
            *(LAS u32x4*)(base + (t0 + 2 * q) * BN_LD) = o0; *(LAS u32x4*)(base + (t0 + 2 * q + 1) * BN_LD) = o1;
        }
    }
    }
}

#define MFMA32(a, b, c) __builtin_amdgcn_mfma_f32_32x32x16_bf16((a), (b), (c), 0, 0, 0)
__device__ __forceinline__ f32x16 zero16() { f32x16 z; for (int i = 0; i < 16; ++i) z[i] = 0.f; return z; }

__device__ __forceinline__ void ssd_passA_unit(const Args& a, LAS unsigned char* lds, int unit, int tid, int w4, int lane, LAS unsigned* bcnt, unsigned& btarget) {
    const int ubc = unit >> 1, g = unit & 1;
    const SeqInfo si = ssd_unit(ubc);
    sub_barrier(bcnt, btarget, lane);
    ssd_cs(a, lds, si, g, lane, 0, w4 == 0 ? (float*)(a.ws + WS_CDEC) : nullptr);
    ssd_stage(a, lds, si, g, ubc & 127, tid, 0);
    sub_barrier(bcnt, btarget, lane);
    const int h4 = w4, r = lane & 31, hf = lane >> 5;
    const LAS bf16_t* XT = (const LAS bf16_t*)(lds + L_XT); const LAS bf16_t* BT = (const LAS bf16_t*)(lds + L_BT);
    bf16_t* sst = (bf16_t*)(a.ws + WS_SST) + ((size_t)si.slot * 8 + g * 4 + h4) * 8192;
#pragma unroll 1
    for (int nh = 0; nh < 2; ++nh) {
        f32x16 acc[2][2]; acc[0][0] = zero16(); acc[0][1] = zero16(); acc[1][0] = zero16(); acc[1][1] = zero16();
#pragma unroll
        for (int ks = 0; ks < 4; ++ks) {
            bf16x8 af[2], bfr[2];
#pragma unroll
            for (int ni = 0; ni < 2; ++ni) af[ni] = *(const LAS bf16x8*)(BT + (nh * 64 + ni * 32 + r) * XT_LD + (((ks * 2 + hf) ^ ((ni * 4 + (r >> 3)) & 7)) << 3));
#pragma unroll
            for (int pj = 0; pj < 2; ++pj) bfr[pj] = *(const LAS bf16x8*)(XT + (h4 * 64 + pj * 32 + r) * XT_LD + (((ks * 2 + hf) ^ ((pj * 4 + (r >> 3)) & 7)) << 3));
#pragma unroll
            for (int ni = 0; ni < 2; ++ni)
#pragma unroll
                for (int pj = 0; pj < 2; ++pj) acc[ni][pj] = MFMA32(af[ni], bfr[pj], acc[ni][pj]);
        }
#pragma unroll
        for (int ni = 0; ni < 2; ++ni)
#pragma unroll
            for (int pj = 0; pj < 2; ++pj)
#pragma unroll
                for (int i = 0; i < 4; ++i) { const int p = pj * 32 + r, n = nh * 64 + ni * 32 + 8 * i + 4 * hf;
                    u32x2 w; w.x = pk2(acc[ni][pj][4 * i], acc[ni][pj][4 * i + 1]); w.y = pk2(acc[ni][pj][4 * i + 2], acc[ni][pj][4 * i + 3]);
                    *(u32x2*)(sst + p * 128 + n) = w; }
    }
}

__device__ __forceinline__ void ssd_passC_unit(const Args& a, LAS unsigned char* lds, int unit, int tid, int w4, int lane, LAS unsigned* bcnt, unsigned& btarget) {
    const int ubc = unit >> 1, g = unit & 1;
    const SeqInfo si = ssd_unit(ubc);
    sub_barrier(bcnt, btarget, lane);
    ssd_cs(a, lds, si, g, lane, 1, nullptr);
    ssd_stage(a, lds, si, g, ubc & 127, tid, 1);
    sub_barrier(bcnt, btarget, lane);
    const int h4 = w4, r = lane & 31, hf = lane >> 5, h = g * 4 + h4;
    const LAS bf16_t* XT = (const LAS bf16_t*)(lds + L_XT) + h4 * 64 * XT_LD; const LAS bf16_t* Bn = (const LAS bf16_t*)(lds + L_BT); const LAS bf16_t* Cn = (const LAS bf16_t*)(lds + L_CN);
    const LAS float* cs = (const LAS float*)(lds + L_CS) + h4 * 64; const LAS float* dtl = cs + 256; const LAS float* ecs = cs + 512; LAS float* red = (LAS float*)(lds + L_CS) + 768;
#pragma unroll 1
    for (int lh = 0; lh < 2; ++lh) {
    const int l = lh * 32 + r;
    const int row = si.row0 + l;
    const bool realtok = l >= si.pad;
    const bf16_t* zrow = (const bf16_t*)(a.ws + WS_PROJ) + (size_t)row * NPROJ + g * 256 + h4 * 64;
    u32x2 zq[2][4];
#pragma unroll
    for (int pt = 0; pt < 2; ++pt)
#pragma unroll
        for (int i = 0; i < 4; ++i) zq[pt][i] = *(const u32x2*)(zrow + pt * 32 + 8 * i + 4 * hf);
    bf16x8 cf[8];
#pragma unroll
    for (int ks = 0; ks < 8; ++ks) cf[ks] = *(const LAS bf16x8*)(Cn + l * BN_LD + ks * 16 + 8 * hf);
    f32x16 ya[2]; ya[0] = zero16(); ya[1] = zero16();
    const bf16_t* hp = (const bf16_t*)(a.ws + WS_SST) + ((size_t)si.slot * 8 + h) * 8192;
#pragma unroll
    for (int ks = 0; ks < 8; ++ks) {
#pragma unroll
        for (int pt = 0; pt < 2; ++pt) { const bf16x8 af = *(const bf16x8*)(hp + (pt * 32 + r) * 128 + ks * 16 + 8 * hf); ya[pt] = MFMA32(af, cf[ks], ya[pt]); }
    }
    { const float e = ecs[l];
#pragma unroll
      for (int pt = 0; pt < 2; ++pt)
#pragma unroll
          for (int i = 0; i < 16; ++i) ya[pt][i] *= e; }
    const float csl = cs[l];
#pragma unroll
    for (int st = 0; st < 2; ++st) {
        if (st <= lh) {
            f32x16 sa = zero16();
#pragma unroll
            for (int ks = 0; ks < 8; ++ks) { const bf16x8 af = *(const LAS bf16x8*)(Bn + (st * 32 + r) * BN_LD + ks * 16 + 8 * hf); sa = MFMA32(af, cf[ks], sa); }
#pragma unroll
            for (int i = 0; i < 16; ++i) { const int s = st * 32 + (i & 3) + 8 * (i >> 2) + 4 * hf;
                const float v = sa[i] * __expf(csl - cs[s]) * dtl[s]; sa[i] = (s <= l) ? v : 0.f; }
#pragma unroll
            for (int k2 = 0; k2 < 2; ++k2) {
                u32x4 gp; gp.x = pk2(sa[8 * k2 + 0], sa[8 * k2 + 1]); gp.y = pk2(sa[8 * k2 + 2], sa[8 * k2 + 3]); gp.z = pk2(sa[8 * k2 + 4], sa[8 * k2 + 5]); gp.w = pk2(sa[8 * k2 + 6], sa[8 * k2 + 7]);
                const bf16x8 gf = __builtin_bit_cast(bf16x8, gp);
#pragma unroll
                for (int pt = 0; pt < 2; ++pt) {
                    const LAS bf16_t* xr = XT + (pt * 32 + r) * XT_LD + 4 * hf; const int swz = (pt * 4 + (r >> 3)) & 7;
                    const u32x2 lo = *(const LAS u32x2*)(xr + (((st * 4 + 2 * k2) ^ swz) << 3)), hi = *(const LAS u32x2*)(xr + (((st * 4 + 2 * k2 + 1) ^ swz) << 3));
                    u32x4 xa; xa.x = lo.x; xa.y = lo.y; xa.z = hi.x; xa.w = hi.y;
                    ya[pt] = MFMA32(__builtin_bit_cast(bf16x8, xa), gf, ya[pt]);
                }
            }
        }
    }
    const float Dh = a.in[I_SSDD][h];
    float ssq = 0.f;
#pragma unroll
    for (int pt = 0; pt < 2; ++pt)
#pragma unroll
        for (int i = 0; i < 4; ++i) {
            const int p0 = pt * 32 + 8 * i + 4 * hf;
            const u32x2 zz = zq[pt][i];
            const float zv[4] = {bf2f(zz.x & 0xffff), bf2f(zz.x >> 16), bf2f(zz.y & 0xffff), bf2f(zz.y >> 16)};
#pragma unroll
            for (int j = 0; j < 4; ++j) { const float xv = bf2f(XT[(p0 + j) * XT_LD + ((((l >> 3) ^ ((pt * 4 + i) & 7)) << 3) | (l & 7))]); const float y = (ya[pt][4 * i + j] + Dh * xv) * silu_f(zv[j]); ya[pt][4 * i + j] = y; ssq += y * y; }
        }
    ssq += __shfl_xor(ssq, 32);
    if (hf == 0) red[h4 * 64 + l] = ssq;
    sub_barrier(bcnt, btarget, lane);
    const float* nw0 = a.in[I_SNW] + g * 256 + h4 * 64;
    const float tot = red[l] + red[64 + l] + red[128 + l] + red[192 + l];
    const float rs = 1.f / sqrtf(tot * (1.f / 256.f) + EPS);
    if (realtok) {
        bf16_t* orow = (bf16_t*)(a.ws + WS_MIXIN) + (size_t)row * DM + g * 256 + h4 * 64;
#pragma unroll
        for (int pt = 0; pt < 2; ++pt)
#pragma unroll
            for (int i = 0; i < 4; ++i) { const int p0 = pt * 32 + 8 * i + 4 * hf; const f32x4 nq = *(const f32x4*)(nw0 + p0);
                u32x2 w; w.x = pk2(ya[pt][4 * i] * rs * nq[0], ya[pt][4 * i + 1] * rs * nq[1]); w.y = pk2(ya[pt][4 * i + 2] * rs * nq[2], ya[pt][4 * i + 3] * rs * nq[3]);
                *(u32x2*)(orow + p0) = w; }
    }
    }
}

struct S5Consts { float lbr, lbi; bf16x8 bb[4]; };
__device__ __forceinline__ void s5_lambda(const Args& a, int g, int p, float& lbr, float& lbi, float& qr, float& qi) {
    const float lr = a.in[I_LRE][g * 64 + p], li = a.in[I_LIM][g * 64 + p], dt = expf(a.in[I_LDT][g]);
    const float mag = expf(lr * dt), ang = li * dt;
    lbr = mag * cosf(ang); lbi = mag * sinf(ang);
    const float den = lr * lr + li * li;
    qr = ((lbr - 1.f) * lr + lbi * li) / den; qi = (lbi * lr - (lbr - 1.f) * li) / den;
}
__device__ __forceinline__ void s5_consts(const Args& a, int g, int lane, S5Consts& c) {
    const int r = lane & 31, hf = lane >> 5;
    float lb0r, lb0i, q0r, q0i, lb1r, lb1i, q1r, q1i;
    s5_lambda(a, g, r, lb0r, lb0i, q0r, q0i); s5_lambda(a, g, 32 + r, lb1r, lb1i, q1r, q1i);
    c.lbr = hf ? lb1r : lb0r; c.lbi = hf ? lb1i : lb0i;
#pragma unroll
    for (int nb = 0; nb < 4; ++nb) {
        const int ps = r + 32 * (nb >> 1); const float qr = (nb >> 1) ? q1r : q0r, qi = (nb >> 1) ? q1i : q0i;
        const float* br = a.in[I_BRE] + (size_t)(g * 64 + ps) * 16 + 8 * hf; const float* bi = a.in[I_BIM] + (size_t)(g * 64 + ps) * 16 + 8 * hf;
        float v[8];
#pragma unroll
        for (int j = 0; j < 8; ++j) v[j] = (nb & 1) ? (qr * bi[j] + qi * br[j]) : (qr * br[j] - qi * bi[j]);
        u32x4 w; w.x = pk2(v[0], v[1]); w.y = pk2(v[2], v[3]); w.z = pk2(v[4], v[5]); w.w = pk2(v[6], v[7]);
        c.bb[nb] = __builtin_bit_cast(bf16x8, w);
    }
}
template <bool STORE>
__device__ __forceinline__ void s5_block(const Args& a, const S5Consts& c, const bf16x8 uf, int lane, float& hr, float& hi, LAS unsigned char* wl, const bf16_t* nxt, bf16x8& nuf) {
    f32x16 bu[4];
#pragma unroll
    for (int nb = 0; nb < 4; ++nb) bu[nb] = MFMA32(uf, c.bb[nb], zero16());
    asm volatile("" ::: "memory");
    nuf = *(const bf16x8*)nxt;
    asm volatile("" ::: "memory");
#pragma unroll
    for (int i = 0; i < 16; ++i) {
        auto s0 = __builtin_amdgcn_permlane32_swap(__float_as_uint(bu[0][i]), __float_as_uint(bu[2][i]), false, false);
        auto s1 = __builtin_amdgcn_permlane32_swap(__float_as_uint(bu[1][i]), __float_as_uint(bu[3][i]), false, false);
        bu[0][i] = __uint_as_float(s0[0]); bu[2][i] = __uint_as_float(s0[1]); bu[1][i] = __uint_as_float(s1[0]); bu[3][i] = __uint_as_float(s1[1]);
    }
    const float nlbi = -c.lbi;
#pragma unroll
    for (int ib = 0; ib < 4; ++ib) {
#pragma unroll
        for (int j = 0; j < 4; ++j) { const float nr = __builtin_fmaf(c.lbr, hr, __builtin_fmaf(nlbi, hi, bu[0][4 * ib + j])), ni = __builtin_fmaf(c.lbr, hi, __builtin_fmaf(c.lbi, hr, bu[1][4 * ib + j])); hr = nr; hi = ni; if (STORE) *(LAS unsigned*)(wl + (8 * ib + j) * 272 + lane * 4) = pk2(hr, hi); }
#pragma unroll
        for (int j = 0; j < 4; ++j) { const float nr = __builtin_fmaf(c.lbr, hr, __builtin_fmaf(nlbi, hi, bu[2][4 * ib + j])), ni = __builtin_fmaf(c.lbr, hi, __builtin_fmaf(c.lbi, hr, bu[3][4 * ib + j])); hr = nr; hi = ni; if (STORE) *(LAS unsigned*)(wl + (8 * ib + 4 + j) * 272 + lane * 4) = pk2(hr, hi); }
    }
}
__device__ __forceinline__ void s5_passA_item(const Args& a, int item, int lane) {
    const int b = item >> 8, g = (item >> 3) & 31, seg = item & 7;
    S5Consts c; s5_consts(a, g, lane, c);
    float hr = 0.f, hi = 0.f;
    const int row0 = b * SEQ + seg * 1024;
    const bf16_t* up_ = (const bf16_t*)(a.ws + WS_PROJ) + (size_t)(row0 + (lane & 31)) * NPROJ + 1536 + g * 16 + 8 * (lane >> 5);
    bf16x8 uf = *(const bf16x8*)up_;
    for (int blk = 0; blk < 32; ++blk) { const int nb = blk < 31 ? blk + 1 : 31; bf16x8 nuf; s5_block<false>(a, c, uf, lane, hr, hi, nullptr, up_ + (size_t)nb * 32 * NPROJ, nuf); uf = nuf; }
    float* loc = (float*)(a.ws + WS_S5LOC) + (size_t)item * 128;
    loc[lane] = hr; loc[64 + lane] = hi;
}
constexpr int S5_LD = 272;
__device__ __forceinline__ void s5_passC_run(const Args& a, LAS unsigned char* wlds, int row0, int nblk, int g, int lane, float& hr, float& hi) {
    S5Consts c; s5_consts(a, g, lane, c);
    const int r16 = lane & 15, q4 = lane >> 4;
    bf16x8 ca[4];
#pragma unroll
    for (int kb = 0; kb < 4; ++kb) { float v[8];
#pragma unroll
        for (int j = 0; j < 8; ++j) { const int comp = 32 * kb + 8 * q4 + j, p = comp >> 1; v[j] = (comp & 1) ? -a.in[I_CIM][(size_t)(g * 16 + r16) * 64 + p] : a.in[I_CRE][(size_t)(g * 16 + r16) * 64 + p]; }
        u32x4 w; w.x = pk2(v[0], v[1]); w.y = pk2(v[2], v[3]); w.z = pk2(v[4], v[5]); w.w = pk2(v[6], v[7]); ca[kb] = __builtin_bit_cast(bf16x8, w); }
    bf16x4 ga[2];
#pragma unroll
    for (int mb = 0; mb < 2; ++mb) { float v[4];
#pragma unroll
        for (int j = 0; j < 4; ++j) v[j] = a.in[I_GLUW][(size_t)(g * 16 + 4 * q4 + j) * 32 + mb * 16 + r16];
        u32x2 w; w.x = pk2(v[0], v[1]); w.y = pk2(v[2], v[3]); ga[mb] = __builtin_bit_cast(bf16x4, w); }
    f32x4 dD, gb0, gb1;
#pragma unroll
    for (int j = 0; j < 4; ++j) { dD[j] = a.in[I_S5D][g * 16 + 4 * q4 + j]; gb0[j] = a.in[I_GLUB][g * 32 + 4 * q4 + j]; gb1[j] = a.in[I_GLUB][g * 32 + 16 + 4 * q4 + j]; }
    const bf16_t* proj = (const bf16_t*)(a.ws + WS_PROJ);
    bf16_t* mixin = (bf16_t*)(a.ws + WS_MIXIN);
    const bf16_t* up_ = proj + (size_t)(row0 + (lane & 31)) * NPROJ + 1536 + g * 16 + 8 * (lane >> 5);
    bf16x8 uf = *(const bf16x8*)up_;
    u32x2 uus[2], uun[2];
#pragma unroll
    for (int sb = 0; sb < 2; ++sb) uus[sb] = *(const u32x2*)(proj + (size_t)(row0 + sb * 16 + r16) * NPROJ + 1536 + g * 16 + 4 * q4);
    for (int blk = 0; blk < nblk; ++blk) {
        const int rb = row0 + blk * 32;
        const int nb = blk < nblk - 1 ? blk + 1 : blk; bf16x8 nuf;
        s5_block<true>(a, c, uf, lane, hr, hi, wlds, up_ + (size_t)nb * 32 * NPROJ, nuf); uf = nuf;
#pragma unroll
        for (int sb = 0; sb < 2; ++sb) uun[sb] = *(const u32x2*)(proj + (size_t)(row0 + nb * 32 + sb * 16 + r16) * NPROJ + 1536 + g * 16 + 4 * q4);
        asm volatile("s_waitcnt lgkmcnt(0)" ::: "memory");
#pragma unroll
        for (int sb = 0; sb < 2; ++sb) {
            f32x4 y = (f32x4){0.f, 0.f, 0.f, 0.f};
#pragma unroll
            for (int kb = 0; kb < 4; ++kb) { const bf16x8 hb = *(const LAS bf16x8*)(wlds + (sb * 16 + r16) * S5_LD + (32 * kb + 8 * q4) * 2);
                y = __builtin_amdgcn_mfma_f32_16x16x32_bf16(ca[kb], hb, y, 0, 0, 0); }
            const int row = rb + sb * 16 + r16;
            const u32x2 uu = uus[sb];
            const float uv[4] = {bf2f(uu.x & 0xffff), bf2f(uu.x >> 16), bf2f(uu.y & 0xffff), bf2f(uu.y >> 16)};
            float ge[4];
#pragma unroll
            for (int j = 0; j < 4; ++j) ge[j] = gelu_tanh(y[j] + dD[j] * uv[j]);
            u32x2 gw; gw.x = pk2(ge[0], ge[1]); gw.y = pk2(ge[2], ge[3]);
            const bf16x4 gbf = __builtin_bit_cast(bf16x4, gw);
            const f32x4 o0 = __builtin_amdgcn_mfma_f32_16x16x16bf16_1k(ga[0], gbf, gb0, 0, 0, 0);
            const f32x4 o1 = __builtin_amdgcn_mfma_f32_16x16x16bf16_1k(ga[1], gbf, gb1, 0, 0, 0);
            float ov[4];
#pragma unroll
            for (int j = 0; j < 4; ++j) ov[j] = o0[j] * __builtin_amdgcn_rcpf(1.f + __builtin_amdgcn_exp2f(-1.4426950409f * o1[j]));
            u32x2 ow; ow.x = pk2(ov[0], ov[1]); ow.y = pk2(ov[2], ov[3]);
            *(u32x2*)(mixin + (size_t)row * DM + 512 + g * 16 + 4 * q4) = ow;
        }
        asm volatile("s_waitcnt lgkmcnt(0)" ::: "memory");
        uus[0] = uun[0]; uus[1] = uun[1];
    }
}

#define XB_TMO      128
#define XB_XCNT(j)  (256  + 64 * (j))
#define XB_XSUB(j)  (1280 + 64 * (j))
#define XB_XGEN(j)  (2304 + 64 * (j))
#define XB_TOP      3328
#define XB_TOPGEN   3392
#define XCD_BAR_WORDS 3456
#define XB_SPIN_CAP (1u << 18)

__device__ __forceinline__ unsigned xb_ld(unsigned* p)              { return __hip_atomic_load(p, __ATOMIC_RELAXED, __HIP_MEMORY_SCOPE_AGENT); }
__device__ __forceinline__ unsigned xb_add(unsigned* p, unsigned v) { return __hip_atomic_fetch_add(p, v, __ATOMIC_RELAXED, __HIP_MEMORY_SCOPE_AGENT); }
__device__ __forceinline__ unsigned xb_xcc_id() { return (unsigned)__builtin_amdgcn_s_getreg((3 << 11) | 20) & 0xFu; }
#define XB_SPIN(cond, bar) do { unsigned _sp = 0; while (cond) { __builtin_amdgcn_s_sleep(1); \
    if ((++_sp & 255u) == 0u) { if (xb_ld(&(bar)[XB_TMO])) break; if (_sp > XB_SPIN_CAP) { atomicAdd(&(bar)[XB_TMO], 1u); break; } } } } while (0)

struct XcdBarrier {
    unsigned* bar; unsigned x;
    volatile LAS unsigned* st;
};

__device__ __forceinline__ XcdBarrier xcd_barrier_post(unsigned* bar, volatile LAS unsigned* st) {
    XcdBarrier b; b.bar = bar; b.x = xb_xcc_id(); b.st = st;
    if (threadIdx.x == 0) (void)xb_add(&bar[XB_XCNT(b.x)], 1u);
    return b;
}
__device__ __forceinline__ void xcd_barrier_complete(unsigned* bar, unsigned x, unsigned& nloc, unsigned& nx) {
    const unsigned G = gridDim.x * gridDim.y * gridDim.z;
    unsigned sum, cnt, mine, sp = 0u;
    for (;;) {
        sum = 0u; cnt = 0u; mine = 0u;
#pragma unroll
        for (unsigned j = 0; j < 16; ++j) { const unsigned c = xb_ld(&bar[XB_XCNT(j)]); sum += c; cnt += (c > 0u) ? 1u : 0u; mine = (j == x) ? c : mine; }
        if (sum == G) break;
        __builtin_amdgcn_s_sleep(1);
        if ((++sp & 255u) == 0u) { if (xb_ld(&bar[XB_TMO])) break; if (sp > XB_SPIN_CAP) { atomicAdd(&bar[XB_TMO], 1u); break; } }
    }
    nloc = mine > 0u ? mine : 1u; nx = cnt > 0u ? cnt : 1u;
}

__device__ __forceinline__ void xcd_barrier(const XcdBarrier& b) {
    asm volatile("s_waitcnt vmcnt(0)" ::: "memory");
    __syncthreads();
    if (threadIdx.x == 0) {
        unsigned* bar = b.bar;
        __builtin_amdgcn_s_waitcnt(0);
        unsigned nloc = b.st[0], nx = b.st[1];
        if (nloc == 0u) { xcd_barrier_complete(bar, b.x, nloc, nx); b.st[0] = nloc; b.st[1] = nx; }
        const unsigned old = xb_add(&bar[XB_XSUB(b.x)], 1u);
        const unsigned gen = old / nloc;
        if (old + 1u == (gen + 1u) * nloc) {
            __builtin_amdgcn_fence(__ATOMIC_RELEASE, "agent");
            asm volatile("s_waitcnt vmcnt(0)" ::: "memory");
            const unsigned og = xb_add(&bar[XB_TOP], 1u);
            const unsigned tg = og / nx;
            if (og + 1u == (tg + 1u) * nx) xb_add(&bar[XB_TOPGEN], 1u);
            else XB_SPIN(xb_ld(&bar[XB_TOPGEN]) == tg, bar);
            __builtin_amdgcn_fence(__ATOMIC_ACQUIRE, "agent");
            xb_add(&bar[XB_XGEN(b.x)], 1u);
            asm volatile("s_waitcnt vmcnt(0)" ::: "memory");
        } else {
            XB_SPIN(xb_ld(&bar[XB_XGEN(b.x)]) == gen, bar);
            __builtin_amdgcn_fence(__ATOMIC_ACQUIRE, "agent");
            asm volatile("s_waitcnt vmcnt(0)" ::: "memory");
        }
    }
    __syncthreads();
}


constexpr int LDS_BYTES = 163840;
__global__ void __launch_bounds__(512, 2) fwd_kernel(Args a) {
    extern __shared__ __attribute__((aligned(16))) unsigned char lds_raw[];
    LAS unsigned char* lds = (LAS unsigned char*)lds_raw;
    const int tid = threadIdx.x, lane = tid & 63, wave = __builtin_amdgcn_readfirstlane(tid >> 6);
    const int G = gridDim.x, bx = blockIdx.x;
    const int gw = bx * 8 + wave, NGW = G * 8;
    unsigned char* ws = a.ws;
#if ONE_LAUNCH
    cg::grid_group grid = cg::this_grid();
    volatile LAS unsigned* bst = (volatile LAS unsigned*)(lds + LDS_BYTES - 16);
    if (tid < 4) bst[tid] = 0u;
    __syncthreads();
    XcdBarrier xbar = xcd_barrier_post((unsigned*)(ws + WS_BAR), bst);
#define GSYNC() xcd_barrier(xbar)
#else
#define GSYNC() do {} while (0)
#endif
#ifndef PHMASK
#define PHMASK 0x3ff
#endif
#define IN(k) (((PHMASK >> (k)) & 1) && a.ph_lo <= (k) && (k) < a.ph_hi)
#define SEAM(k) do { if (IN(k) && IN((k) + 1)) GSYNC(); } while (0)

    if (IN(0)) { p0_prologue(a, lds, gw, NGW, lane, wave); }
#if ONE_LAUNCH
    if (a.ph_hi > 1000) grid.sync();
#endif
    SEAM(0);
    if (IN(1)) {
        pg8::Gemm g{(const bf16_t*)(ws + WS_HB), (const bf16_t*)(ws + WS_WIN), RP / 256, NPROJ / 256, DM, 64};
        pg8::StaticOrder S; S.init(g.nM, g.nN, G, bx);
        EpiProj E{(bf16_t*)(ws + WS_PROJ), (const float*)(ws + WS_RSTD1), NPROJ};
        pg8::gemm_phase<EpiProj>(lds, g, S, E);
        mini_gemm<0>(lds, (const bf16_t*)(ws + WS_HB) + (size_t)RP * DM, (const bf16_t*)(ws + WS_WIN), DM, NPROJ, (bf16_t*)(ws + WS_PROJ) + (size_t)RP * NPROJ, NPROJ, (const float*)(ws + WS_RSTD1) + RP, nullptr, bx, G, tid, wave, lane);
    }
    SEAM(1);
    if (IN(2)) {
        {
            const int sb = wave >> 2, sid = tid & 255, w4 = wave & 3;
            LAS unsigned char* sl = lds + sb * SUB_LDS; LAS unsigned* bcnt = (LAS unsigned*)(sl + L_SSD_END);
            if (sid == 0) *bcnt = 0u;
            __syncthreads();
            unsigned btarget = 0u;
            const bool spread = (G == 256);
            const int ulim = spread ? NBATCH * NCHUNK * 2 : NUNITS_BC * 2, u0 = bx * 2 + sb;
            const int nk = u0 < ulim ? (ulim - u0 + 2 * G - 1) / (2 * G) : 0;
            const int sj = (spread && sb == 0 && (bx & 15) == 8) ? (bx >> 4) : -1;
            if (sb) __builtin_amdgcn_s_sleep(100);
            for (int k = 0; k < nk + (sj >= 0 ? 1 : 0); ++k) ssd_passA_unit(a, sl, k < nk ? u0 + k * 2 * G : NBATCH * NCHUNK * 2 + sj, sid, w4, lane, bcnt, btarget);
            __syncthreads();
        }
        for (int it = gw; it < NBATCH * 32 * 8; it += NGW) s5_passA_item(a, it, lane);
        const bf16_t* proj = (const bf16_t*)(ws + WS_PROJ);
        for (int i = bx * 512 + tid; i < 16 * 3 * 1024; i += G * 512) {
            const int sq = i / 3072, rem = i % 3072, k = rem >> 10, ch = rem & 1023;
            const int row = sq < 8 ? sq * SEQ + SEQ - 3 + k : RP + (sq - 8) * DSEQ + DSEQ - 3 + k;
            const float v = bf2f(proj[(size_t)row * NPROJ + 512 + ch]);
            if (sq < 8) a.out[O_CONVP + (size_t)(sq * 3 + k) * 1024 + ch] = v; else a.out[O_CONVS + (size_t)((sq - 8) * 3 + k) * 1024 + ch] = v;
        }
    }
    SEAM(2);
    if (IN(3)) {
        bf16_t* sst = (bf16_t*)(ws + WS_SST); const float* cdec = (const float*)(ws + WS_CDEC);
        for (int i = bx * 512 + tid; i < 16 * 8 * 2048; i += G * 512) {
            const int sq = i >> 14, h = (i >> 11) & 7, e4 = (i & 2047) * 4;
            const bool smp = sq >= 8; const int b = sq & 7;
            const int nch = smp ? 1 : NCHUNK, slot0 = smp ? NBATCH * NCHUNK + b : b * NCHUNK;
            f32x4 hc = (f32x4){0.f, 0.f, 0.f, 0.f};
            if (smp) hc = *(const f32x4*)(a.in[I_SSSD] + ((size_t)(b * 8 + h) * 8192 + e4));
            for (int c = 0; c < nch; ++c) {
                u32x2* p = (u32x2*)(sst + ((size_t)(slot0 + c) * 8 + h) * 8192 + e4);
                const u32x2 w = *p; const float d = cdec[(size_t)(slot0 + c) * 8 + h];
                u32x2 o; o.x = pk2(hc[0], hc[1]); o.y = pk2(hc[2], hc[3]); *p = o;
                hc[0] = hc[0] * d + bf2f(w.x & 0xffff); hc[1] = hc[1] * d + bf2f(w.x >> 16); hc[2] = hc[2] * d + bf2f(w.y & 0xffff); hc[3] = hc[3] * d + bf2f(w.y >> 16);
            }
            *(f32x4*)(a.out + (smp ? O_SSDS : O_SSDP) + ((size_t)(b * 8 + h) * 8192 + e4)) = hc;
        }
        for (int i = bx * 512 + tid; i < NBATCH * 32 * 64; i += G * 512) {
            const int b = i >> 11, g = (i >> 6) & 31, p = i & 63;
            float lbr, lbi, qr, qi; s5_lambda(a, g, p, lbr, lbi, qr, qi);
            float pr = lbr, pi = lbi;
            for (int k = 0; k < 10; ++k) { const float nr = pr * pr - pi * pi, ni = 2.f * pr * pi; pr = nr; pi = ni; }
            const float* loc = (const float*)(ws + WS_S5LOC) + (size_t)((b * 32 + g) * 8) * 128; float* hin = (float*)(ws + WS_S5HIN) + (size_t)((b * 32 + g) * 8) * 128;
            float hr = 0.f, hi = 0.f;
            for (int s = 0; s < 8; ++s) { hin[s * 128 + p] = hr; hin[s * 128 + 64 + p] = hi;
                const float nr = pr * hr - pi * hi + loc[s * 128 + p], ni = pr * hi + pi * hr + loc[s * 128 + 64 + p]; hr = nr; hi = ni; }
            a.out[O_S5REP + i] = hr; a.out[O_S5IMP + i] = hi;
        }
    }
    SEAM(3);
    if (IN(4)) {
        {
            const int sb = wave >> 2, sid = tid & 255, w4 = wave & 3;
            LAS unsigned char* sl = lds + sb * SUB_LDS; LAS unsigned* bcnt = (LAS unsigned*)(sl + L_SSD_END);
            if (sid == 0) *bcnt = 0u;
            __syncthreads();
            unsigned btarget = 0u;
            const bool spread = (G == 256);
            const int ulim = spread ? NBATCH * NCHUNK * 2 : NUNITS_BC * 2, u0 = bx * 2 + sb;
            const int nk = u0 < ulim ? (ulim - u0 + 2 * G - 1) / (2 * G) : 0;
            const int sj = (spread && sb == 0 && (bx & 15) == 8) ? (bx >> 4) : -1;
            if (sb) __builtin_amdgcn_s_sleep(100);
            for (int k = 0; k < nk + (sj >= 0 ? 1 : 0); ++k) ssd_passC_unit(a, sl, k < nk ? u0 + k * 2 * G : NBATCH * NCHUNK * 2 + sj, sid, w4, lane, bcnt, btarget);
        }
        __syncthreads();
        LAS unsigned char* wlds = lds + wave * (32 * S5_LD);
        for (int it = gw; it < NBATCH * 32 * 8 + NBATCH * 32; it += NGW) {
            if (it < NBATCH * 32 * 8) {
                const int b = it >> 8, g = (it >> 3) & 31, seg = it & 7;
                const float* hin = (const float*)(ws + WS_S5HIN) + (size_t)it * 128;
                float hr = hin[lane], hi = hin[64 + lane];
                s5_passC_run(a, wlds, b * SEQ + seg * 1024, 32, g, lane, hr, hi);
            } else {
                const int j = it - NBATCH * 32 * 8, b = j >> 5, g = j & 31;
                float hr = a.in[I_S5RE][(size_t)(b * 32 + g) * 64 + lane], hi = a.in[I_S5IM][(size_t)(b * 32 + g) * 64 + lane];
                s5_passC_run(a, wlds, RP + b * DSEQ, 1, g, lane, hr, hi);
                a.out[O_S5RES + (size_t)(b * 32 + g) * 64 + lane] = hr; a.out[O_S5IMS + (size_t)(b * 32 + g) * 64 + lane] = hi;
            }
        }
        __syncthreads();
    }
    SEAM(4);
    if (IN(5)) {
        pg8::Gemm g{(const bf16_t*)(ws + WS_MIXIN), (const bf16_t*)(ws + WS_WOUT), RP / 256, DM / 256, DM, 64};
        pg8::StaticOrder S; S.init(g.nM, g.nN, G, bx);
        EpiSq E{(bf16_t*)(ws + WS_MIX), (float*)(ws + WS_SUMSQ2), DM};
        pg8::gemm_phase<EpiSq>(lds, g, S, E);
        mini_gemm<1>(lds, (const bf16_t*)(ws + WS_MIXIN) + (size_t)RP * DM, (const bf16_t*)(ws + WS_WOUT), DM, DM, (bf16_t*)(ws + WS_MIX) + (size_t)RP * DM, DM, nullptr, (float*)(ws + WS_SUMSQ2) + RP, bx, G, tid, wave, lane);
    }
    SEAM(5);
    if (IN(6)) {
        const bf16_t* mix = (const bf16_t*)(ws + WS_MIX); const float* s2 = (const float*)(ws + WS_SUMSQ2); bf16_t* hb = (bf16_t*)(ws + WS_HB); float* rstd3 = (float*)(ws + WS_RSTD3);
        const float* pw = a.in[I_POSTMIX];
        f32x4 w4[4];
#pragma unroll
        for (int q = 0; q < 4; ++q) w4[q] = *(const f32x4*)(pw + q * 256 + lane * 4);
        for (int row0 = 2 * gw; row0 < R; row0 += 2 * NGW) {
            f32x4 xv[2][4]; u32x2 mm[2][4]; float rs[2];
#pragma unroll
            for (int rr = 0; rr < 2; ++rr) { const int row = row0 + rr;
                rs[rr] = s2[row];
#pragma unroll
                for (int q = 0; q < 4; ++q) { const u32x2 xx = *(const u32x2*)(hb + (size_t)row * DM + q * 256 + lane * 4);
                    xv[rr][q][0] = bf2f(xx.x & 0xffff); xv[rr][q][1] = bf2f(xx.x >> 16); xv[rr][q][2] = bf2f(xx.y & 0xffff); xv[rr][q][3] = bf2f(xx.y >> 16);
                    mm[rr][q] = *(const u32x2*)(mix + (size_t)row * DM + q * 256 + lane * 4); } }
#pragma unroll
            for (int rr = 0; rr < 2; ++rr) { const int row = row0 + rr;
                const float r_ = 1.f / sqrtf(rs[rr] * (1.f / DM) + EPS);
                float ss = 0.f; f32x4 hv[4];
#pragma unroll
                for (int q = 0; q < 4; ++q) { const u32x2 m2 = mm[rr][q];
                    hv[q][0] = xv[rr][q][0] + bf2f(m2.x & 0xffff) * r_ * w4[q][0]; hv[q][1] = xv[rr][q][1] + bf2f(m2.x >> 16) * r_ * w4[q][1]; hv[q][2] = xv[rr][q][2] + bf2f(m2.y & 0xffff) * r_ * w4[q][2]; hv[q][3] = xv[rr][q][3] + bf2f(m2.y >> 16) * r_ * w4[q][3];
                    ss += (hv[q][0] * hv[q][0] + hv[q][1] * hv[q][1]) + (hv[q][2] * hv[q][2] + hv[q][3] * hv[q][3]); }
                ss = wave_sum(ss);
#pragma unroll
                for (int q = 0; q < 4; ++q) { u32x2 w; w.x = pk2(hv[q][0], hv[q][1]); w.y = pk2(hv[q][2], hv[q][3]); *(u32x2*)(hb + (size_t)row * DM + q * 256 + lane * 4) = w; }
                if (lane == 0) rstd3[row] = 1.f / sqrtf(ss * (1.f / DM) + EPS); }
        }
    }
    SEAM(6);
    if (IN(7)) {
        constexpr int nM = (R + 247) / 248;
        pg8::Gemm g{(const bf16_t*)(ws + WS_HB) - 2 * DM, (const bf16_t*)(ws + WS_WUP), nM, NUP / 256, DM, 62};
        pg8::StaticOrder S; S.init(g.nM, g.nN, G, bx);
        const int nfull = (nM * (NUP / 256)) % G;
        EpiUp E{(bf16_t*)(ws + WS_ACT), (const float*)(ws + WS_RSTD3), a.in[I_FCW], a.in[I_FCB], a.in[I_CFFN], a.out + O_FFNP, a.out + O_FFNS, lds + 131072};
        pg8::gemm_phase<EpiUp>(lds, g, S, E);
        if (nfull == 0 || G - nfull < 8) up_fixup(a, lds, bx, G, tid, wave, lane);
        else if (bx >= nfull) up_fixup(a, lds, bx - nfull, G - nfull, tid, wave, lane);
    }
    SEAM(7);
    if (IN(8)) {
        pg8::Gemm g{(const bf16_t*)(ws + WS_ACT), (const bf16_t*)(ws + WS_WDOWN), RP / 256, DM / 256, DFF, 64};
        pg8::StaticOrder S; S.init(g.nM, g.nN, G, bx);
        EpiSq E{(bf16_t*)(ws + WS_FFN), (float*)(ws + WS_SUMSQ4), DM};
        pg8::gemm_phase<EpiSq>(lds, g, S, E);
        mini_gemm<1>(lds, (const bf16_t*)(ws + WS_ACT) + (size_t)RP * DFF, (const bf16_t*)(ws + WS_WDOWN), DFF, DM, (bf16_t*)(ws + WS_FFN) + (size_t)RP * DM, DM, nullptr, (float*)(ws + WS_SUMSQ4) + RP, bx, G, tid, wave, lane);
    }
    SEAM(8);
    if (IN(9)) {
        const bf16_t* ffn = (const bf16_t*)(ws + WS_FFN); const float* s4 = (const float*)(ws + WS_SUMSQ4); const bf16_t* hb = (const bf16_t*)(ws + WS_HB);
        const float* pw = a.in[I_POSTFFN];
        f32x4 w4[4];
#pragma unroll
        for (int q = 0; q < 4; ++q) w4[q] = *(const f32x4*)(pw + q * 256 + lane * 4);
        for (int row0 = 2 * gw; row0 < R; row0 += 2 * NGW) {
            u32x2 hh[2][4], mm[2][4]; float rs[2];
#pragma unroll
            for (int rr = 0; rr < 2; ++rr) { const int row = row0 + rr; rs[rr] = s4[row];
#pragma unroll
                for (int q = 0; q < 4; ++q) { hh[rr][q] = *(const u32x2*)(hb + (size_t)row * DM + q * 256 + lane * 4); mm[rr][q] = *(const u32x2*)(ffn + (size_t)row * DM + q * 256 + lane * 4); } }
#pragma unroll
            for (int rr = 0; rr < 2; ++rr) { const int row = row0 + rr;
                float* yr = row < RP ? a.out + O_YP + (size_t)row * DM : a.out + O_YS + (size_t)(row - RP) * DM;
                const float r_ = 1.f / sqrtf(rs[rr] * (1.f / DM) + EPS);
#pragma unroll
                for (int q = 0; q < 4; ++q) { const u32x2 h2 = hh[rr][q], m2 = mm[rr][q];
                    f32x4 o; o[0] = bf2f(h2.x & 0xffff) + bf2f(m2.x & 0xffff) * r_ * w4[q][0]; o[1] = bf2f(h2.x >> 16) + bf2f(m2.x >> 16) * r_ * w4[q][1];
                    o[2] = bf2f(h2.y & 0xffff) + bf2f(m2.y & 0xffff) * r_ * w4[q][2]; o[3] = bf2f(h2.y >> 16) + bf2f(m2.y >> 16) * r_ * w4[q][3];
                    __builtin_nontemporal_store(o, (f32x4*)(yr + q * 256 + lane * 4)); } }
        }
    }
}

constexpr int NPHASE = 10;
extern "C" void kernel_launch(void* const* d_in, const int* in_sizes, int n_in, void* d_out, int out_size, void* d_ws, size_t ws_size, hipStream_t stream) {
    static int grid = 0;
    if (grid == 0) {
        if (n_in != 33 || ws_size < WS_END) { fprintf(stderr, "kernel_launch: unexpected n_in %d / ws %zu\n", n_in, ws_size); grid = -1; return; }
        int dev = 0, cus = 0, per_cu = 0;
        hipGetDevice(&dev); hipDeviceGetAttribute(&cus, hipDeviceAttributeMultiprocessorCount, dev);
        hipFuncSetAttribute((const void*)fwd_kernel, hipFuncAttributeMaxDynamicSharedMemorySize, LDS_BYTES);
        hipOccupancyMaxActiveBlocksPerMultiprocessor(&per_cu, (const void*)fwd_kernel, 512, LDS_BYTES);
        (void)hipGetLastError();
        if (per_cu < 1) per_cu = 1;
        grid = cus * 1;
    }
    if (grid < 0) return;
    Args a{};
    for (int i = 0; i < 33; ++i) a.in[i] = (const float*)d_in[i];
    a.out = (float*)d_out; a.ws = (unsigned char*)d_ws;
#if ONE_LAUNCH
    (void)hipMemsetAsync((char*)d_ws + WS_BAR, 0, 16384, stream);
    a.ph_lo = 0; a.ph_hi = NPHASE;
    void* args[] = {&a};
    hipError_t e = hipLaunchCooperativeKernel((const void*)fwd_kernel, dim3(grid), dim3(512), args, LDS_BYTES, stream);
    if (e != hipSuccess) fprintf(stderr, "cooperative launch failed: %s (grid %d)\n", hipGetErrorString(e), grid);
#else
#ifndef DUPMASK
#define DUPMASK 0
#endif
    for (int p = 0; p < NPHASE; ++p) { a.ph_lo = p; a.ph_hi = p + 1; for (int rep = 0; rep < (((DUPMASK >> p) & 1) ? 2 : 1); ++rep) hipLaunchKernelGGL(fwd_kernel, dim3(grid), dim3(512), LDS_BYTES, stream, a); }
#endif
}
```

```cpp
#include <hip/hip_runtime.h>
#include <hip/hip_cooperative_groups.h>
#include <cstdio>
namespace cg = cooperative_groups;

#ifndef ONE_LAUNCH
#define ONE_LAUNCH 1
#endif

#define LAS __attribute__((address_space(3)))
typedef unsigned short bf16_t;
typedef short bf16x8 __attribute__((ext_vector_type(8)));
typedef short bf16x4 __attribute__((ext_vector_type(4)));
typedef float f32x4 __attribute__((ext_vector_type(4)));
typedef float f32x16 __attribute__((ext_vector_type(16)));
typedef unsigned u32x4 __attribute__((ext_vector_type(4)));
typedef unsigned u32x2 __attribute__((ext_vector_type(2)));

constexpr int DM = 1024, SEQ = 8192, NBATCH = 8, DSEQ = 32;
constexpr int RP = NBATCH * SEQ;
constexpr int RS = NBATCH * DSEQ;
constexpr int R = RP + RS;
constexpr int NPROJ = 2048;
constexpr int DFF = 2816, NUP = 5632;
constexpr int NCHUNK = 128;
constexpr int NUNITS_BC = NBATCH * NCHUNK + NBATCH;
constexpr float EPS = 1e-6f;

constexpr size_t MiB = 1u << 20;
constexpr size_t WS_BAR = 512 * 1024;
constexpr size_t WS_WDT = 0;
constexpr size_t WS_RSTD1 = 1 * MiB, WS_SUMSQ2 = 1 * MiB + 512 * 1024, WS_RSTD3 = 2 * MiB, WS_SUMSQ4 = 2 * MiB + 512 * 1024;
constexpr size_t WS_DTV = 3 * MiB;
constexpr size_t WS_CDEC = 6 * MiB;
constexpr size_t WS_S5LOC = 7 * MiB, WS_S5HIN = 8 * MiB;
constexpr size_t WS_WIN = 10 * MiB, WS_WOUT = 14 * MiB, WS_WUP = 16 * MiB, WS_WDOWN = 28 * MiB;
constexpr size_t WS_HB = 36 * MiB;
constexpr size_t WS_PROJ = 168 * MiB;
constexpr size_t WS_SST = 426 * MiB;
constexpr size_t WS_MIXIN = 556 * MiB;
constexpr size_t WS_MIX = 686 * MiB;
constexpr size_t WS_ACT = 168 * MiB;
constexpr size_t WS_FFN = 556 * MiB;
constexpr size_t WS_END = 816 * MiB;

constexpr size_t O_YP = 0, O_YS = O_YP + (size_t)RP * DM, O_CONVP = O_YS + (size_t)RS * DM, O_SSDP = O_CONVP + 8 * 3 * 1024,
                 O_S5REP = O_SSDP + 8 * 8 * 64 * 128, O_S5IMP = O_S5REP + 8 * 32 * 64, O_FFNP = O_S5IMP + 8 * 32 * 64,
                 O_CONVS = O_FFNP + 8 * 2 * NUP, O_SSDS = O_CONVS + 8 * 3 * 1024, O_S5RES = O_SSDS + 8 * 8 * 64 * 128,
                 O_S5IMS = O_S5RES + 8 * 32 * 64, O_FFNS = O_S5IMS + 8 * 32 * 64;

struct Args {
    const float* in[33];
    float* out; unsigned char* ws;
    int ph_lo, ph_hi;
};
enum { I_XP = 0, I_XS, I_CSSD, I_SSSD, I_S5RE, I_S5IM, I_CFFN, I_PREMIX, I_WIN, I_SCW, I_SCB, I_DTB, I_ALOG, I_SSDD, I_SNW,
       I_LRE, I_LIM, I_LDT, I_BRE, I_BIM, I_CRE, I_CIM, I_S5D, I_GLUW, I_GLUB, I_WOUT, I_POSTMIX, I_PREFFN, I_WUP, I_FCW, I_FCB, I_WDOWN, I_POSTFFN };

__device__ __forceinline__ float bf2f(unsigned v) { return __uint_as_float(v << 16); }
__device__ __forceinline__ unsigned f2bf(float f) { unsigned u = __float_as_uint(f); return (u + 0x7fffu + ((u >> 16) & 1u)) >> 16; }
typedef __bf16 hwbf2 __attribute__((ext_vector_type(2)));
typedef float f32x2 __attribute__((ext_vector_type(2)));
__device__ __forceinline__ unsigned pk2(float lo, float hi) { f32x2 v; v.x = lo; v.y = hi; return __builtin_bit_cast(unsigned, __builtin_convertvector(v, hwbf2)); }
template <int CTRL, int RM> __device__ __forceinline__ float dpp_get(float v) { return __builtin_bit_cast(float, __builtin_amdgcn_update_dpp(0, __builtin_bit_cast(int, v), CTRL, RM, 0xF, false)); }
__device__ __forceinline__ float wave_sum(float v) {
    v += dpp_get<0xB1, 0xF>(v);
    v += dpp_get<0x4E, 0xF>(v);
    v += dpp_get<0x141, 0xF>(v);
    v += dpp_get<0x140, 0xF>(v);
    v += dpp_get<0x142, 0xA>(v);
    v += dpp_get<0x143, 0xC>(v);
    return __builtin_bit_cast(float, __builtin_amdgcn_readlane(__builtin_bit_cast(int, v), 63));
}
__device__ __forceinline__ float silu_f(float v) { return v * __builtin_amdgcn_rcpf(1.f + __builtin_amdgcn_exp2f(-1.4426950409f * v)); }
__device__ __forceinline__ float gelu_tanh(float v) {
    const float w = v * (-2.3022082f + -0.1029432f * (v * v));
    return v * __builtin_amdgcn_rcpf(1.f + __builtin_amdgcn_exp2f(w));
}

namespace pg8 {
constexpr int BM = 256, BK = 64, HALF = 128, HTB = HALF * BK * 2, STAGE_BYTES = 8 * HTB, NXCD = 8, WGM = 8;
__host__ __device__ __forceinline__ int lds_byte(int r, int c) { const int st = (r >> 4) * 2 + (c >> 5), rr = r & 15, cc = c & 31, ob = rr * 64 + cc * 2; return st * 1024 + (ob ^ (((ob >> 9) & 1) << 5)); }
__host__ __device__ __forceinline__ void stage_rc(int b, int& R_, int& C) { const int st = b / 1024, sb = b % 1024, swz = sb ^ (((sb >> 9) & 1) << 5); R_ = (st >> 1) * 16 + swz / 64; C = (st & 1) * 32 + (swz % 64) / 2; }
__host__ __device__ __forceinline__ int perm32(int rho) { const int n = rho >> 4, i = rho & 15; return 8 * (i >> 2) + 4 * n + (i & 3); }
struct Unit { int pm, pn; };
struct Gemm { const bf16_t* A; const bf16_t* Bt; int nM, nN, K, rp64; };
struct StaticOrder {
    int nM, nN, nwg, G, c;
    __device__ void init(int nM_, int nN_, int G_, int c_) { nM = nM_; nN = nN_; nwg = nM * nN; G = G_; c = c_; }
    __device__ bool next(int i, Unit& u) const {
        const long L = (long)i * G + c; if (L >= nwg) return false;
        int wgid = (int)L; { const int q = nwg / NXCD, r = nwg % NXCD, xcd = wgid % NXCD, off = wgid / NXCD; wgid = (xcd < r ? xcd * (q + 1) : r * (q + 1) + (xcd - r) * q) + off; }
        const int nig = WGM * nN, gid = wgid / nig, fm = gid * WGM, gsz = (nM - fm) < WGM ? (nM - fm) : WGM;
        u.pm = fm + ((wgid % nig) % gsz); u.pn = (wgid % nig) / gsz; return true;
    }
};

template <class Epi>
__device__ __forceinline__ void gemm_phase(LAS unsigned char* lds, const Gemm g, const StaticOrder& S, const Epi& E) {
    const int tid = threadIdx.x, wid = __builtin_amdgcn_readfirstlane(tid >> 6), lane = tid & 63, wr = wid >> 2, wc = wid & 3, fr = lane & 15, fq = lane >> 4;
    const int K = g.K, nt = K / BK;
    unsigned voffA[2], voffB[2];
#pragma unroll
    for (int i = 0; i < 2; ++i) { int R_, C; stage_rc(tid * 16 + i * 8192, R_, C); const int Rb = Epi::PERM ? ((R_ & ~31) + perm32(R_ & 31)) : R_;
        const int Ra = (R_ >> 6) * g.rp64 + (R_ & 63);
        voffA[i] = (unsigned)(Ra * K + C) * 2u; voffB[i] = (unsigned)(Rb * K + C) * 2u; }
    const size_t kstep = (size_t)(BK * 2);
    const size_t hstepB = (size_t)HALF * K * 2, tstepB = 2 * hstepB;
    const size_t hstepA = (size_t)2 * g.rp64 * K * 2, tstepA = 2 * hstepA;
    const unsigned ldsw = (unsigned)wid * 1024u;
    const int aoff = lds_byte(wr * 64 + fr, fq * 8), boff = lds_byte(wc * 32 + fr, fq * 8);
#define PG8_SA(b, h) (((b) * 2 + (h)) * HTB)
#define PG8_SB(b, h) ((4 + (b) * 2 + (h)) * HTB)
#define PG8_STAGE(bufoff, gbase, voff) do { _Pragma("unroll") for (int _i = 0; _i < 2; ++_i) \
        __builtin_amdgcn_global_load_lds((const unsigned*)((const char*)(gbase) + (voff)[_i]), (LAS unsigned*)(lds + (bufoff) + ldsw + _i * 8192), 16, 0, 0); } while (0)
#define PG8_LDA(dst, b, h) do { _Pragma("unroll") for (int m = 0; m < 4; ++m) _Pragma("unroll") for (int k = 0; k < 2; ++k) dst[m][k] = *(const LAS bf16x8*)(lds + PG8_SA(b, h) + aoff + m * 2048 + k * 1024); } while (0)
#define PG8_LDB(dst, b, h) do { _Pragma("unroll") for (int n = 0; n < 2; ++n) _Pragma("unroll") for (int k = 0; k < 2; ++k) dst[n][k] = *(const LAS bf16x8*)(lds + PG8_SB(b, h) + boff + n * 2048 + k * 1024); } while (0)
#define PG8_MMA(ai, bj, At, Bt) do { __builtin_amdgcn_s_setprio(1); _Pragma("unroll") for (int m = 0; m < 4; ++m) _Pragma("unroll") for (int n = 0; n < 2; ++n) _Pragma("unroll") for (int k = 0; k < 2; ++k) \
        acc[ai][bj][m][n] = __builtin_amdgcn_mfma_f32_16x16x32_bf16(Bt[n][k], At[m][k], acc[ai][bj][m][n], 0, 0, 0); __builtin_amdgcn_s_setprio(0); } while (0)
#define PG8_WAIT_V(n) asm volatile("s_waitcnt vmcnt(" #n ")" ::: "memory")
#define PG8_WAIT_L(n) asm volatile("s_waitcnt lgkmcnt(" #n ")" ::: "memory")
#define PG8_BAR __builtin_amdgcn_s_barrier()
#define PG8_SCHED __builtin_amdgcn_sched_barrier(0)
    Unit cur, nxt; int ui = 0;
    if (!S.next(0, cur)) return;
    f32x4 acc[2][2][4][2];
#pragma unroll
    for (int a = 0; a < 2; ++a)
#pragma unroll
        for (int b = 0; b < 2; ++b)
#pragma unroll
            for (int m = 0; m < 4; ++m)
#pragma unroll
                for (int n = 0; n < 2; ++n) acc[a][b][m][n] = (f32x4){0.f, 0.f, 0.f, 0.f};
    bf16x8 At[4][2], B0[2][2], B1[2][2];
    const char* cA = (const char*)g.A + (size_t)cur.pm * tstepA; const char* cB = (const char*)g.Bt + (size_t)cur.pn * tstepB;
    PG8_STAGE(PG8_SB(0, 0), cB, voffB); PG8_STAGE(PG8_SA(0, 0), cA, voffA); PG8_STAGE(PG8_SB(0, 1), cB + hstepB, voffB); PG8_STAGE(PG8_SA(0, 1), cA + hstepA, voffA);
    if (wr == 1) PG8_BAR;
    PG8_WAIT_V(4); PG8_BAR;
    PG8_STAGE(PG8_SB(1, 0), cB + kstep, voffB); PG8_STAGE(PG8_SA(1, 0), cA + kstep, voffA); PG8_STAGE(PG8_SB(1, 1), cB + hstepB + kstep, voffB);
    PG8_WAIT_V(6); PG8_BAR;
    for (;;) {
        const bool has_next = S.next(ui + 1, nxt);
        const char* nA = has_next ? (const char*)g.A + (size_t)nxt.pm * tstepA : cA; const char* nB = has_next ? (const char*)g.Bt + (size_t)nxt.pn * tstepB : cB;
        for (int t = 0; t < nt; t += 2) {
            const bool last = (t == nt - 2);
            const char* a1 = cA + (size_t)(t + 1) * kstep;
            const char* a2 = last ? nA : cA + (size_t)(t + 2) * kstep; const char* b2 = last ? nB : cB + (size_t)(t + 2) * kstep;
            const char* a3 = a2 + kstep; const char* b3 = b2 + kstep;
            PG8_LDB(B0, 0, 0); PG8_SCHED; PG8_LDA(At, 0, 0); PG8_STAGE(PG8_SA(1, 1), a1 + hstepA, voffA);
            PG8_WAIT_L(8); PG8_BAR; PG8_WAIT_L(0); PG8_MMA(0, 0, At, B0); PG8_BAR; PG8_SCHED;
            PG8_LDB(B1, 0, 1); PG8_STAGE(PG8_SB(0, 0), b2, voffB);
            PG8_BAR; PG8_WAIT_L(0); PG8_MMA(0, 1, At, B1); PG8_BAR;
            PG8_LDA(At, 0, 1); PG8_STAGE(PG8_SA(0, 0), a2, voffA);
            PG8_BAR; PG8_WAIT_L(0); PG8_MMA(1, 0, At, B0); PG8_BAR; PG8_SCHED;
            PG8_STAGE(PG8_SB(0, 1), b2 + hstepB, voffB);
            PG8_WAIT_V(6); PG8_BAR; PG8_MMA(1, 1, At, B1); PG8_BAR;
            PG8_LDB(B0, 1, 0); PG8_SCHED; PG8_LDA(At, 1, 0); PG8_STAGE(PG8_SA(0, 1), a2 + hstepA, voffA);
            PG8_WAIT_L(8); PG8_BAR; PG8_WAIT_L(0); PG8_MMA(0, 0, At, B0); PG8_BAR; PG8_SCHED;
            PG8_LDB(B1, 1, 1); PG8_STAGE(PG8_SB(1, 0), b3, voffB);
            PG8_BAR; PG8_WAIT_L(0); PG8_MMA(0, 1, At, B1); PG8_BAR;
            PG8_LDA(At, 1, 1); PG8_STAGE(PG8_SA(1, 0), a3, voffA);
            PG8_BAR; PG8_WAIT_L(0); PG8_MMA(1, 0, At, B0); PG8_BAR; PG8_SCHED;
            PG8_STAGE(PG8_SB(1, 1), b3 + hstepB, voffB);
            PG8_WAIT_V(6); PG8_BAR; PG8_MMA(1, 1, At, B1); PG8_BAR;
        }
        E(acc, cur, wr, wc, fr, fq);
        if (!has_next) break;
#pragma unroll
        for (int a = 0; a < 2; ++a)
#pragma unroll
            for (int b = 0; b < 2; ++b)
#pragma unroll
                for (int m = 0; m < 4; ++m)
#pragma unroll
                    for (int n = 0; n < 2; ++n) acc[a][b][m][n] = (f32x4){0.f, 0.f, 0.f, 0.f};
        cur = nxt; cA = nA; cB = nB; ++ui;
    }
    PG8_WAIT_V(0);
    if (wr == 0) PG8_BAR;
    PG8_BAR;
#undef PG8_SA
#undef PG8_SB
#undef PG8_STAGE
#undef PG8_LDA
#undef PG8_LDB
#undef PG8_MMA
#undef PG8_WAIT_V
#undef PG8_WAIT_L
#undef PG8_BAR
#undef PG8_SCHED
}
}

struct EpiProj {
    static constexpr bool PERM = true;
    bf16_t* O; const float* rstd; int ldc;
    __device__ __forceinline__ void operator()(const f32x4 (&acc)[2][2][4][2], const pg8::Unit& u, int wr, int wc, int fr, int fq) const {
        const int row0 = u.pm * 256 + wr * 64 + fr, col0 = u.pn * 256 + wc * 32 + 8 * fq;
#pragma unroll
        for (int ai = 0; ai < 2; ++ai)
#pragma unroll
            for (int m = 0; m < 4; ++m) { const int row = row0 + ai * 128 + m * 16; const float s = rstd[row]; bf16_t* rowp = O + (size_t)row * ldc + col0;
#pragma unroll
                for (int bj = 0; bj < 2; ++bj) { const f32x4 v0 = acc[ai][bj][m][0] * s, v1 = acc[ai][bj][m][1] * s;
                    u32x4 w; w.x = pk2(v0[0], v0[1]); w.y = pk2(v0[2], v0[3]); w.z = pk2(v1[0], v1[1]); w.w = pk2(v1[2], v1[3]);
                    *(u32x4*)(rowp + bj * 128) = w; } }
    }
};
struct EpiSq {
    static constexpr bool PERM = true;
    bf16_t* O; float* sumsq; int ldc;
    __device__ __forceinline__ void operator()(const f32x4 (&acc)[2][2][4][2], const pg8::Unit& u, int wr, int wc, int fr, int fq) const {
        const int row0 = u.pm * 256 + wr * 64 + fr, col0 = u.pn * 256 + wc * 32 + 8 * fq;
#pragma unroll
        for (int ai = 0; ai < 2; ++ai)
#pragma unroll
            for (int m = 0; m < 4; ++m) { const int row = row0 + ai * 128 + m * 16; bf16_t* rowp = O + (size_t)row * ldc + col0; float ss = 0.f;
#pragma unroll
                for (int bj = 0; bj < 2; ++bj) { const f32x4 v0 = acc[ai][bj][m][0], v1 = acc[ai][bj][m][1];
                    ss += (v0[0] * v0[0] + v0[1] * v0[1]) + (v0[2] * v0[2] + v0[3] * v0[3]) + (v1[0] * v1[0] + v1[1] * v1[1]) + (v1[2] * v1[2] + v1[3] * v1[3]);
                    u32x4 w; w.x = pk2(v0[0], v0[1]); w.y = pk2(v0[2], v0[3]); w.z = pk2(v1[0], v1[1]); w.w = pk2(v1[2], v1[3]);
                    *(u32x4*)(rowp + bj * 128) = w; }
                ss += __shfl_xor(ss, 16); ss += __shfl_xor(ss, 32);
                if (fq == 0) atomicAdd(sumsq + row, ss); }
    }
};
constexpr int SLAB_LD = 40, SLAB_BYTES = 64 * SLAB_LD;
struct EpiUp {
    static constexpr bool PERM = true;
    bf16_t* act; const float* rstd3; const float* cw; const float* cb; const float* cache; float* outp; float* outs; LAS unsigned char* xl;
    __device__ __forceinline__ void operator()(const f32x4 (&acc)[2][2][4][2], const pg8::Unit& u, int wr, int wc, int fr_, int fq_) const {
        int fr = fr_, fq = fq_; asm volatile("" : "+v"(fr), "+v"(fq));
        LAS unsigned char* slab = xl + (wr * 4 + wc) * SLAB_BYTES;
        const int lane = fq * 16 + fr, cq = lane & 3, rs = lane >> 2;
        const int j0 = u.pn * 128 + wc * 32 + 8 * cq;
        float sc[2][4];
#pragma unroll
        for (int ai = 0; ai < 2; ++ai)
#pragma unroll
            for (int m = 0; m < 4; ++m) { const int row = 248 * u.pm + 62 * (2 * ai + wr) - 2 + 16 * m + fr; const int rc = row < 0 ? 0 : (row < R ? row : R - 1); const float sv = rstd3[rc]; sc[ai][m] = (row >= 0 && row < R) ? sv : 0.f; }
        f32x4 wn[4];
        { const int colb = j0; wn[0] = *(const f32x4*)(cw + colb); wn[1] = *(const f32x4*)(cw + NUP + colb); wn[2] = *(const f32x4*)(cw + 2 * NUP + colb); wn[3] = *(const f32x4*)(cb + colb); }
        float cgv[4][4];
#pragma unroll
        for (int sp = 0; sp < 8; ++sp) {
            const int ai = sp >> 2, n = (sp >> 1) & 1, bj = sp & 1;
            const int rowbase = 248 * u.pm + 62 * (2 * ai + wr) - 2;
            const f32x4 w0 = wn[0], w1 = wn[1], w2 = wn[2], bb = wn[3];
            if (sp < 7) { const int sq = sp + 1, n2 = (sq >> 1) & 1, bj2 = sq & 1, colb = bj2 * DFF + j0 + 4 * n2;
                wn[0] = *(const f32x4*)(cw + colb); wn[1] = *(const f32x4*)(cw + NUP + colb); wn[2] = *(const f32x4*)(cw + 2 * NUP + colb); wn[3] = *(const f32x4*)(cb + colb); }
#pragma unroll
            for (int m = 0; m < 4; ++m) { const f32x4 v = acc[ai][bj][m][n] * sc[ai][m];
                u32x2 w; w.x = pk2(v[0], v[1]); w.y = pk2(v[2], v[3]); *(LAS u32x2*)(slab + (16 * m + fr) * SLAB_LD + fq * 8) = w; }
            f32x4 p2, p1;
            { const int h1 = rs > 0 ? 4 * rs - 1 : 0, h2 = rs > 0 ? 4 * rs - 2 : 0;
                const u32x2 q1 = *(const LAS u32x2*)(slab + h1 * SLAB_LD + cq * 8), q2 = *(const LAS u32x2*)(slab + h2 * SLAB_LD + cq * 8);
                p1[0] = bf2f(q1.x & 0xffff); p1[1] = bf2f(q1.x >> 16); p1[2] = bf2f(q1.y & 0xffff); p1[3] = bf2f(q1.y >> 16);
                p2[0] = bf2f(q2.x & 0xffff); p2[1] = bf2f(q2.x >> 16); p2[2] = bf2f(q2.y & 0xffff); p2[3] = bf2f(q2.y >> 16); }
#pragma unroll
            for (int i = 0; i < 4; ++i) {
                const int lr = 4 * rs + i, row = rowbase + lr;
                const u32x2 q0 = *(const LAS u32x2*)(slab + lr * SLAB_LD + cq * 8);
                f32x4 cur; cur[0] = bf2f(q0.x & 0xffff); cur[1] = bf2f(q0.x >> 16); cur[2] = bf2f(q0.y & 0xffff); cur[3] = bf2f(q0.y >> 16);
                const bool smp = row >= RP;
                const int t = smp ? ((row - RP) & (DSEQ - 1)) : (row & (SEQ - 1));
                const bool valid = (lr >= 2) && (row < R) && (t >= 2);
                const f32x4 cv = bb + w0 * p2 + w1 * p1 + w2 * cur;
                p2 = p1; p1 = cur;
                if (bj == 0) { cgv[i][0] = cv[0]; cgv[i][1] = cv[1]; cgv[i][2] = cv[2]; cgv[i][3] = cv[3]; }
                else { u32x2 w; w.x = pk2(gelu_tanh(cgv[i][0]) * cv[0], gelu_tanh(cgv[i][1]) * cv[1]); w.y = pk2(gelu_tanh(cgv[i][2]) * cv[2], gelu_tanh(cgv[i][3]) * cv[3]); if (valid) *(u32x2*)(act + (size_t)row * DFF + j0 + 4 * n) = w; }
            }
        }
    }
};

template <int MODE>
__device__ __forceinline__ void mini_gemm(LAS unsigned char* lds, const bf16_t* A, const bf16_t* Bt, int K, int N, bf16_t* O, int ldc, const float* rstd, float* sumsq, int bx, int G, int tid, int wave, int lane) {
    const int r = lane & 31, hf = lane >> 5, ntn = N >> 5, ntiles = 8 * ntn, kw = K >> 3;
    LAS float* red = (LAS float*)lds;
    for (int tile = bx; tile < ntiles; tile += G) {
        const int m0 = (tile / ntn) * 32, n0 = (tile % ntn) * 32;
        const bf16_t* ap = A + (size_t)(m0 + r) * K + wave * kw + 8 * hf; const bf16_t* bp = Bt + (size_t)(n0 + r) * K + wave * kw + 8 * hf;
        f32x16 acc; for (int i = 0; i < 16; ++i) acc[i] = 0.f;
        for (int k = 0; k < kw; k += 16) { const bf16x8 af = *(const bf16x8*)(ap + k), bf = *(const bf16x8*)(bp + k); acc = __builtin_amdgcn_mfma_f32_32x32x16_bf16(af, bf, acc, 0, 0, 0); }
        __syncthreads();
#pragma unroll
        for (int i = 0; i < 16; ++i) red[(wave * 16 + i) * 64 + lane] = acc[i];
        __syncthreads();
#pragma unroll
        for (int h2 = 0; h2 < 2; ++h2) {
            const int e = tid + h2 * 512, i = e >> 6, ln = e & 63;
            float v = 0.f;
#pragma unroll
            for (int w = 0; w < 8; ++w) v += red[(w * 16 + i) * 64 + ln];
            const int row = m0 + (i & 3) + 8 * (i >> 2) + 4 * (ln >> 5), col = n0 + (ln & 31);
            if (MODE == 0) { O[(size_t)row * ldc + col] = (bf16_t)f2bf(v * rstd[row]); }
            else { O[(size_t)row * ldc + col] = (bf16_t)f2bf(v); float ss = v * v;
#pragma unroll
                for (int o = 1; o < 32; o <<= 1) ss += __shfl_xor(ss, o);
                if ((ln & 31) == 0) atomicAdd(sumsq + row, ss); }
        }
    }
    __syncthreads();
}

__device__ __forceinline__ int fix_row(int m) { const int sq = m >> 2, k4 = m & 3; return sq < 8 ? sq * SEQ + (k4 < 2 ? k4 : SEQ - 4 + k4) : RP + (sq - 8) * DSEQ + (k4 < 2 ? k4 : DSEQ - 4 + k4); }
__device__ __forceinline__ void up_fixup(const Args& a, LAS unsigned char* lds, int bx, int G, int tid, int wave, int lane) {
    const int r = lane & 31, hf = lane >> 5;
    LAS float* red = (LAS float*)lds;
    LAS float* tile = (LAS float*)(lds + 65536);
    const bf16_t* hb = (const bf16_t*)(a.ws + WS_HB); const bf16_t* W = (const bf16_t*)(a.ws + WS_WUP); const float* rstd3 = (const float*)(a.ws + WS_RSTD3);
    for (int item = bx; item < 176; item += G) {
        const int mt = item / 88, cp = item % 88, pn = cp >> 2, sub = cp & 3;
        const bf16_t* ap = hb + (size_t)fix_row(mt * 32 + r) * DM + wave * 128 + 8 * hf;
        const bf16_t* bg = W + (size_t)(256 * pn + 32 * sub + r) * DM + wave * 128 + 8 * hf; const bf16_t* bv = bg + (size_t)128 * DM;
        f32x16 ag, av; for (int i = 0; i < 16; ++i) { ag[i] = 0.f; av[i] = 0.f; }
#pragma unroll
        for (int k = 0; k < 128; k += 16) { const bf16x8 af = *(const bf16x8*)(ap + k); ag = __builtin_amdgcn_mfma_f32_32x32x16_bf16(af, *(const bf16x8*)(bg + k), ag, 0, 0, 0); av = __builtin_amdgcn_mfma_f32_32x32x16_bf16(af, *(const bf16x8*)(bv + k), av, 0, 0, 0); }
        __syncthreads();
#pragma unroll
        for (int i = 0; i < 16; ++i) { red[((wave * 2 + 0) * 16 + i) * 64 + lane] = ag[i]; red[((wave * 2 + 1) * 16 + i) * 64 + lane] = av[i]; }
        __syncthreads();
#pragma unroll
        for (int h4 = 0; h4 < 4; ++h4) {
            const int e = tid + h4 * 512, gv = e >> 10, i = (e >> 6) & 15, ln = e & 63;
            float v = 0.f;
#pragma unroll
            for (int w = 0; w < 8; ++w) v += red[((w * 2 + gv) * 16 + i) * 64 + ln];
            const int ml = (i & 3) + 8 * (i >> 2) + 4 * (ln >> 5);
            tile[(gv * 32 + ml) * 32 + (ln & 31)] = v * rstd3[fix_row(mt * 32 + ml)];
        }
        __syncthreads();
        {
            const int q = tid >> 6, c = tid & 31, part = (tid >> 5) & 1, m0 = 4 * q, b = q;
            const int j = 128 * pn + 32 * sub + c;
            if (part == 0) {
                const float* cw = a.in[I_FCW]; const float* cb = a.in[I_FCB];
                const float ug0 = tile[(m0) * 32 + c], ug1 = tile[(m0 + 1) * 32 + c], uv0 = tile[(32 + m0) * 32 + c], uv1 = tile[(32 + m0 + 1) * 32 + c];
                float hg0 = 0.f, hg1 = 0.f, hv0 = 0.f, hv1 = 0.f;
                if (mt) { const float* ch = a.in[I_CFFN] + (size_t)(b * 2) * NUP; hg0 = ch[j]; hg1 = ch[NUP + j]; hv0 = ch[DFF + j]; hv1 = ch[NUP + DFF + j]; }
                const float wg0 = cw[j], wg1 = cw[NUP + j], wg2 = cw[2 * NUP + j], bgg = cb[j], wv0 = cw[DFF + j], wv1 = cw[NUP + DFF + j], wv2 = cw[2 * NUP + DFF + j], bvv = cb[DFF + j];
                const float cg0 = bgg + wg0 * hg0 + wg1 * hg1 + wg2 * ug0, cv0 = bvv + wv0 * hv0 + wv1 * hv1 + wv2 * uv0;
                const float cg1 = bgg + wg0 * hg1 + wg1 * ug0 + wg2 * ug1, cv1 = bvv + wv0 * hv1 + wv1 * uv0 + wv2 * uv1;
                bf16_t* act = (bf16_t*)(a.ws + WS_ACT);
                const int row0 = fix_row(mt * 32 + m0);
                act[(size_t)row0 * DFF + j] = (bf16_t)f2bf(gelu_tanh(cg0) * cv0); act[(size_t)(row0 + 1) * DFF + j] = (bf16_t)f2bf(gelu_tanh(cg1) * cv1);
            } else {
                float* op = (mt ? a.out + O_FFNS : a.out + O_FFNP) + (size_t)(b * 2) * NUP;
                op[j] = tile[(m0 + 2) * 32 + c]; op[NUP + j] = tile[(m0 + 3) * 32 + c]; op[DFF + j] = tile[(32 + m0 + 2) * 32 + c]; op[NUP + DFF + j] = tile[(32 + m0 + 3) * 32 + c];
            }
        }
    }
    __syncthreads();
}

__device__ __forceinline__ void transpose_item(const float* W, int ldw, int K, bf16_t* WT, const float* kscale, LAS float* scr, int k0, int srccol0, int dstrow0, int lane) {
#pragma unroll 8
    for (int i = 0; i < 32; ++i) { const int kk = 2 * i + (lane >> 5); float v = W[(size_t)(k0 + kk) * ldw + srccol0 + (lane & 31)]; if (kscale) v *= kscale[k0 + kk]; scr[kk * 33 + (lane & 31)] = v; }
    asm volatile("s_waitcnt lgkmcnt(0)" ::: "memory");
    const int c = lane & 7;
#pragma unroll
    for (int j = 0; j < 4; ++j) { const int n = (lane >> 3) + 8 * j; const LAS float* s = scr + (8 * c) * 33 + n;
        u32x4 o; o.x = pk2(s[0 * 33], s[1 * 33]); o.y = pk2(s[2 * 33], s[3 * 33]); o.z = pk2(s[4 * 33], s[5 * 33]); o.w = pk2(s[6 * 33], s[7 * 33]);
        *(u32x4*)(WT + (size_t)(dstrow0 + n) * K + k0 + 8 * c) = o; }
    asm volatile("s_waitcnt lgkmcnt(0)" ::: "memory");
}

__device__ __forceinline__ void p0_prologue(const Args& a, LAS unsigned char* lds, int gw, int NGW, int lane, int wave) {
    unsigned char* ws = a.ws;
    LAS float* scr = (LAS float*)(lds + wave * 16384);
    bf16_t* WinT = (bf16_t*)(ws + WS_WIN); bf16_t* WoutT = (bf16_t*)(ws + WS_WOUT); bf16_t* WupT = (bf16_t*)(ws + WS_WUP); bf16_t* WdownT = (bf16_t*)(ws + WS_WDOWN);
    constexpr int I_IN = 16 * 64, I_OUT = 16 * 32, I_UP = 16 * 176, I_DOWN = 44 * 32, NIT = I_IN + I_OUT + I_UP + I_DOWN;
    for (int it = gw; it < NIT; it += NGW) {
        int r = it;
        if (r < I_IN) { const int kb = r / 64, nb = r % 64; const int dst = nb * 32; const int src = dst < 1536 ? dst : dst + 8;
            transpose_item(a.in[I_WIN], 2056, 1024, WinT, a.in[I_PREMIX], scr, kb * 64, src, dst, lane); continue; }
        r -= I_IN;
        if (r < I_OUT) { const int kb = r / 32, nb = r % 32; transpose_item(a.in[I_WOUT], 1024, 1024, WoutT, nullptr, scr, kb * 64, nb * 32, nb * 32, lane); continue; }
        r -= I_OUT;
        if (r < I_UP) { const int kb = r / 176, nb = r % 176; const int dst = nb * 32; const int pn = dst >> 8, i = dst & 255; const int src = i < 128 ? pn * 128 + i : DFF + pn * 128 + (i - 128);
            transpose_item(a.in[I_WUP], NUP, 1024, WupT, a.in[I_PREFFN], scr, kb * 64, src, dst, lane); continue; }
        r -= I_UP;
        { const int kb = r / 32, nb = r % 32; transpose_item(a.in[I_WDOWN], 1024, DFF, WdownT, nullptr, scr, kb * 64, nb * 32, nb * 32, lane); }
    }
    { float* s2 = (float*)(ws + WS_SUMSQ2); float* s4 = (float*)(ws + WS_SUMSQ4);
      for (int i = gw * 64 + lane; i < R; i += NGW * 64) { s2[i] = 0.f; s4[i] = 0.f; } }
    float wd[8][16];
    { const float* Win = a.in[I_WIN]; const float* pw = a.in[I_PREMIX];
#pragma unroll
      for (int j = 0; j < 8; ++j)
#pragma unroll
          for (int q = 0; q < 4; ++q)
#pragma unroll
              for (int e = 0; e < 4; ++e) { const int k = q * 256 + lane * 4 + e; wd[j][q * 4 + e] = Win[(size_t)k * 2056 + 1536 + j] * pw[k]; } }
    bf16_t* xb = (bf16_t*)(ws + WS_HB); float* rstd1 = (float*)(ws + WS_RSTD1); float* dtv = (float*)(ws + WS_DTV);
    const float* dtb = a.in[I_DTB];
    for (int row0 = 2 * gw; row0 < R; row0 += 2 * NGW) {
        f32x4 vv[2][4];
#pragma unroll
        for (int rr = 0; rr < 2; ++rr) { const int row = row0 + rr;
            const float* xr = row < RP ? a.in[I_XP] + (size_t)row * DM : a.in[I_XS] + (size_t)(row - RP) * DM;
#pragma unroll
            for (int q = 0; q < 4; ++q) vv[rr][q] = *(const f32x4*)(xr + q * 256 + lane * 4); }
#pragma unroll
        for (int rr = 0; rr < 2; ++rr) { const int row = row0 + rr;
            float ss = 0.f;
#pragma unroll
            for (int q = 0; q < 4; ++q) { const f32x4 v = vv[rr][q]; ss += (v[0] * v[0] + v[1] * v[1]) + (v[2] * v[2] + v[3] * v[3]); }
            ss = wave_sum(ss);
            const float rs = 1.f / sqrtf(ss * (1.f / DM) + EPS);
#pragma unroll
            for (int q = 0; q < 4; ++q) { const f32x4 v = vv[rr][q]; u32x2 w; w.x = pk2(v[0], v[1]); w.y = pk2(v[2], v[3]); *(u32x2*)(xb + (size_t)row * DM + q * 256 + lane * 4) = w; }
            float myd = 0.f;
#pragma unroll
            for (int j = 0; j < 8; ++j) { float d = 0.f;
#pragma unroll
                for (int q = 0; q < 4; ++q)
#pragma unroll
                    for (int e = 0; e < 4; ++e) d += vv[rr][q][e] * wd[j][q * 4 + e];
                d = wave_sum(d);
                if (lane == j) myd = d; }
            if (lane < 8) { const float xx = myd * rs + dtb[lane]; dtv[(size_t)row * 8 + lane] = xx > 20.f ? xx : log1pf(expf(xx)); }
            if (lane == 0) rstd1[row] = rs; }
    }
}

constexpr int XT_LD = 72, BN_LD = 136;
constexpr int L_XT = 0;
constexpr int L_BT = 36864;
constexpr int L_CN = L_BT + 18432;
constexpr int L_CS = L_CN + 17408;
constexpr int L_SSD_END = L_CS + 4 * 4 * 64 * 4;
constexpr int SUB_LDS = L_SSD_END + 64;
__device__ __forceinline__ void sub_barrier(LAS unsigned* cnt, unsigned& target, int lane) {
    asm volatile("s_waitcnt lgkmcnt(0)" ::: "memory");
    target += 4u;
    if (lane == 0) __hip_atomic_fetch_add(cnt, 1u, __ATOMIC_RELAXED, __HIP_MEMORY_SCOPE_WORKGROUP);
    for (;;) { const unsigned v = (unsigned)__builtin_amdgcn_readfirstlane((int)__hip_atomic_load(cnt, __ATOMIC_RELAXED, __HIP_MEMORY_SCOPE_WORKGROUP)); if ((int)(v - target) >= 0) break; __builtin_amdgcn_s_sleep(1); }
    asm volatile("" ::: "memory");
}

struct SeqInfo { int row0; int nreal; int pad; bool smp; int b; int slot; };
__device__ __forceinline__ SeqInfo ssd_unit(int ubc) {
    SeqInfo s;
    if (ubc < NBATCH * NCHUNK) { s.b = ubc >> 7; s.row0 = ubc * 64; s.pad = 0; s.smp = false; }
    else { s.b = ubc - NBATCH * NCHUNK; s.row0 = RP + s.b * DSEQ - 32; s.pad = 32; s.smp = true; }
    s.slot = ubc; s.nreal = 64 - s.pad; return s;
}

__device__ __forceinline__ void ssd_cs(const Args& a, LAS unsigned char* lds, const SeqInfo& si, int g, int lane, int mode, float* cdec) {
    LAS float* cs = (LAS float*)(lds + L_CS); LAS float* dtl = cs + 256; LAS float* aux = cs + 512;
    const float* dtv = (const float*)(a.ws + WS_DTV);
#pragma unroll
    for (int h4 = 0; h4 < 4; ++h4) {
        const int h = g * 4 + h4;
        float d = dtv[(size_t)(si.row0 + lane) * 8 + h]; d = lane >= si.pad ? d : 0.f;
        const float av = -__expf(a.in[I_ALOG][h]);
        float x = d * av;
#pragma unroll
        for (int o = 1; o < 64; o <<= 1) { const float y = __shfl_up(x, o); if (lane >= o) x += y; }
        const float ce = __shfl(x, 63);
        cs[h4 * 64 + lane] = x; dtl[h4 * 64 + lane] = d;
        aux[h4 * 64 + lane] = mode == 0 ? __expf(ce - x) * d : __expf(x);
        if (mode == 0 && lane == 0 && cdec) cdec[(size_t)si.slot * 8 + h] = __expf(ce);
    }
}

__device__ __forceinline__ void raw8(const Args& a, const SeqInfo& si, int tpos  , int tok  , int cch, float (&o)[8]) {
    const bf16_t* proj = (const bf16_t*)(a.ws + WS_PROJ);
    if (tpos >= 0) { const u32x4 w = *(const u32x4*)(proj + (size_t)(si.row0 + tok) * NPROJ + 512 + cch);
        o[0] = bf2f(w.x & 0xffff); o[1] = bf2f(w.x >> 16); o[2] = bf2f(w.y & 0xffff); o[3] = bf2f(w.y >> 16); o[4] = bf2f(w.z & 0xffff); o[5] = bf2f(w.z >> 16); o[6] = bf2f(w.w & 0xffff); o[7] = bf2f(w.w >> 16); }
    else if (si.smp && tpos >= -3) { const float* c = a.in[I_CSSD] + (size_t)(si.b * 3 + (tpos + 3)) * 1024 + cch;
#pragma unroll
        for (int e = 0; e < 8; ++e) o[e] = c[e]; }
    else {
#pragma unroll
        for (int e = 0; e < 8; ++e) o[e] = 0.f; }
}

__device__ __forceinline__ void rowvals(const Args& a, const SeqInfo& si, const u32x4 w, int tpos, int cch, float (&o)[8]) {
    o[0] = bf2f(w.x & 0xffff); o[1] = bf2f(w.x >> 16); o[2] = bf2f(w.y & 0xffff); o[3] = bf2f(w.y >> 16); o[4] = bf2f(w.z & 0xffff); o[5] = bf2f(w.z >> 16); o[6] = bf2f(w.w & 0xffff); o[7] = bf2f(w.w >> 16);
    if (tpos < 0) {
        if (si.smp && tpos >= -3) { const float* c = a.in[I_CSSD] + (size_t)(si.b * 3 + (tpos + 3)) * 1024 + cch;
#pragma unroll
            for (int e = 0; e < 8; ++e) o[e] = c[e]; }
        else {
#pragma unroll
            for (int e = 0; e < 8; ++e) o[e] = 0.f; }
    }
}
__device__ __forceinline__ void ssd_stage(const Args& a, LAS unsigned char* lds, const SeqInfo& si, int g, int c_in_seq, int tid, int mode) {
    const int cg8 = tid & 63;
    if (mode == 0 && cg8 >= 48) return;
    int cch, kind;
    if (cg8 < 32) { kind = 0; cch = g * 256 + cg8 * 8; } else if (cg8 < 48) { kind = 1; cch = 512 + g * 128 + (cg8 - 32) * 8; } else { kind = 2; cch = 768 + g * 128 + (cg8 - 48) * 8; }
    float w[4][8], bias[8];
#pragma unroll
    for (int k = 0; k < 4; ++k) { const f32x4 a0 = *(const f32x4*)(a.in[I_SCW] + k * 1024 + cch), a1 = *(const f32x4*)(a.in[I_SCW] + k * 1024 + cch + 4);
#pragma unroll
        for (int e = 0; e < 4; ++e) { w[k][e] = a0[e]; w[k][4 + e] = a1[e]; } }
    { const f32x4 a0 = *(const f32x4*)(a.in[I_SCB] + cch), a1 = *(const f32x4*)(a.in[I_SCB] + cch + 4);
#pragma unroll
      for (int e = 0; e < 4; ++e) { bias[e] = a0[e]; bias[4 + e] = a1[e]; } }
    const int seq0 = si.smp ? -32 : c_in_seq * 64;
#pragma unroll
    for (int tgi = 0; tgi < 2; ++tgi) {
    const int tg = __builtin_amdgcn_readfirstlane(tid >> 6) + 4 * tgi;
    const int t0 = 8 * tg;
    float r0[8], r1[8], r2[8], r3[8];
    u32x4 rw[11];
    { const bf16_t* pr = (const bf16_t*)(a.ws + WS_PROJ) + (size_t)(si.row0 + t0 - 3) * NPROJ + 512 + cch;
#pragma unroll
      for (int i = 0; i < 11; ++i) rw[i] = *(const u32x4*)(pr + (size_t)i * NPROJ); }
    rowvals(a, si, rw[0], seq0 + t0 - 3, cch, r0); rowvals(a, si, rw[1], seq0 + t0 - 2, cch, r1); rowvals(a, si, rw[2], seq0 + t0 - 1, cch, r2);
    unsigned pk[4][8]; float prev[8];
    const LAS float* aux = (const LAS float*)(lds + L_CS) + 512;
#pragma unroll
    for (int i = 0; i < 8; ++i) {
        rowvals(a, si, rw[3 + i], seq0 + t0 + i, cch, r3);
        const bool real = (t0 + i) >= si.pad;
        float sc = 1.f;
        if (mode == 0) { const float sv = aux[((cg8 >> 3) & 3) * 64 + t0 + i]; sc = kind == 0 ? sv : 1.f; }
#pragma unroll
        for (int e = 0; e < 8; ++e) { const float v = __builtin_fmaf(w[3][e], r3[e], __builtin_fmaf(w[2][e], r2[e], __builtin_fmaf(w[1][e], r1[e], __builtin_fmaf(w[0][e], r0[e], bias[e]))));
            const float ov = real ? silu_f(v) * sc : 0.f; r0[e] = r1[e]; r1[e] = r2[e]; r2[e] = r3[e];
            if (i & 1) pk[i >> 1][e] = pk2(prev[e], ov); else prev[e] = ov; }
    }
    const bool transposed = (kind == 0) || (mode == 0);
    if (transposed) {
        LAS bf16_t* base = kind == 0 ? (LAS bf16_t*)(lds + L_XT) + (cg8 * 8) * XT_LD : (LAS bf16_t*)(lds + L_BT) + ((cg8 - 32) * 8) * XT_LD;
#pragma unroll
        for (int e = 0; e < 8; ++e) { u32x4 o; o.x = pk[0][e]; o.y = pk[1][e]; o.z = pk[2][e]; o.w = pk[3][e];
            *(LAS u32x4*)(base + e * XT_LD + ((tg ^ (cg8 & 7)) << 3)) = o; }
    } else {
        LAS bf16_t* base = kind == 1 ? (LAS bf16_t*)(lds + L_BT) + (cg8 - 32) * 8 : (LAS bf16_t*)(lds + L_CN) + (cg8 - 48) * 8;
#pragma unroll
        for (int q = 0; q < 4; ++q) {
            u32x4 o0, o1;
#pragma unroll
            for (int c2 = 0; c2 < 4; ++c2) { const unsigned lo = pk[q][2 * c2], hi = pk[q][2 * c2 + 1];
                o0[c2] = (lo & 0xffffu) | (hi << 16); o1[c2] = (lo >> 16) | (hi & 0xffff0000u); }
            *(LAS u32x4*)(base + (t0 + 2 * q) * BN_LD) = o0; *(LAS u32x4*)(base + (t0 + 2 * q + 1) * BN_LD) = o1;
        }
    }
    }
}

#define MFMA32(a, b, c) __builtin_amdgcn_mfma_f32_32x32x16_bf16((a), (b), (c), 0, 0, 0)
__device__ __forceinline__ f32x16 zero16() { f32x16 z; for (int i = 0; i < 16; ++i) z[i] = 0.f; return z; }

__device__ __forceinline__ void ssd_passA_unit(const Args& a, LAS unsigned char* lds, int unit, int tid, int w4, int lane, LAS unsigned* bcnt, unsigned& btarget) {
    const int ubc = unit >> 1, g = unit & 1;
    const SeqInfo si = ssd_unit(ubc);
    sub_barrier(bcnt, btarget, lane);
    ssd_cs(a, lds, si, g, lane, 0, w4 == 0 ? (float*)(a.ws + WS_CDEC) : nullptr);
    ssd_stage(a, lds, si, g, ubc & 127, tid, 0);
    sub_barrier(bcnt, btarget, lane);
    const int h4 = w4, r = lane & 31, hf = lane >> 5;
    const LAS bf16_t* XT = (const LAS bf16_t*)(lds + L_XT); const LAS bf16_t* BT = (const LAS bf16_t*)(lds + L_BT);
    bf16_t* sst = (bf16_t*)(a.ws + WS_SST) + ((size_t)si.slot * 8 + g * 4 + h4) * 8192;
#pragma unroll 1
    for (int nh = 0; nh < 2; ++nh) {
        f32x16 acc[2][2]; acc[0][0] = zero16(); acc[0][1] = zero16(); acc[1][0] = zero16(); acc[1][1] = zero16();
#pragma unroll
        for (int ks = 0; ks < 4; ++ks) {
            bf16x8 af[2], bfr[2];
#pragma unroll
            for (int ni = 0; ni < 2; ++ni) af[ni] = *(const LAS bf16x8*)(BT + (nh * 64 + ni * 32 + r) * XT_LD + (((ks * 2 + hf) ^ ((ni * 4 + (r >> 3)) & 7)) << 3));
#pragma unroll
            for (int pj = 0; pj < 2; ++pj) bfr[pj] = *(const LAS bf16x8*)(XT + (h4 * 64 + pj * 32 + r) * XT_LD + (((ks * 2 + hf) ^ ((pj * 4 + (r >> 3)) & 7)) << 3));
#pragma unroll
            for (int ni = 0; ni < 2; ++ni)
#pragma unroll
                for (int pj = 0; pj < 2; ++pj) acc[ni][pj] = MFMA32(af[ni], bfr[pj], acc[ni][pj]);
        }
#pragma unroll
        for (int ni = 0; ni < 2; ++ni)
#pragma unroll
            for (int pj = 0; pj < 2; ++pj)
#pragma unroll
                for (int i = 0; i < 4; ++i) { const int p = pj * 32 + r, n = nh * 64 + ni * 32 + 8 * i + 4 * hf;
                    u32x2 w; w.x = pk2(acc[ni][pj][4 * i], acc[ni][pj][4 * i + 1]); w.y = pk2(acc[ni][pj][4 * i + 2], acc[ni][pj][4 * i + 3]);
                    *(u32x2*)(sst + p * 128 + n) = w; }
    }
}

__device__ __forceinline__ void ssd_passC_unit(const Args& a, LAS unsigned char* lds, int unit, int tid, int w4, int lane, LAS unsigned* bcnt, unsigned& btarget) {
    const int ubc = unit >> 1, g = unit & 1;
    const SeqInfo si = ssd_unit(ubc);
    sub_barrier(bcnt, btarget, lane);
    ssd_cs(a, lds, si, g, lane, 1, nullptr);
    ssd_stage(a, lds, si, g, ubc & 127, tid, 1);
    sub_barrier(bcnt, btarget, lane);
    const int h4 = w4, r = lane & 31, hf = lane >> 5, h = g * 4 + h4;
    const LAS bf16_t* XT = (const LAS bf16_t*)(lds + L_XT) + h4 * 64 * XT_LD; const LAS bf16_t* Bn = (const LAS bf16_t*)(lds + L_BT); const LAS bf16_t* Cn = (const LAS bf16_t*)(lds + L_CN);
    const LAS float* cs = (const LAS float*)(lds + L_CS) + h4 * 64; const LAS float* dtl = cs + 256; const LAS float* ecs = cs + 512; LAS float* red = (LAS float*)(lds + L_CS) + 768;
#pragma unroll 1
    for (int lh = 0; lh < 2; ++lh) {
    const int l = lh * 32 + r;
    const int row = si.row0 + l;
    const bool realtok = l >= si.pad;
    const bf16_t* zrow = (const bf16_t*)(a.ws + WS_PROJ) + (size_t)row * NPROJ + g * 256 + h4 * 64;
    u32x2 zq[2][4];
#pragma unroll
    for (int pt = 0; pt < 2; ++pt)
#pragma unroll
        for (int i = 0; i < 4; ++i) zq[pt][i] = *(const u32x2*)(zrow + pt * 32 + 8 * i + 4 * hf);
    bf16x8 cf[8];
#pragma unroll
    for (int ks = 0; ks < 8; ++ks) cf[ks] = *(const LAS bf16x8*)(Cn + l * BN_LD + ks * 16 + 8 * hf);
    f32x16 ya[2]; ya[0] = zero16(); ya[1] = zero16();
    const bf16_t* hp = (const bf16_t*)(a.ws + WS_SST) + ((size_t)si.slot * 8 + h) * 8192;
#pragma unroll
    for (int ks = 0; ks < 8; ++ks) {
#pragma unroll
        for (int pt = 0; pt < 2; ++pt) { const bf16x8 af = *(const bf16x8*)(hp + (pt * 32 + r) * 128 + ks * 16 + 8 * hf); ya[pt] = MFMA32(af, cf[ks], ya[pt]); }
    }
    { const float e = ecs[l];
#pragma unroll
      for (int pt = 0; pt < 2; ++pt)
#pragma unroll
          for (int i = 0; i < 16; ++i) ya[pt][i] *= e; }
    const float csl = cs[l];
#pragma unroll
    for (int st = 0; st < 2; ++st) {
        if (st <= lh) {
            f32x16 sa = zero16();
#pragma unroll
            for (int ks = 0; ks < 8; ++ks) { const bf16x8 af = *(const LAS bf16x8*)(Bn + (st * 32 + r) * BN_LD + ks * 16 + 8 * hf); sa = MFMA32(af, cf[ks], sa); }
#pragma unroll
            for (int i = 0; i < 16; ++i) { const int s = st * 32 + (i & 3) + 8 * (i >> 2) + 4 * hf;
                const float v = sa[i] * __expf(csl - cs[s]) * dtl[s]; sa[i] = (s <= l) ? v : 0.f; }
#pragma unroll
            for (int k2 = 0; k2 < 2; ++k2) {
                u32x4 gp; gp.x = pk2(sa[8 * k2 + 0], sa[8 * k2 + 1]); gp.y = pk2(sa[8 * k2 + 2], sa[8 * k2 + 3]); gp.z = pk2(sa[8 * k2 + 4], sa[8 * k2 + 5]); gp.w = pk2(sa[8 * k2 + 6], sa[8 * k2 + 7]);
                const bf16x8 gf = __builtin_bit_cast(bf16x8, gp);
#pragma unroll
                for (int pt = 0; pt < 2; ++pt) {
                    const LAS bf16_t* xr = XT + (pt * 32 + r) * XT_LD + 4 * hf; const int swz = (pt * 4 + (r >> 3)) & 7;
                    const u32x2 lo = *(const LAS u32x2*)(xr + (((st * 4 + 2 * k2) ^ swz) << 3)), hi = *(const LAS u32x2*)(xr + (((st * 4 + 2 * k2 + 1) ^ swz) << 3));
                    u32x4 xa; xa.x = lo.x; xa.y = lo.y; xa.z = hi.x; xa.w = hi.y;
                    ya[pt] = MFMA32(__builtin_bit_cast(bf16x8, xa), gf, ya[pt]);
                }
            }
        }
    }
    const float Dh = a.in[I_SSDD][h];
    float ssq = 0.f;
#pragma unroll
    for (int pt = 0; pt < 2; ++pt)
#pragma unroll
        for (int i = 0; i < 4; ++i) {
            const int p0 = pt * 32 + 8 * i + 4 * hf;
            const u32x2 zz = zq[pt][i];
            const float zv[4] = {bf2f(zz.x & 0xffff), bf2f(zz.x >> 16), bf2f(zz.y & 0xffff), bf2f(zz.y >> 16)};
#pragma unroll
            for (int j = 0; j < 4; ++j) { const float xv = bf2f(XT[(p0 + j) * XT_LD + ((((l >> 3) ^ ((pt * 4 + i) & 7)) << 3) | (l & 7))]); const float y = (ya[pt][4 * i + j] + Dh * xv) * silu_f(zv[j]); ya[pt][4 * i + j] = y; ssq += y * y; }
        }
    ssq += __shfl_xor(ssq, 32);
    if (hf == 0) red[h4 * 64 + l] = ssq;
    sub_barrier(bcnt, btarget, lane);
    const float* nw0 = a.in[I_SNW] + g * 256 + h4 * 64;
    const float tot = red[l] + red[64 + l] + red[128 + l] + red[192 + l];
    const float rs = 1.f / sqrtf(tot * (1.f / 256.f) + EPS);
    if (realtok) {
        bf16_t* orow = (bf16_t*)(a.ws + WS_MIXIN) + (size_t)row * DM + g * 256 + h4 * 64;
#pragma unroll
        for (int pt = 0; pt < 2; ++pt)
#pragma unroll
            for (int i = 0; i < 4; ++i) { const int p0 = pt * 32 + 8 * i + 4 * hf; const f32x4 nq = *(const f32x4*)(nw0 + p0);
                u32x2 w; w.x = pk2(ya[pt][4 * i] * rs * nq[0], ya[pt][4 * i + 1] * rs * nq[1]); w.y = pk2(ya[pt][4 * i + 2] * rs * nq[2], ya[pt][4 * i + 3] * rs * nq[3]);
                *(u32x2*)(orow + p0) = w; }
    }
    }
}

struct S5Consts { float lbr, lbi; bf16x8 bb[4]; };
__device__ __forceinline__ void s5_lambda(const Args& a, int g, int p, float& lbr, float& lbi, float& qr, float& qi) {
    const float lr = a.in[I_LRE][g * 64 + p], li = a.in[I_LIM][g * 64 + p], dt = expf(a.in[I_LDT][g]);
    const float mag = expf(lr * dt), ang = li * dt;
    lbr = mag * cosf(ang); lbi = mag * sinf(ang);
    const float den = lr * lr + li * li;
    qr = ((lbr - 1.f) * lr + lbi * li) / den; qi = (lbi * lr - (lbr - 1.f) * li) / den;
}
__device__ __forceinline__ void s5_consts(const Args& a, int g, int lane, S5Consts& c) {
    const int r = lane & 31, hf = lane >> 5;
    float lb0r, lb0i, q0r, q0i, lb1r, lb1i, q1r, q1i;
    s5_lambda(a, g, r, lb0r, lb0i, q0r, q0i); s5_lambda(a, g, 32 + r, lb1r, lb1i, q1r, q1i);
    c.lbr = hf ? lb1r : lb0r; c.lbi = hf ? lb1i : lb0i;
#pragma unroll
    for (int nb = 0; nb < 4; ++nb) {
        const int ps = r + 32 * (nb >> 1); const float qr = (nb >> 1) ? q1r : q0r, qi = (nb >> 1) ? q1i : q0i;
        const float* br = a.in[I_BRE] + (size_t)(g * 64 + ps) * 16 + 8 * hf; const float* bi = a.in[I_BIM] + (size_t)(g * 64 + ps) * 16 + 8 * hf;
        float v[8];
#pragma unroll
        for (int j = 0; j < 8; ++j) v[j] = (nb & 1) ? (qr * bi[j] + qi * br[j]) : (qr * br[j] - qi * bi[j]);
        u32x4 w; w.x = pk2(v[0], v[1]); w.y = pk2(v[2], v[3]); w.z = pk2(v[4], v[5]); w.w = pk2(v[6], v[7]);
        c.bb[nb] = __builtin_bit_cast(bf16x8, w);
    }
}
template <bool STORE>
__device__ __forceinline__ void s5_block(const Args& a, const S5Consts& c, const bf16x8 uf, int lane, float& hr, float& hi, LAS unsigned char* wl, const bf16_t* nxt, bf16x8& nuf) {
    f32x16 bu[4];
#pragma unroll
    for (int nb = 0; nb < 4; ++nb) bu[nb] = MFMA32(uf, c.bb[nb], zero16());
    asm volatile("" ::: "memory");
    nuf = *(const bf16x8*)nxt;
    asm volatile("" ::: "memory");
#pragma unroll
    for (int i = 0; i < 16; ++i) {
        auto s0 = __builtin_amdgcn_permlane32_swap(__float_as_uint(bu[0][i]), __float_as_uint(bu[2][i]), false, false);
        auto s1 = __builtin_amdgcn_permlane32_swap(__float_as_uint(bu[1][i]), __float_as_uint(bu[3][i]), false, false);
        bu[0][i] = __uint_as_float(s0[0]); bu[2][i] = __uint_as_float(s0[1]); bu[1][i] = __uint_as_float(s1[0]); bu[3][i] = __uint_as_float(s1[1]);
    }
    const float nlbi = -c.lbi;
#pragma unroll
    for (int ib = 0; ib < 4; ++ib) {
#pragma unroll
        for (int j = 0; j < 4; ++j) { const float nr = __builtin_fmaf(c.lbr, hr, __builtin_fmaf(nlbi, hi, bu[0][4 * ib + j])), ni = __builtin_fmaf(c.lbr, hi, __builtin_fmaf(c.lbi, hr, bu[1][4 * ib + j])); hr = nr; hi = ni; if (STORE) *(LAS unsigned*)(wl + (8 * ib + j) * 272 + lane * 4) = pk2(hr, hi); }
#pragma unroll
        for (int j = 0; j < 4; ++j) { const float nr = __builtin_fmaf(c.lbr, hr, __builtin_fmaf(nlbi, hi, bu[2][4 * ib + j])), ni = __builtin_fmaf(c.lbr, hi, __builtin_fmaf(c.lbi, hr, bu[3][4 * ib + j])); hr = nr; hi = ni; if (STORE) *(LAS unsigned*)(wl + (8 * ib + 4 + j) * 272 + lane * 4) = pk2(hr, hi); }
    }
}
__device__ __forceinline__ void s5_passA_item(const Args& a, int item, int lane) {
    const int b = item >> 8, g = (item >> 3) & 31, seg = item & 7;
    S5Consts c; s5_consts(a, g, lane, c);
    float hr = 0.f, hi = 0.f;
    const int row0 = b * SEQ + seg * 1024;
    const bf16_t* up_ = (const bf16_t*)(a.ws + WS_PROJ) + (size_t)(row0 + (lane & 31)) * NPROJ + 1536 + g * 16 + 8 * (lane >> 5);
    bf16x8 uf = *(const bf16x8*)up_;
    for (int blk = 0; blk < 32; ++blk) { const int nb = blk < 31 ? blk + 1 : 31; bf16x8 nuf; s5_block<false>(a, c, uf, lane, hr, hi, nullptr, up_ + (size_t)nb * 32 * NPROJ, nuf); uf = nuf; }
    float* loc = (float*)(a.ws + WS_S5LOC) + (size_t)item * 128;
    loc[lane] = hr; loc[64 + lane] = hi;
}
constexpr int S5_LD = 272;
__device__ __forceinline__ void s5_passC_run(const Args& a, LAS unsigned char* wlds, int row0, int nblk, int g, int lane, float& hr, float& hi) {
    S5Consts c; s5_consts(a, g, lane, c);
    const int r16 = lane & 15, q4 = lane >> 4;
    bf16x8 ca[4];
#pragma unroll
    for (int kb = 0; kb < 4; ++kb) { float v[8];
#pragma unroll
        for (int j = 0; j < 8; ++j) { const int comp = 32 * kb + 8 * q4 + j, p = comp >> 1; v[j] = (comp & 1) ? -a.in[I_CIM][(size_t)(g * 16 + r16) * 64 + p] : a.in[I_CRE][(size_t)(g * 16 + r16) * 64 + p]; }
        u32x4 w; w.x = pk2(v[0], v[1]); w.y = pk2(v[2], v[3]); w.z = pk2(v[4], v[5]); w.w = pk2(v[6], v[7]); ca[kb] = __builtin_bit_cast(bf16x8, w); }
    bf16x4 ga[2];
#pragma unroll
    for (int mb = 0; mb < 2; ++mb) { float v[4];
#pragma unroll
        for (int j = 0; j < 4; ++j) v[j] = a.in[I_GLUW][(size_t)(g * 16 + 4 * q4 + j) * 32 + mb * 16 + r16];
        u32x2 w; w.x = pk2(v[0], v[1]); w.y = pk2(v[2], v[3]); ga[mb] = __builtin_bit_cast(bf16x4, w); }
    f32x4 dD, gb0, gb1;
#pragma unroll
    for (int j = 0; j < 4; ++j) { dD[j] = a.in[I_S5D][g * 16 + 4 * q4 + j]; gb0[j] = a.in[I_GLUB][g * 32 + 4 * q4 + j]; gb1[j] = a.in[I_GLUB][g * 32 + 16 + 4 * q4 + j]; }
    const bf16_t* proj = (const bf16_t*)(a.ws + WS_PROJ);
    bf16_t* mixin = (bf16_t*)(a.ws + WS_MIXIN);
    const bf16_t* up_ = proj + (size_t)(row0 + (lane & 31)) * NPROJ + 1536 + g * 16 + 8 * (lane >> 5);
    bf16x8 uf = *(const bf16x8*)up_;
    u32x2 uus[2], uun[2];
#pragma unroll
    for (int sb = 0; sb < 2; ++sb) uus[sb] = *(const u32x2*)(proj + (size_t)(row0 + sb * 16 + r16) * NPROJ + 1536 + g * 16 + 4 * q4);
    for (int blk = 0; blk < nblk; ++blk) {
        const int rb = row0 + blk * 32;
        const int nb = blk < nblk - 1 ? blk + 1 : blk; bf16x8 nuf;
        s5_block<true>(a, c, uf, lane, hr, hi, wlds, up_ + (size_t)nb * 32 * NPROJ, nuf); uf = nuf;
#pragma unroll
        for (int sb = 0; sb < 2; ++sb) uun[sb] = *(const u32x2*)(proj + (size_t)(row0 + nb * 32 + sb * 16 + r16) * NPROJ + 1536 + g * 16 + 4 * q4);
        asm volatile("s_waitcnt lgkmcnt(0)" ::: "memory");
#pragma unroll
        for (int sb = 0; sb < 2; ++sb) {
            f32x4 y = (f32x4){0.f, 0.f, 0.f, 0.f};
#pragma unroll
            for (int kb = 0; kb < 4; ++kb) { const bf16x8 hb = *(const LAS bf16x8*)(wlds + (sb * 16 + r16) * S5_LD + (32 * kb + 8 * q4) * 2);
                y = __builtin_amdgcn_mfma_f32_16x16x32_bf16(ca[kb], hb, y, 0, 0, 0); }
            const int row = rb + sb * 16 + r16;
            const u32x2 uu = uus[sb];
            const float uv[4] = {bf2f(uu.x & 0xffff), bf2f(uu.x >> 16), bf2f(uu.y & 0xffff), bf2f(uu.y >> 16)};
            float ge[4];
#pragma unroll
            for (int j = 0; j < 4; ++j) ge[j] = gelu_tanh(y[j] + dD[j] * uv[j]);
            u32x2 gw; gw.x = pk2(ge[0], ge[1]); gw.y = pk2(ge[2], ge[3]);
            const bf16x4 gbf = __builtin_bit_cast(bf16x4, gw);
            const f32x4 o0 = __builtin_amdgcn_mfma_f32_16x16x16bf16_1k(ga[0], gbf, gb0, 0, 0, 0);
            const f32x4 o1 = __builtin_amdgcn_mfma_f32_16x16x16bf16_1k(ga[1], gbf, gb1, 0, 0, 0);
            float ov[4];
#pragma unroll
            for (int j = 0; j < 4; ++j) ov[j] = o0[j] * __builtin_amdgcn_rcpf(1.f + __builtin_amdgcn_exp2f(-1.4426950409f * o1[j]));
            u32x2 ow; ow.x = pk2(ov[0], ov[1]); ow.y = pk2(ov[2], ov[3]);
            *(u32x2*)(mixin + (size_t)row * DM + 512 + g * 16 + 4 * q4) = ow;
        }
        asm volatile("s_waitcnt lgkmcnt(0)" ::: "memory");
        uus[0] = uun[0]; uus[1] = uun[1];
    }
}

#define XB_TMO      128
#define XB_XCNT(j)  (256  + 64 * (j))
#define XB_XSUB(j)  (1280 + 64 * (j))
#define XB_XGEN(j)  (2304 + 64 * (j))
#define XB_TOP      3328
#define XB_TOPGEN   3392
#define XCD_BAR_WORDS 3456
#define XB_SPIN_CAP (1u << 18)

__device__ __forceinline__ unsigned xb_ld(unsigned* p)              { return __hip_atomic_load(p, __ATOMIC_RELAXED, __HIP_MEMORY_SCOPE_AGENT); }
__device__ __forceinline__ unsigned xb_add(unsigned* p, unsigned v) { return __hip_atomic_fetch_add(p, v, __ATOMIC_RELAXED, __HIP_MEMORY_SCOPE_AGENT); }
__device__ __forceinline__ unsigned xb_xcc_id() { return (unsigned)__builtin_amdgcn_s_getreg((3 << 11) | 20) & 0xFu; }
#define XB_SPIN(cond, bar) do { unsigned _sp = 0; while (cond) { __builtin_amdgcn_s_sleep(1); \
    if ((++_sp & 255u) == 0u) { if (xb_ld(&(bar)[XB_TMO])) break; if (_sp > XB_SPIN_CAP) { atomicAdd(&(bar)[XB_TMO], 1u); break; } } } } while (0)

struct XcdBarrier {
    unsigned* bar; unsigned x;
    volatile LAS unsigned* st;
};

__device__ __forceinline__ XcdBarrier xcd_barrier_post(unsigned* bar, volatile LAS unsigned* st) {
    XcdBarrier b; b.bar = bar; b.x = xb_xcc_id(); b.st = st;
    if (threadIdx.x == 0) (void)xb_add(&bar[XB_XCNT(b.x)], 1u);
    return b;
}
__device__ __forceinline__ void xcd_barrier_complete(unsigned* bar, unsigned x, unsigned& nloc, unsigned& nx) {
    const unsigned G = gridDim.x * gridDim.y * gridDim.z;
    unsigned sum, cnt, mine, sp = 0u;
    for (;;) {
        sum = 0u; cnt = 0u; mine = 0u;
#pragma unroll
        for (unsigned j = 0; j < 16; ++j) { const unsigned c = xb_ld(&bar[XB_XCNT(j)]); sum += c; cnt += (c > 0u) ? 1u : 0u; mine = (j == x) ? c : mine; }
        if (sum == G) break;
        __builtin_amdgcn_s_sleep(1);
        if ((++sp & 255u) == 0u) { if (xb_ld(&bar[XB_TMO])) break; if (sp > XB_SPIN_CAP) { atomicAdd(&bar[XB_TMO], 1u); break; } }
    }
    nloc = mine > 0u ? mine : 1u; nx = cnt > 0u ? cnt : 1u;
}

__device__ __forceinline__ void xcd_barrier(const XcdBarrier& b) {
    asm volatile("s_waitcnt vmcnt(0)" ::: "memory");
    __syncthreads();
    if (threadIdx.x == 0) {
        unsigned* bar = b.bar;
        __builtin_amdgcn_s_waitcnt(0);
        unsigned nloc = b.st[0], nx = b.st[1];
        if (nloc == 0u) { xcd_barrier_complete(bar, b.x, nloc, nx); b.st[0] = nloc; b.st[1] = nx; }
        const unsigned old = xb_add(&bar[XB_XSUB(b.x)], 1u);
        const unsigned gen = old / nloc;
        if (old + 1u == (gen + 1u) * nloc) {
            __builtin_amdgcn_fence(__ATOMIC_RELEASE, "agent");
            asm volatile("s_waitcnt vmcnt(0)" ::: "memory");
            const unsigned og = xb_add(&bar[XB_TOP], 1u);
            const unsigned tg = og / nx;
            if (og + 1u == (tg + 1u) * nx) xb_add(&bar[XB_TOPGEN], 1u);
            else XB_SPIN(xb_ld(&bar[XB_TOPGEN]) == tg, bar);
            __builtin_amdgcn_fence(__ATOMIC_ACQUIRE, "agent");
            xb_add(&bar[XB_XGEN(b.x)], 1u);
            asm volatile("s_waitcnt vmcnt(0)" ::: "memory");
        } else {
            XB_SPIN(xb_ld(&bar[XB_XGEN(b.x)]) == gen, bar);
            __builtin_amdgcn_fence(__ATOMIC_ACQUIRE, "agent");
            asm volatile("s_waitcnt vmcnt(0)" ::: "memory");
        }
    }
    __syncthreads();
}


constexpr int LDS_BYTES = 163840;
__global__ void __launch_bounds__(512, 2) fwd_kernel(Args a) {
    extern __shared__ __attribute__((aligned(16))) unsigned char lds_raw[];
    LAS unsigned char* lds = (LAS unsigned char*)lds_raw;
    const int tid = threadIdx.x, lane = tid & 63, wave = __builtin_amdgcn_readfirstlane(tid >> 6);
    const int G = gridDim.x, bx = blockIdx.x;
    const int gw = bx * 8 + wave, NGW = G * 8;
    unsigned char* ws = a.ws;
#if ONE_LAUNCH
    cg::grid_group grid = cg::this_grid();
    volatile LAS unsigned* bst = (volatile LAS unsigned*)(lds + LDS_BYTES - 16);
    if (tid < 4) bst[tid] = 0u;
    __syncthreads();
    XcdBarrier xbar = xcd_barrier_post((unsigned*)(ws + WS_BAR), bst);
#define GSYNC() xcd_barrier(xbar)
#else
#define GSYNC() do {} while (0)
#endif
#ifndef PHMASK
#define PHMASK 0x3ff
#endif
#define IN(k) (((PHMASK >> (k)) & 1) && a.ph_lo <= (k) && (k) < a.ph_hi)
#define SEAM(k) do { if (IN(k) && IN((k) + 1)) GSYNC(); } while (0)

    if (IN(0)) { p0_prologue(a, lds, gw, NGW, lane, wave); }
#if ONE_LAUNCH
    if (a.ph_hi > 1000) grid.sync();
#endif
    SEAM(0);
    if (IN(1)) {
        pg8::Gemm g{(const bf16_t*)(ws + WS_HB), (const bf16_t*)(ws + WS_WIN), RP / 256, NPROJ / 256, DM, 64};
        pg8::StaticOrder S; S.init(g.nM, g.nN, G, bx);
        EpiProj E{(bf16_t*)(ws + WS_PROJ), (const float*)(ws + WS_RSTD1), NPROJ};
        pg8::gemm_phase<EpiProj>(lds, g, S, E);
        mini_gemm<0>(lds, (const bf16_t*)(ws + WS_HB) + (size_t)RP * DM, (const bf16_t*)(ws + WS_WIN), DM, NPROJ, (bf16_t*)(ws + WS_PROJ) + (size_t)RP * NPROJ, NPROJ, (const float*)(ws + WS_RSTD1) + RP, nullptr, bx, G, tid, wave, lane);
    }
    SEAM(1);
    if (IN(2)) {
        {
            const int sb = wave >> 2, sid = tid & 255, w4 = wave & 3;
            LAS unsigned char* sl = lds + sb * SUB_LDS; LAS unsigned* bcnt = (LAS unsigned*)(sl + L_SSD_END);
            if (sid == 0) *bcnt = 0u;
            __syncthreads();
            unsigned btarget = 0u;
            const bool spread = (G == 256);
            const int ulim = spread ? NBATCH * NCHUNK * 2 : NUNITS_BC * 2, u0 = bx * 2 + sb;
            const int nk = u0 < ulim ? (ulim - u0 + 2 * G - 1) / (2 * G) : 0;
            const int sj = (spread && sb == 0 && (bx & 15) == 8) ? (bx >> 4) : -1;
            if (sb) __builtin_amdgcn_s_sleep(100);
            for (int k = 0; k < nk + (sj >= 0 ? 1 : 0); ++k) ssd_passA_unit(a, sl, k < nk ? u0 + k * 2 * G : NBATCH * NCHUNK * 2 + sj, sid, w4, lane, bcnt, btarget);
            __syncthreads();
        }
        for (int it = gw; it < NBATCH * 32 * 8; it += NGW) s5_passA_item(a, it, lane);
        const bf16_t* proj = (const bf16_t*)(ws + WS_PROJ);
        for (int i = bx * 512 + tid; i < 16 * 3 * 1024; i += G * 512) {
            const int sq = i / 3072, rem = i % 3072, k = rem >> 10, ch = rem & 1023;
            const int row = sq < 8 ? sq * SEQ + SEQ - 3 + k : RP + (sq - 8) * DSEQ + DSEQ - 3 + k;
            const float v = bf2f(proj[(size_t)row * NPROJ + 512 + ch]);
            if (sq < 8) a.out[O_CONVP + (size_t)(sq * 3 + k) * 1024 + ch] = v; else a.out[O_CONVS + (size_t)((sq - 8) * 3 + k) * 1024 + ch] = v;
        }
    }
    SEAM(2);
    if (IN(3)) {
        bf16_t* sst = (bf16_t*)(ws + WS_SST); const float* cdec = (const float*)(ws + WS_CDEC);
        for (int i = bx * 512 + tid; i < 16 * 8 * 2048; i += G * 512) {
            const int sq = i >> 14, h = (i >> 11) & 7, e4 = (i & 2047) * 4;
            const bool smp = sq >= 8; const int b = sq & 7;
            const int nch = smp ? 1 : NCHUNK, slot0 = smp ? NBATCH * NCHUNK + b : b * NCHUNK;
            f32x4 hc = (f32x4){0.f, 0.f, 0.f, 0.f};
            if (smp) hc = *(const f32x4*)(a.in[I_SSSD] + ((size_t)(b * 8 + h) * 8192 + e4));
            for (int c = 0; c < nch; ++c) {
                u32x2* p = (u32x2*)(sst + ((size_t)(slot0 + c) * 8 + h) * 8192 + e4);
                const u32x2 w = *p; const float d = cdec[(size_t)(slot0 + c) * 8 + h];
                u32x2 o; o.x = pk2(hc[0], hc[1]); o.y = pk2(hc[2], hc[3]); *p = o;
                hc[0] = hc[0] * d + bf2f(w.x & 0xffff); hc[1] = hc[1] * d + bf2f(w.x >> 16); hc[2] = hc[2] * d + bf2f(w.y & 0xffff); hc[3] = hc[3] * d + bf2f(w.y >> 16);
            }
            *(f32x4*)(a.out + (smp ? O_SSDS : O_SSDP) + ((size_t)(b * 8 + h) * 8192 + e4)) = hc;
        }
        for (int i = bx * 512 + tid; i < NBATCH * 32 * 64; i += G * 512) {
            const int b = i >> 11, g = (i >> 6) & 31, p = i & 63;
            float lbr, lbi, qr, qi; s5_lambda(a, g, p, lbr, lbi, qr, qi);
            float pr = lbr, pi = lbi;
            for (int k = 0; k < 10; ++k) { const float nr = pr * pr - pi * pi, ni = 2.f * pr * pi; pr = nr; pi = ni; }
            const float* loc = (const float*)(ws + WS_S5LOC) + (size_t)((b * 32 + g) * 8) * 128; float* hin = (float*)(ws + WS_S5HIN) + (size_t)((b * 32 + g) * 8) * 128;
            float hr = 0.f, hi = 0.f;
            for (int s = 0; s < 8; ++s) { hin[s * 128 + p] = hr; hin[s * 128 + 64 + p] = hi;
                const float nr = pr * hr - pi * hi + loc[s * 128 + p], ni = pr * hi + pi * hr + loc[s * 128 + 64 + p]; hr = nr; hi = ni; }
            a.out[O_S5REP + i] = hr; a.out[O_S5IMP + i] = hi;
        }
    }
    SEAM(3);
    if (IN(4)) {
        {
            const int sb = wave >> 2, sid = tid & 255, w4 = wave & 3;
            LAS unsigned char* sl = lds + sb * SUB_LDS; LAS unsigned* bcnt = (LAS unsigned*)(sl + L_SSD_END);
            if (sid == 0) *bcnt = 0u;
            __syncthreads();
            unsigned btarget = 0u;
            const bool spread = (G == 256);
            const int ulim = spread ? NBATCH * NCHUNK * 2 : NUNITS_BC * 2, u0 = bx * 2 + sb;
            const int nk = u0 < ulim ? (ulim - u0 + 2 * G - 1) / (2 * G) : 0;
            const int sj = (spread && sb == 0 && (bx & 15) == 8) ? (bx >> 4) : -1;
            if (sb) __builtin_amdgcn_s_sleep(100);
            for (int k = 0; k < nk + (sj >= 0 ? 1 : 0); ++k) ssd_passC_unit(a, sl, k < nk ? u0 + k * 2 * G : NBATCH * NCHUNK * 2 + sj, sid, w4, lane, bcnt, btarget);
        }
        __syncthreads();
        LAS unsigned char* wlds = lds + wave * (32 * S5_LD);
        for (int it = gw; it < NBATCH * 32 * 8 + NBATCH * 32; it += NGW) {
            if (it < NBATCH * 32 * 8) {
                const int b = it >> 8, g = (it >> 3) & 31, seg = it & 7;
                const float* hin = (const float*)(ws + WS_S5HIN) + (size_t)it * 128;
                float hr = hin[lane], hi = hin[64 + lane];
                s5_passC_run(a, wlds, b * SEQ + seg * 1024, 32, g, lane, hr, hi);
            } else {
                const int j = it - NBATCH * 32 * 8, b = j >> 5, g = j & 31;
                float hr = a.in[I_S5RE][(size_t)(b * 32 + g) * 64 + lane], hi = a.in[I_S5IM][(size_t)(b * 32 + g) * 64 + lane];
                s5_passC_run(a, wlds, RP + b * DSEQ, 1, g, lane, hr, hi);
                a.out[O_S5RES + (size_t)(b * 32 + g) * 64 + lane] = hr; a.out[O_S5IMS + (size_t)(b * 32 + g) * 64 + lane] = hi;
            }
        }
        __syncthreads();
    }
    SEAM(4);
    if (IN(5)) {
        pg8::Gemm g{(const bf16_t*)(ws + WS_MIXIN), (const bf16_t*)(ws + WS_WOUT), RP / 256, DM / 256, DM, 64};
        pg8::StaticOrder S; S.init(g.nM, g.nN, G, bx);
        EpiSq E{(bf16_t*)(ws + WS_MIX), (float*)(ws + WS_SUMSQ2), DM};
        pg8::gemm_phase<EpiSq>(lds, g, S, E);
        mini_gemm<1>(lds, (const bf16_t*)(ws + WS_MIXIN) + (size_t)RP * DM, (const bf16_t*)(ws + WS_WOUT), DM, DM, (bf16_t*)(ws + WS_MIX) + (size_t)RP * DM, DM, nullptr, (float*)(ws + WS_SUMSQ2) + RP, bx, G, tid, wave, lane);
    }
    SEAM(5);
    if (IN(6)) {
        const bf16_t* mix = (const bf16_t*)(ws + WS_MIX); const float* s2 = (const float*)(ws + WS_SUMSQ2); bf16_t* hb = (bf16_t*)(ws + WS_HB); float* rstd3 = (float*)(ws + WS_RSTD3);
        const float* pw = a.in[I_POSTMIX];
        f32x4 w4[4];
#pragma unroll
        for (int q = 0; q < 4; ++q) w4[q] = *(const f32x4*)(pw + q * 256 + lane * 4);
        for (int row0 = 2 * gw; row0 < R; row0 += 2 * NGW) {
            f32x4 xv[2][4]; u32x2 mm[2][4]; float rs[2];
#pragma unroll
            for (int rr = 0; rr < 2; ++rr) { const int row = row0 + rr;
                rs[rr] = s2[row];
#pragma unroll
                for (int q = 0; q < 4; ++q) { const u32x2 xx = *(const u32x2*)(hb + (size_t)row * DM + q * 256 + lane * 4);
                    xv[rr][q][0] = bf2f(xx.x & 0xffff); xv[rr][q][1] = bf2f(xx.x >> 16); xv[rr][q][2] = bf2f(xx.y & 0xffff); xv[rr][q][3] = bf2f(xx.y >> 16);
                    mm[rr][q] = *(const u32x2*)(mix + (size_t)row * DM + q * 256 + lane * 4); } }
#pragma unroll
            for (int rr = 0; rr < 2; ++rr) { const int row = row0 + rr;
                const float r_ = 1.f / sqrtf(rs[rr] * (1.f / DM) + EPS);
                float ss = 0.f; f32x4 hv[4];
#pragma unroll
                for (int q = 0; q < 4; ++q) { const u32x2 m2 = mm[rr][q];
                    hv[q][0] = xv[rr][q][0] + bf2f(m2.x & 0xffff) * r_ * w4[q][0]; hv[q][1] = xv[rr][q][1] + bf2f(m2.x >> 16) * r_ * w4[q][1]; hv[q][2] = xv[rr][q][2] + bf2f(m2.y & 0xffff) * r_ * w4[q][2]; hv[q][3] = xv[rr][q][3] + bf2f(m2.y >> 16) * r_ * w4[q][3];
                    ss += (hv[q][0] * hv[q][0] + hv[q][1] * hv[q][1]) + (hv[q][2] * hv[q][2] + hv[q][3] * hv[q][3]); }
                ss = wave_sum(ss);
#pragma unroll
                for (int q = 0; q < 4; ++q) { u32x2 w; w.x = pk2(hv[q][0], hv[q][1]); w.y = pk2(hv[q][2], hv[q][3]); *(u32x2*)(hb + (size_t)row * DM + q * 256 + lane * 4) = w; }
                if (lane == 0) rstd3[row] = 1.f / sqrtf(ss * (1.f / DM) + EPS); }
        }
    }
    SEAM(6);
    if (IN(7)) {
        constexpr int nM = (R + 247) / 248;
        pg8::Gemm g{(const bf16_t*)(ws + WS_HB) - 2 * DM, (const bf16_t*)(ws + WS_WUP), nM, NUP / 256, DM, 62};
        pg8::StaticOrder S; S.init(g.nM, g.nN, G, bx);
        const int nfull = (nM * (NUP / 256)) % G;
        EpiUp E{(bf16_t*)(ws + WS_ACT), (const float*)(ws + WS_RSTD3), a.in[I_FCW], a.in[I_FCB], a.in[I_CFFN], a.out + O_FFNP, a.out + O_FFNS, lds + 131072};
        pg8::gemm_phase<EpiUp>(lds, g, S, E);
        if (nfull == 0 || G - nfull < 8) up_fixup(a, lds, bx, G, tid, wave, lane);
        else if (bx >= nfull) up_fixup(a, lds, bx - nfull, G - nfull, tid, wave, lane);
    }
    SEAM(7);
    if (IN(8)) {
        pg8::Gemm g{(const bf16_t*)(ws + WS_ACT), (const bf16_t*)(ws + WS_WDOWN), RP / 256, DM / 256, DFF, 64};
        pg8::StaticOrder S; S.init(g.nM, g.nN, G, bx);
        EpiSq E{(bf16_t*)(ws + WS_FFN), (float*)(ws + WS_SUMSQ4), DM};
        pg8::gemm_phase<EpiSq>(lds, g, S, E);
        mini_gemm<1>(lds, (const bf16_t*)(ws + WS_ACT) + (size_t)RP * DFF, (const bf16_t*)(ws + WS_WDOWN), DFF, DM, (bf16_t*)(ws + WS_FFN) + (size_t)RP * DM, DM, nullptr, (float*)(ws + WS_SUMSQ4) + RP, bx, G, tid, wave, lane);
    }
    SEAM(8);
    if (IN(9)) {
        const bf16_t* ffn = (const bf16_t*)(ws + WS_FFN); const float* s4 = (const float*)(ws + WS_SUMSQ4); const bf16_t* hb = (const bf16_t*)(ws + WS_HB);
        const float* pw = a.in[I_POSTFFN];
        f32x4 w4[4];
#pragma unroll
        for (int q = 0; q < 4; ++q) w4[q] = *(const f32x4*)(pw + q * 256 + lane * 4);
        for (int row0 = 2 * gw; row0 < R; row0 += 2 * NGW) {
            u32x2 hh[2][4], mm[2][4]; float rs[2];
#pragma unroll
            for (int rr = 0; rr < 2; ++rr) { const int row = row0 + rr; rs[rr] = s4[row];
#pragma unroll
                for (int q = 0; q < 4; ++q) { hh[rr][q] = *(const u32x2*)(hb + (size_t)row * DM + q * 256 + lane * 4); mm[rr][q] = *(const u32x2*)(ffn + (size_t)row * DM + q * 256 + lane * 4); } }
#pragma unroll
            for (int rr = 0; rr < 2; ++rr) { const int row = row0 + rr;
                float* yr = row < RP ? a.out + O_YP + (size_t)row * DM : a.out + O_YS + (size_t)(row - RP) * DM;
                const float r_ = 1.f / sqrtf(rs[rr] * (1.f / DM) + EPS);
#pragma unroll
                for (int q = 0; q < 4; ++q) { const u32x2 h2 = hh[rr][q], m2 = mm[rr][q];
                    f32x4 o; o[0] = bf2f(h2.x & 0xffff) + bf2f(m2.x & 0xffff) * r_ * w4[q][0]; o[1] = bf2f(h2.x >> 16) + bf2f(m2.x >> 16) * r_ * w4[q][1];
                    o[2] = bf2f(h2.y & 0xffff) + bf2f(m2.y & 0xffff) * r_ * w4[q][2]; o[3] = bf2f(h2.y >> 16) + bf2f(m2.y >> 16) * r_ * w4[q][3];
                    __builtin_nontemporal_store(o, (f32x4*)(yr + q * 256 + lane * 4)); } }
        }
    }
}

constexpr int NPHASE = 10;
extern "C" void kernel_launch(void* const* d_in, const int* in_sizes, int n_in, void* d_out, int out_size, void* d_ws, size_t ws_size, hipStream_t stream) {
    static int grid = 0;
    if (grid == 0) {
        if (n_in != 33 || ws_size < WS_END) { fprintf(stderr, "kernel_launch: unexpected n_in %d / ws %zu\n", n_in, ws_size); grid = -1; return; }
        int dev = 0, cus = 0, per_cu = 0;
        hipGetDevice(&dev); hipDeviceGetAttribute(&cus, hipDeviceAttributeMultiprocessorCount, dev);
        hipFuncSetAttribute((const void*)fwd_kernel, hipFuncAttributeMaxDynamicSharedMemorySize, LDS_BYTES);
        hipOccupancyMaxActiveBlocksPerMultiprocessor(&per_cu, (const void*)fwd_kernel, 512, LDS_BYTES);
        (void)hipGetLastError();
        if (per_cu < 1) per_cu = 1;
        grid = cus * 1;
    }
    if (grid < 0) return;
    Args a{};
    for (int i = 0; i < 33; ++i) a.in[i] = (const float*)d_in[i];
    a.out = (float*)d_out; a.ws = (unsigned char*)d_ws;
#if ONE_LAUNCH
    (void)hipMemsetAsync((char*)d_ws + WS_BAR, 0, 16384, stream);
    a.ph_lo = 0; a.ph_hi = NPHASE;
    void* args[] = {&a};
    hipError_t e = hipLaunchCooperativeKernel((const void*)fwd_kernel, dim3(grid), dim3(512), args, LDS_BYTES, stream);
    if (e != hipSuccess) fprintf(stderr, "cooperative launch failed: %s (grid %d)\n", hipGetErrorString(e), grid);
#else
#ifndef DUPMASK
#define DUPMASK 0
#endif
    for (int p = 0; p < NPHASE; ++p) { a.ph_lo = p; a.ph_hi = p + 1; for (int rep = 0; rep < (((DUPMASK >> p) & 1) ? 2 : 1); ++rep) hipLaunchKernelGGL(fwd_kernel, dim3(grid), dim3(512), LDS_BYTES, stream, a); }
#endif
}
```

```cpp
#include <hip/hip_runtime.h>
#include <hip/hip_cooperative_groups.h>
#include <cstdio>
namespace cg = cooperative_groups;

#ifndef ONE_LAUNCH
#define ONE_LAUNCH 1
#endif

#define LAS __attribute__((address_space(3)))
typedef unsigned short bf16_t;
typedef short bf16x8 __attribute__((ext_vector_type(8)));
typedef short bf16x4 __attribute__((ext_vector_type(4)));
typedef float f32x4 __attribute__((ext_vector_type(4)));
typedef float f32x16 __attribute__((ext_vector_type(16)));
typedef unsigned u32x4 __attribute__((ext_vector_type(4)));
typedef unsigned u32x2 __attribute__((ext_vector_type(2)));

constexpr int DM = 1024, SEQ = 8192, NBATCH = 8, DSEQ = 32;
constexpr int RP = NBATCH * SEQ;
constexpr int RS = NBATCH * DSEQ;
constexpr int R = RP + RS;
constexpr int NPROJ = 2048;
constexpr int DFF = 2816, NUP = 5632;
constexpr int NCHUNK = 128;
constexpr int NUNITS_BC = NBATCH * NCHUNK + NBATCH;
constexpr float EPS = 1e-6f;

constexpr size_t MiB = 1u << 20;
constexpr size_t WS_BAR = 512 * 1024;
constexpr size_t WS_WDT = 0;
constexpr size_t WS_RSTD1 = 1 * MiB, WS_SUMSQ2 = 1 * MiB + 512 * 1024, WS_RSTD3 = 2 * MiB, WS_SUMSQ4 = 2 * MiB + 512 * 1024;
constexpr size_t WS_DTV = 3 * MiB;
constexpr size_t WS_CDEC = 6 * MiB;
constexpr size_t WS_S5LOC = 7 * MiB, WS_S5HIN = 8 * MiB;
constexpr size_t WS_WIN = 10 * MiB, WS_WOUT = 14 * MiB, WS_WUP = 16 * MiB, WS_WDOWN = 28 * MiB;
constexpr size_t WS_HB = 36 * MiB;
constexpr size_t WS_PROJ = 168 * MiB;
constexpr size_t WS_SST = 426 * MiB;
constexpr size_t WS_MIXIN = 556 * MiB;
constexpr size_t WS_MIX = 686 * MiB;
constexpr size_t WS_ACT = 168 * MiB;
constexpr size_t WS_FFN = 556 * MiB;
constexpr size_t WS_END = 816 * MiB;

constexpr size_t O_YP = 0, O_YS = O_YP + (size_t)RP * DM, O_CONVP = O_YS + (size_t)RS * DM, O_SSDP = O_CONVP + 8 * 3 * 1024,
                 O_S5REP = O_SSDP + 8 * 8 * 64 * 128, O_S5IMP = O_S5REP + 8 * 32 * 64, O_FFNP = O_S5IMP + 8 * 32 * 64,
                 O_CONVS = O_FFNP + 8 * 2 * NUP, O_SSDS = O_CONVS + 8 * 3 * 1024, O_S5RES = O_SSDS + 8 * 8 * 64 * 128,
                 O_S5IMS = O_S5RES + 8 * 32 * 64, O_FFNS = O_S5IMS + 8 * 32 * 64;

struct Args {
    const float* in[33];
    float* out; unsigned char* ws;
    int ph_lo, ph_hi;
};
enum { I_XP = 0, I_XS, I_CSSD, I_SSSD, I_S5RE, I_S5IM, I_CFFN, I_PREMIX, I_WIN, I_SCW, I_SCB, I_DTB, I_ALOG, I_SSDD, I_SNW,
       I_LRE, I_LIM, I_LDT, I_BRE, I_BIM, I_CRE, I_CIM, I_S5D, I_GLUW, I_GLUB, I_WOUT, I_POSTMIX, I_PREFFN, I_WUP, I_FCW, I_FCB, I_WDOWN, I_POSTFFN };

__device__ __forceinline__ float bf2f(unsigned v) { return __uint_as_float(v << 16); }
__device__ __forceinline__ unsigned f2bf(float f) { unsigned u = __float_as_uint(f); return (u + 0x7fffu + ((u >> 16) & 1u)) >> 16; }
typedef __bf16 hwbf2 __attribute__((ext_vector_type(2)));
typedef float f32x2 __attribute__((ext_vector_type(2)));
__device__ __forceinline__ unsigned pk2(float lo, float hi) { f32x2 v; v.x = lo; v.y = hi; return __builtin_bit_cast(unsigned, __builtin_convertvector(v, hwbf2)); }
template <int CTRL, int RM> __device__ __forceinline__ float dpp_get(float v) { return __builtin_bit_cast(float, __builtin_amdgcn_update_dpp(0, __builtin_bit_cast(int, v), CTRL, RM, 0xF, false)); }
__device__ __forceinline__ float wave_sum(float v) {
    v += dpp_get<0xB1, 0xF>(v);
    v += dpp_get<0x4E, 0xF>(v);
    v += dpp_get<0x141, 0xF>(v);
    v += dpp_get<0x140, 0xF>(v);
    v += dpp_get<0x142, 0xA>(v);
    v += dpp_get<0x143, 0xC>(v);
    return __builtin_bit_cast(float, __builtin_amdgcn_readlane(__builtin_bit_cast(int, v), 63));
}
__device__ __forceinline__ float silu_f(float v) { return v * __builtin_amdgcn_rcpf(1.f + __builtin_amdgcn_exp2f(-1.4426950409f * v)); }
__device__ __forceinline__ float gelu_tanh(float v) {
    const float w = v * (-2.3022082f + -0.1029432f * (v * v));
    return v * __builtin_amdgcn_rcpf(1.f + __builtin_amdgcn_exp2f(w));
}

namespace pg8 {
constexpr int BM = 256, BK = 64, HALF = 128, HTB = HALF * BK * 2, STAGE_BYTES = 8 * HTB, NXCD = 8, WGM = 8;
__host__ __device__ __forceinline__ int lds_byte(int r, int c) { const int st = (r >> 4) * 2 + (c >> 5), rr = r & 15, cc = c & 31, ob = rr * 64 + cc * 2; return st * 1024 + (ob ^ (((ob >> 9) & 1) << 5)); }
__host__ __device__ __forceinline__ void stage_rc(int b, int& R_, int& C) { const int st = b / 1024, sb = b % 1024, swz = sb ^ (((sb >> 9) & 1) << 5); R_ = (st >> 1) * 16 + swz / 64; C = (st & 1) * 32 + (swz % 64) / 2; }
__host__ __device__ __forceinline__ int perm32(int rho) { const int n = rho >> 4, i = rho & 15; return 8 * (i >> 2) + 4 * n + (i & 3); }
struct Unit { int pm, pn; };
struct Gemm { const bf16_t* A; const bf16_t* Bt; int nM, nN, K, rp64; };
struct StaticOrder {
    int nM, nN, nwg, G, c;
    __device__ void init(int nM_, int nN_, int G_, int c_) { nM = nM_; nN = nN_; nwg = nM * nN; G = G_; c = c_; }
    __device__ bool next(int i, Unit& u) const {
        const long L = (long)i * G + c; if (L >= nwg) return false;
        int wgid = (int)L; { const int q = nwg / NXCD, r = nwg % NXCD, xcd = wgid % NXCD, off = wgid / NXCD; wgid = (xcd < r ? xcd * (q + 1) : r * (q + 1) + (xcd - r) * q) + off; }
        const int nig = WGM * nN, gid = wgid / nig, fm = gid * WGM, gsz = (nM - fm) < WGM ? (nM - fm) : WGM;
        u.pm = fm + ((wgid % nig) % gsz); u.pn = (wgid % nig) / gsz; return true;
    }
};

template <class Epi>
__device__ __forceinline__ void gemm_phase(LAS unsigned char* lds, const Gemm g, const StaticOrder& S, const Epi& E) {
    const int tid = threadIdx.x, wid = __builtin_amdgcn_readfirstlane(tid >> 6), lane = tid & 63, wr = wid >> 2, wc = wid & 3, fr = lane & 15, fq = lane >> 4;
    const int K = g.K, nt = K / BK;
    unsigned voffA[2], voffB[2];
#pragma unroll
    for (int i = 0; i < 2; ++i) { int R_, C; stage_rc(tid * 16 + i * 8192, R_, C); const int Rb = Epi::PERM ? ((R_ & ~31) + perm32(R_ & 31)) : R_;
        const int Ra = (R_ >> 6) * g.rp64 + (R_ & 63);
        voffA[i] = (unsigned)(Ra * K + C) * 2u; voffB[i] = (unsigned)(Rb * K + C) * 2u; }
    const size_t kstep = (size_t)(BK * 2);
    const size_t hstepB = (size_t)HALF * K * 2, tstepB = 2 * hstepB;
    const size_t hstepA = (size_t)2 * g.rp64 * K * 2, tstepA = 2 * hstepA;
    const unsigned ldsw = (unsigned)wid * 1024u;
    const int aoff = lds_byte(wr * 64 + fr, fq * 8), boff = lds_byte(wc * 32 + fr, fq * 8);
#define PG8_SA(b, h) (((b) * 2 + (h)) * HTB)
#define PG8_SB(b, h) ((4 + (b) * 2 + (h)) * HTB)
#define PG8_STAGE(bufoff, gbase, voff) do { _Pragma("unroll") for (int _i = 0; _i < 2; ++_i) \
        __builtin_amdgcn_global_load_lds((const unsigned*)((const char*)(gbase) + (voff)[_i]), (LAS unsigned*)(lds + (bufoff) + ldsw + _i * 8192), 16, 0, 0); } while (0)
#define PG8_LDA(dst, b, h) do { _Pragma("unroll") for (int m = 0; m < 4; ++m) _Pragma("unroll") for (int k = 0; k < 2; ++k) dst[m][k] = *(const LAS bf16x8*)(lds + PG8_SA(b, h) + aoff + m * 2048 + k * 1024); } while (0)
#define PG8_LDB(dst, b, h) do { _Pragma("unroll") for (int n = 0; n < 2; ++n) _Pragma("unroll") for (int k = 0; k < 2; ++k) dst[n][k] = *(const LAS bf16x8*)(lds + PG8_SB(b, h) + boff + n * 2048 + k * 1024); } while (0)
#define PG8_MMA(ai, bj, At, Bt) do { __builtin_amdgcn_s_setprio(1); _Pragma("unroll") for (int m = 0; m < 4; ++m) _Pragma("unroll") for (int n = 0; n < 2; ++n) _Pragma("unroll") for (int k = 0; k < 2; ++k) \
        acc[ai][bj][m][n] = __builtin_amdgcn_mfma_f32_16x16x32_bf16(Bt[n][k], At[m][k], acc[ai][bj][m][n], 0, 0, 0); __builtin_amdgcn_s_setprio(0); } while (0)
#define PG8_WAIT_V(n) asm volatile("s_waitcnt vmcnt(" #n ")" ::: "memory")
#define PG8_WAIT_L(n) asm volatile("s_waitcnt lgkmcnt(" #n ")" ::: "memory")
#define PG8_BAR __builtin_amdgcn_s_barrier()
#define PG8_SCHED __builtin_amdgcn_sched_barrier(0)
    Unit cur, nxt; int ui = 0;
    if (!S.next(0, cur)) return;
    f32x4 acc[2][2][4][2];
#pragma unroll
    for (int a = 0; a < 2; ++a)
#pragma unroll
        for (int b = 0; b < 2; ++b)
#pragma unroll
            for (int m = 0; m < 4; ++m)
#pragma unroll
                for (int n = 0; n < 2; ++n) acc[a][b][m][n] = (f32x4){0.f, 0.f, 0.f, 0.f};
    bf16x8 At[4][2], B0[2][2], B1[2][2];
    const char* cA = (const char*)g.A + (size_t)cur.pm * tstepA; const char* cB = (const char*)g.Bt + (size_t)cur.pn * tstepB;
    PG8_STAGE(PG8_SB(0, 0), cB, voffB); PG8_STAGE(PG8_SA(0, 0), cA, voffA); PG8_STAGE(PG8_SB(0, 1), cB + hstepB, voffB); PG8_STAGE(PG8_SA(0, 1), cA + hstepA, voffA);
    if (wr == 1) PG8_BAR;
    PG8_WAIT_V(4); PG8_BAR;
    PG8_STAGE(PG8_SB(1, 0), cB + kstep, voffB); PG8_STAGE(PG8_SA(1, 0), cA + kstep, voffA); PG8_STAGE(PG8_SB(1, 1), cB + hstepB + kstep, voffB);
    PG8_WAIT_V(6); PG8_BAR;
    for (;;) {
        const bool has_next = S.next(ui + 1, nxt);
        const char* nA = has_next ? (const char*)g.A + (size_t)nxt.pm * tstepA : cA; const char* nB = has_next ? (const char*)g.Bt + (size_t)nxt.pn * tstepB : cB;
        for (int t = 0; t < nt; t += 2) {
            const bool last = (t == nt - 2);
            const char* a1 = cA + (size_t)(t + 1) * kstep;
            const char* a2 = last ? nA : cA + (size_t)(t + 2) * kstep; const char* b2 = last ? nB : cB + (size_t)(t + 2) * kstep;
            const char* a3 = a2 + kstep; const char* b3 = b2 + kstep;
            PG8_LDB(B0, 0, 0); PG8_SCHED; PG8_LDA(At, 0, 0); PG8_STAGE(PG8_SA(1, 1), a1 + hstepA, voffA);
            PG8_WAIT_L(8); PG8_BAR; PG8_WAIT_L(0); PG8_MMA(0, 0, At, B0); PG8_BAR; PG8_SCHED;
            PG8_LDB(B1, 0, 1); PG8_STAGE(PG8_SB(0, 0), b2, voffB);
            PG8_BAR; PG8_WAIT_L(0); PG8_MMA(0, 1, At, B1); PG8_BAR;
            PG8_LDA(At, 0, 1); PG8_STAGE(PG8_SA(0, 0), a2, voffA);
            PG8_BAR; PG8_WAIT_L(0); PG8_MMA(1, 0, At, B0); PG8_BAR; PG8_SCHED;
            PG8_STAGE(PG8_SB(0, 1), b2 + hstepB, voffB);
            PG8_WAIT_V(6); PG8_BAR; PG8_MMA(1, 1, At, B1); PG8_BAR;
            PG8_LDB(B0, 1, 0); PG8_SCHED; PG8_LDA(At, 1, 0); PG8_STAGE(PG8_SA(0, 1), a2 + hstepA, voffA);
            PG8_WAIT_L(8); PG8_BAR; PG8_WAIT_L(0); PG8_MMA(0, 0, At, B0); PG8_BAR; PG8_SCHED;
            PG8_LDB(B1, 1, 1); PG8_STAGE(PG8_SB(1, 0), b3, voffB);
            PG8_BAR; PG8_WAIT_L(0); PG8_MMA(0, 1, At, B1); PG8_BAR;
            PG8_LDA(At, 1, 1); PG8_STAGE(PG8_SA(1, 0), a3, voffA);
            PG8_BAR; PG8_WAIT_L(0); PG8_MMA(1, 0, At, B0); PG8_BAR; PG8_SCHED;
            PG8_STAGE(PG8_SB(1, 1), b3 + hstepB, voffB);
            PG8_WAIT_V(6); PG8_BAR; PG8_MMA(1, 1, At, B1); PG8_BAR;
        }
        E(acc, cur, wr, wc, fr, fq);
        if (!has_next) break;
#pragma unroll
        for (int a = 0; a < 2; ++a)
#pragma unroll
            for (int b = 0; b < 2; ++b)
#pragma unroll
                for (int m = 0; m < 4; ++m)
#pragma unroll
                    for (int n = 0; n < 2; ++n) acc[a][b][m][n] = (f32x4){0.f, 0.f, 0.f, 0.f};
        cur = nxt; cA = nA; cB = nB; ++ui;
    }
    PG8_WAIT_V(0);
    if (wr == 0) PG8_BAR;
    PG8_BAR;
#undef PG8_SA
#undef PG8_SB
#undef PG8_STAGE
#undef PG8_LDA
#undef PG8_LDB
#undef PG8_MMA
#undef PG8_WAIT_V
#undef PG8_WAIT_L
#undef PG8_BAR
#undef PG8_SCHED
}
}

struct EpiProj {
    static constexpr bool PERM = true;
    bf16_t* O; const float* rstd; int ldc;
    __device__ __forceinline__ void operator()(const f32x4 (&acc)[2][2][4][2], const pg8::Unit& u, int wr, int wc, int fr, int fq) const {
        const int row0 = u.pm * 256 + wr * 64 + fr, col0 = u.pn * 256 + wc * 32 + 8 * fq;
#pragma unroll
        for (int ai = 0; ai < 2; ++ai)
#pragma unroll
            for (int m = 0; m < 4; ++m) { const int row = row0 + ai * 128 + m * 16; const float s = rstd[row]; bf16_t* rowp = O + (size_t)row * ldc + col0;
#pragma unroll
                for (int bj = 0; bj < 2; ++bj) { const f32x4 v0 = acc[ai][bj][m][0] * s, v1 = acc[ai][bj][m][1] * s;
                    u32x4 w; w.x = pk2(v0[0], v0[1]); w.y = pk2(v0[2], v0[3]); w.z = pk2(v1[0], v1[1]); w.w = pk2(v1[2], v1[3]);
                    *(u32x4*)(rowp + bj * 128) = w; } }
    }
};
struct EpiSq {
    static constexpr bool PERM = true;
    bf16_t* O; float* sumsq; int ldc;
    __device__ __forceinline__ void operator()(const f32x4 (&acc)[2][2][4][2], const pg8::Unit& u, int wr, int wc, int fr, int fq) const {
        const int row0 = u.pm * 256 + wr * 64 + fr, col0 = u.pn * 256 + wc * 32 + 8 * fq;
#pragma unroll
        for (int ai = 0; ai < 2; ++ai)
#pragma unroll
            for (int m = 0; m < 4; ++m) { const int row = row0 + ai * 128 + m * 16; bf16_t* rowp = O + (size_t)row * ldc + col0; float ss = 0.f;
#pragma unroll
                for (int bj = 0; bj < 2; ++bj) { const f32x4 v0 = acc[ai][bj][m][0], v1 = acc[ai][bj][m][1];
                    ss += (v0[0] * v0[0] + v0[1] * v0[1]) + (v0[2] * v0[2] + v0[3] * v0[3]) + (v1[0] * v1[0] + v1[1] * v1[1]) + (v1[2] * v1[2] + v1[3] * v1[3]);
                    u32x4 w; w.x = pk2(v0[0], v0[1]); w.y = pk2(v0[2], v0[3]); w.z = pk2(v1[0], v1[1]); w.w = pk2(v1[2], v1[3]);
                    *(u32x4*)(rowp + bj * 128) = w; }
                ss += __shfl_xor(ss, 16); ss += __shfl_xor(ss, 32);
                if (fq == 0) atomicAdd(sumsq + row, ss); }
    }
};
constexpr int SLAB_LD = 40, SLAB_BYTES = 64 * SLAB_LD;
struct EpiUp {
    static constexpr bool PERM = true;
    bf16_t* act; const float* rstd3; const float* cw; const float* cb; const float* cache; float* outp; float* outs; LAS unsigned char* xl;
    __device__ __forceinline__ void operator()(const f32x4 (&acc)[2][2][4][2], const pg8::Unit& u, int wr, int wc, int fr_, int fq_) const {
        int fr = fr_, fq = fq_; asm volatile("" : "+v"(fr), "+v"(fq));
        LAS unsigned char* slab = xl + (wr * 4 + wc) * SLAB_BYTES;
        const int lane = fq * 16 + fr, cq = lane & 3, rs = lane >> 2;
        const int j0 = u.pn * 128 + wc * 32 + 8 * cq;
        float sc[2][4];
#pragma unroll
        for (int ai = 0; ai < 2; ++ai)
#pragma unroll
            for (int m = 0; m < 4; ++m) { const int row = 248 * u.pm + 62 * (2 * ai + wr) - 2 + 16 * m + fr; const int rc = row < 0 ? 0 : (row < R ? row : R - 1); const float sv = rstd3[rc]; sc[ai][m] = (row >= 0 && row < R) ? sv : 0.f; }
        f32x4 wn[4];
        { const int colb = j0; wn[0] = *(const f32x4*)(cw + colb); wn[1] = *(const f32x4*)(cw + NUP + colb); wn[2] = *(const f32x4*)(cw + 2 * NUP + colb); wn[3] = *(const f32x4*)(cb + colb); }
        float cgv[4][4];
#pragma unroll
        for (int sp = 0; sp < 8; ++sp) {
            const int ai = sp >> 2, n = (sp >> 1) & 1, bj = sp & 1;
            const int rowbase = 248 * u.pm + 62 * (2 * ai + wr) - 2;
            const f32x4 w0 = wn[0], w1 = wn[1], w2 = wn[2], bb = wn[3];
            if (sp < 7) { const int sq = sp + 1, n2 = (sq >> 1) & 1, bj2 = sq & 1, colb = bj2 * DFF + j0 + 4 * n2;
                wn[0] = *(const f32x4*)(cw + colb); wn[1] = *(const f32x4*)(cw + NUP + colb); wn[2] = *(const f32x4*)(cw + 2 * NUP + colb); wn[3] = *(const f32x4*)(cb + colb); }
#pragma unroll
            for (int m = 0; m < 4; ++m) { const f32x4 v = acc[ai][bj][m][n] * sc[ai][m];
                u32x2 w; w.x = pk2(v[0], v[1]); w.y = pk2(v[2], v[3]); *(LAS u32x2*)(slab + (16 * m + fr) * SLAB_LD + fq * 8) = w; }
            f32x4 p2, p1;
            { const int h1 = rs > 0 ? 4 * rs - 1 : 0, h2 = rs > 0 ? 4 * rs - 2 : 0;
                const u32x2 q1 = *(const LAS u32x2*)(slab + h1 * SLAB_LD + cq * 8), q2 = *(const LAS u32x2*)(slab + h2 * SLAB_LD + cq * 8);
                p1[0] = bf2f(q1.x & 0xffff); p1[1] = bf2f(q1.x >> 16); p1[2] = bf2f(q1.y & 0xffff); p1[3] = bf2f(q1.y >> 16);
                p2[0] = bf2f(q2.x & 0xffff); p2[1] = bf2f(q2.x >> 16); p2[2] = bf2f(q2.y & 0xffff); p2[3] = bf2f(q2.y >> 16); }
#pragma unroll
            for (int i = 0; i < 4; ++i) {
                const int lr = 4 * rs + i, row = rowbase + lr;
                const u32x2 q0 = *(const LAS u32x2*)(slab + lr * SLAB_LD + cq * 8);
                f32x4 cur; cur[0] = bf2f(q0.x & 0xffff); cur[1] = bf2f(q0.x >> 16); cur[2] = bf2f(q0.y & 0xffff); cur[3] = bf2f(q0.y >> 16);
                const bool smp = row >= RP;
                const int t = smp ? ((row - RP) & (DSEQ - 1)) : (row & (SEQ - 1));
                const bool valid = (lr >= 2) && (row < R) && (t >= 2);
                const f32x4 cv = bb + w0 * p2 + w1 * p1 + w2 * cur;
                p2 = p1; p1 = cur;
                if (bj == 0) { cgv[i][0] = cv[0]; cgv[i][1] = cv[1]; cgv[i][2] = cv[2]; cgv[i][3] = cv[3]; }
                else { u32x2 w; w.x = pk2(gelu_tanh(cgv[i][0]) * cv[0], gelu_tanh(cgv[i][1]) * cv[1]); w.y = pk2(gelu_tanh(cgv[i][2]) * cv[2], gelu_tanh(cgv[i][3]) * cv[3]); if (valid) *(u32x2*)(act + (size_t)row * DFF + j0 + 4 * n) = w; }
            }
        }
    }
};

template <int MODE>
__device__ __forceinline__ void mini_gemm(LAS unsigned char* lds, const bf16_t* A, const bf16_t* Bt, int K, int N, bf16_t* O, int ldc, const float* rstd, float* sumsq, int bx, int G, int tid, int wave, int lane) {
    const int r = lane & 31, hf = lane >> 5, ntn = N >> 5, ntiles = 8 * ntn, kw = K >> 3;
    LAS float* red = (LAS float*)lds;
    for (int tile = bx; tile < ntiles; tile += G) {
        const int m0 = (tile / ntn) * 32, n0 = (tile % ntn) * 32;
        const bf16_t* ap = A + (size_t)(m0 + r) * K + wave * kw + 8 * hf; const bf16_t* bp = Bt + (size_t)(n0 + r) * K + wave * kw + 8 * hf;
        f32x16 acc; for (int i = 0; i < 16; ++i) acc[i] = 0.f;
        for (int k = 0; k < kw; k += 16) { const bf16x8 af = *(const bf16x8*)(ap + k), bf = *(const bf16x8*)(bp + k); acc = __builtin_amdgcn_mfma_f32_32x32x16_bf16(af, bf, acc, 0, 0, 0); }
        __syncthreads();
#pragma unroll
        for (int i = 0; i < 16; ++i) red[(wave * 16 + i) * 64 + lane] = acc[i];
        __syncthreads();
#pragma unroll
        for (int h2 = 0; h2 < 2; ++h2) {
            const int e = tid + h2 * 512, i = e >> 6, ln = e & 63;
            float v = 0.f;
#pragma unroll
            for (int w = 0; w < 8; ++w) v += red[(w * 16 + i) * 64 + ln];
            const int row = m0 + (i & 3) + 8 * (i >> 2) + 4 * (ln >> 5), col = n0 + (ln & 31);
            if (MODE == 0) { O[(size_t)row * ldc + col] = (bf16_t)f2bf(v * rstd[row]); }
            else { O[(size_t)row * ldc + col] = (bf16_t)f2bf(v); float ss = v * v;
#pragma unroll
                for (int o = 1; o < 32; o <<= 1) ss += __shfl_xor(ss, o);
                if ((ln & 31) == 0) atomicAdd(sumsq + row, ss); }
        }
    }
    __syncthreads();
}

__device__ __forceinline__ int fix_row(int m) { const int sq = m >> 2, k4 = m & 3; return sq < 8 ? sq * SEQ + (k4 < 2 ? k4 : SEQ - 4 + k4) : RP + (sq - 8) * DSEQ + (k4 < 2 ? k4 : DSEQ - 4 + k4); }
__device__ __forceinline__ void up_fixup(const Args& a, LAS unsigned char* lds, int bx, int G, int tid, int wave, int lane) {
    const int r = lane & 31, hf = lane >> 5;
    LAS float* red = (LAS float*)lds;
    LAS float* tile = (LAS float*)(lds + 65536);
    const bf16_t* hb = (const bf16_t*)(a.ws + WS_HB); const bf16_t* W = (const bf16_t*)(a.ws + WS_WUP); const float* rstd3 = (const float*)(a.ws + WS_RSTD3);
    for (int item = bx; item < 176; item += G) {
        const int mt = item / 88, cp = item % 88, pn = cp >> 2, sub = cp & 3;
        const bf16_t* ap = hb + (size_t)fix_row(mt * 32 + r) * DM + wave * 128 + 8 * hf;
        const bf16_t* bg = W + (size_t)(256 * pn + 32 * sub + r) * DM + wave * 128 + 8 * hf; const bf16_t* bv = bg + (size_t)128 * DM;
        f32x16 ag, av; for (int i = 0; i < 16; ++i) { ag[i] = 0.f; av[i] = 0.f; }
#pragma unroll
        for (int k = 0; k < 128; k += 16) { const bf16x8 af = *(const bf16x8*)(ap + k); ag = __builtin_amdgcn_mfma_f32_32x32x16_bf16(af, *(const bf16x8*)(bg + k), ag, 0, 0, 0); av = __builtin_amdgcn_mfma_f32_32x32x16_bf16(af, *(const bf16x8*)(bv + k), av, 0, 0, 0); }
        __syncthreads();
#pragma unroll
        for (int i = 0; i < 16; ++i) { red[((wave * 2 + 0) * 16 + i) * 64 + lane] = ag[i]; red[((wave * 2 + 1) * 16 + i) * 64 + lane] = av[i]; }
        __syncthreads();
#pragma unroll
        for (int h4 = 0; h4 < 4; ++h4) {
            const int e = tid + h4 * 512, gv = e >> 10, i = (e >> 6) & 15, ln = e & 63;
            float v = 0.f;
#pragma unroll
            for (int w = 0; w < 8; ++w) v += red[((w * 2 + gv) * 16 + i) * 64 + ln];
            const int ml = (i & 3) + 8 * (i >> 2) + 4 * (ln >> 5);
            tile[(gv * 32 + ml) * 32 + (ln & 31)] = v * rstd3[fix_row(mt * 32 + ml)];
        }
        __syncthreads();
        {
            const int q = tid >> 6, c = tid & 31, part = (tid >> 5) & 1, m0 = 4 * q, b = q;
            const int j = 128 * pn + 32 * sub + c;
            if (part == 0) {
                const float* cw = a.in[I_FCW]; const float* cb = a.in[I_FCB];
                const float ug0 = tile[(m0) * 32 + c], ug1 = tile[(m0 + 1) * 32 + c], uv0 = tile[(32 + m0) * 32 + c], uv1 = tile[(32 + m0 + 1) * 32 + c];
                float hg0 = 0.f, hg1 = 0.f, hv0 = 0.f, hv1 = 0.f;
                if (mt) { const float* ch = a.in[I_CFFN] + (size_t)(b * 2) * NUP; hg0 = ch[j]; hg1 = ch[NUP + j]; hv0 = ch[DFF + j]; hv1 = ch[NUP + DFF + j]; }
                const float wg0 = cw[j], wg1 = cw[NUP + j], wg2 = cw[2 * NUP + j], bgg = cb[j], wv0 = cw[DFF + j], wv1 = cw[NUP + DFF + j], wv2 = cw[2 * NUP + DFF + j], bvv = cb[DFF + j];
                const float cg0 = bgg + wg0 * hg0 + wg1 * hg1 + wg2 * ug0, cv0 = bvv + wv0 * hv0 + wv1 * hv1 + wv2 * uv0;
                const float cg1 = bgg + wg0 * hg1 + wg1 * ug0 + wg2 * ug1, cv1 = bvv + wv0 * hv1 + wv1 * uv0 + wv2 * uv1;
                bf16_t* act = (bf16_t*)(a.ws + WS_ACT);
                const int row0 = fix_row(mt * 32 + m0);
                act[(size_t)row0 * DFF + j] = (bf16_t)f2bf(gelu_tanh(cg0) * cv0); act[(size_t)(row0 + 1) * DFF + j] = (bf16_t)f2bf(gelu_tanh(cg1) * cv1);
            } else {
                float* op = (mt ? a.out + O_FFNS : a.out + O_FFNP) + (size_t)(b * 2) * NUP;
                op[j] = tile[(m0 + 2) * 32 + c]; op[NUP + j] = tile[(m0 + 3) * 32 + c]; op[DFF + j] = tile[(32 + m0 + 2) * 32 + c]; op[NUP + DFF + j] = tile[(32 + m0 + 3) * 32 + c];
            }
        }
    }
    __syncthreads();
}

__device__ __forceinline__ void transpose_item(const float* W, int ldw, int K, bf16_t* WT, const float* kscale, LAS float* scr, int k0, int srccol0, int dstrow0, int lane) {
#pragma unroll 8
    for (int i = 0; i < 32; ++i) { const int kk = 2 * i + (lane >> 5); float v = W[(size_t)(k0 + kk) * ldw + srccol0 + (lane & 31)]; if (kscale) v *= kscale[k0 + kk]; scr[kk * 33 + (lane & 31)] = v; }
    asm volatile("s_waitcnt lgkmcnt(0)" ::: "memory");
    const int c = lane & 7;
#pragma unroll
    for (int j = 0; j < 4; ++j) { const int n = (lane >> 3) + 8 * j; const LAS float* s = scr + (8 * c) * 33 + n;
        u32x4 o; o.x = pk2(s[0 * 33], s[1 * 33]); o.y = pk2(s[2 * 33], s[3 * 33]); o.z = pk2(s[4 * 33], s[5 * 33]); o.w = pk2(s[6 * 33], s[7 * 33]);
        *(u32x4*)(WT + (size_t)(dstrow0 + n) * K + k0 + 8 * c) = o; }
    asm volatile("s_waitcnt lgkmcnt(0)" ::: "memory");
}

__device__ __forceinline__ void p0_prologue(const Args& a, LAS unsigned char* lds, int gw, int NGW, int lane, int wave) {
    unsigned char* ws = a.ws;
    LAS float* scr = (LAS float*)(lds + wave * 16384);
    bf16_t* WinT = (bf16_t*)(ws + WS_WIN); bf16_t* WoutT = (bf16_t*)(ws + WS_WOUT); bf16_t* WupT = (bf16_t*)(ws + WS_WUP); bf16_t* WdownT = (bf16_t*)(ws + WS_WDOWN);
    constexpr int I_IN = 16 * 64, I_OUT = 16 * 32, I_UP = 16 * 176, I_DOWN = 44 * 32, NIT = I_IN + I_OUT + I_UP + I_DOWN;
    for (int it = gw; it < NIT; it += NGW) {
        int r = it;
        if (r < I_IN) { const int kb = r / 64, nb = r % 64; const int dst = nb * 32; const int src = dst < 1536 ? dst : dst + 8;
            transpose_item(a.in[I_WIN], 2056, 1024, WinT, a.in[I_PREMIX], scr, kb * 64, src, dst, lane); continue; }
        r -= I_IN;
        if (r < I_OUT) { const int kb = r / 32, nb = r % 32; transpose_item(a.in[I_WOUT], 1024, 1024, WoutT, nullptr, scr, kb * 64, nb * 32, nb * 32, lane); continue; }
        r -= I_OUT;
        if (r < I_UP) { const int kb = r / 176, nb = r % 176; const int dst = nb * 32; const int pn = dst >> 8, i = dst & 255; const int src = i < 128 ? pn * 128 + i : DFF + pn * 128 + (i - 128);
            transpose_item(a.in[I_WUP], NUP, 1024, WupT, a.in[I_PREFFN], scr, kb * 64, src, dst, lane); continue; }
        r -= I_UP;
        { const int kb = r / 32, nb = r % 32; transpose_item(a.in[I_WDOWN], 1024, DFF, WdownT, nullptr, scr, kb * 64, nb * 32, nb * 32, lane); }
    }
    { float* s2 = (float*)(ws + WS_SUMSQ2); float* s4 = (float*)(ws + WS_SUMSQ4);
      for (int i = gw * 64 + lane; i < R; i += NGW * 64) { s2[i] = 0.f; s4[i] = 0.f; } }
    float wd[8][16];
    { const float* Win = a.in[I_WIN]; const float* pw = a.in[I_PREMIX];
#pragma unroll
      for (int j = 0; j < 8; ++j)
#pragma unroll
          for (int q = 0; q < 4; ++q)
#pragma unroll
              for (int e = 0; e < 4; ++e) { const int k = q * 256 + lane * 4 + e; wd[j][q * 4 + e] = Win[(size_t)k * 2056 + 1536 + j] * pw[k]; } }
    bf16_t* xb = (bf16_t*)(ws + WS_HB); float* rstd1 = (float*)(ws + WS_RSTD1); float* dtv = (float*)(ws + WS_DTV);
    const float* dtb = a.in[I_DTB];
    for (int row0 = 2 * gw; row0 < R; row0 += 2 * NGW) {
        f32x4 vv[2][4];
#pragma unroll
        for (int rr = 0; rr < 2; ++rr) { const int row = row0 + rr;
            const float* xr = row < RP ? a.in[I_XP] + (size_t)row * DM : a.in[I_XS] + (size_t)(row - RP) * DM;
#pragma unroll
            for (int q = 0; q < 4; ++q) vv[rr][q] = *(const f32x4*)(xr + q * 256 + lane * 4); }
#pragma unroll
        for (int rr = 0; rr < 2; ++rr) { const int row = row0 + rr;
            float ss = 0.f;
#pragma unroll
            for (int q = 0; q < 4; ++q) { const f32x4 v = vv[rr][q]; ss += (v[0] * v[0] + v[1] * v[1]) + (v[2] * v[2] + v[3] * v[3]); }
            ss = wave_sum(ss);
            const float rs = 1.f / sqrtf(ss * (1.f / DM) + EPS);
#pragma unroll
            for (int q = 0; q < 4; ++q) { const f32x4 v = vv[rr][q]; u32x2 w; w.x = pk2(v[0], v[1]); w.y = pk2(v[2], v[3]); *(u32x2*)(xb + (size_t)row * DM + q * 256 + lane * 4) = w; }
            float myd = 0.f;
#pragma unroll
            for (int j = 0; j < 8; ++j) { float d = 0.f;
#pragma unroll
                for (int q = 0; q < 4; ++q)
#pragma unroll
                    for (int e = 0; e < 4; ++e) d += vv[rr][q][e] * wd[j][q * 4 + e];
                d = wave_sum(d);
                if (lane == j) myd = d; }
            if (lane < 8) { const float xx = myd * rs + dtb[lane]; dtv[(size_t)row * 8 + lane] = xx > 20.f ? xx : log1pf(expf(xx)); }
            if (lane == 0) rstd1[row] = rs; }
    }
}

constexpr int XT_LD = 72, BN_LD = 136;
constexpr int L_XT = 0;
constexpr int L_BT = 36864;
constexpr int L_CN = L_BT + 18432;
constexpr int L_CS = L_CN + 17408;
constexpr int L_SSD_END = L_CS + 4 * 4 * 64 * 4;
constexpr int SUB_LDS = L_SSD_END + 64;
__device__ __forceinline__ void sub_barrier(LAS unsigned* cnt, unsigned& target, int lane) {
    asm volatile("s_waitcnt lgkmcnt(0)" ::: "memory");
    target += 4u;
    if (lane == 0) __hip_atomic_fetch_add(cnt, 1u, __ATOMIC_RELAXED, __HIP_MEMORY_SCOPE_WORKGROUP);
    for (;;) { const unsigned v = (unsigned)__builtin_amdgcn_readfirstlane((int)__hip_atomic_load(cnt, __ATOMIC_RELAXED, __HIP_MEMORY_SCOPE_WORKGROUP)); if ((int)(v - target) >= 0) break; __builtin_amdgcn_s_sleep(1); }
    asm volatile("" ::: "memory");
}

struct SeqInfo { int row0; int nreal; int pad; bool smp; int b; int slot; };
__device__ __forceinline__ SeqInfo ssd_unit(int ubc) {
    SeqInfo s;
    if (ubc < NBATCH * NCHUNK) { s.b = ubc >> 7; s.row0 = ubc * 64; s.pad = 0; s.smp = false; }
    else { s.b = ubc - NBATCH * NCHUNK; s.row0 = RP + s.b * DSEQ - 32; s.pad = 32; s.smp = true; }
    s.slot = ubc; s.nreal = 64 - s.pad; return s;
}

__device__ __forceinline__ void ssd_cs(const Args& a, LAS unsigned char* lds, const SeqInfo& si, int g, int lane, int mode, float* cdec) {
    LAS float* cs = (LAS float*)(lds + L_CS); LAS float* dtl = cs + 256; LAS float* aux = cs + 512;
    const float* dtv = (const float*)(a.ws + WS_DTV);
#pragma unroll
    for (int h4 = 0; h4 < 4; ++h4) {
        const int h = g * 4 + h4;
        float d = dtv[(size_t)(si.row0 + lane) * 8 + h]; d = lane >= si.pad ? d : 0.f;
        const float av = -__expf(a.in[I_ALOG][h]);
        float x = d * av;
#pragma unroll
        for (int o = 1; o < 64; o <<= 1) { const float y = __shfl_up(x, o); if (lane >= o) x += y; }
        const float ce = __shfl(x, 63);
        cs[h4 * 64 + lane] = x * 1.4426950409f; dtl[h4 * 64 + lane] = d;
        aux[h4 * 64 + lane] = mode == 0 ? __expf(ce - x) * d : __expf(x);
        if (mode == 0 && lane == 0 && cdec) cdec[(size_t)si.slot * 8 + h] = __expf(ce);
    }
}

__device__ __forceinline__ void raw8(const Args& a, const SeqInfo& si, int tpos  , int tok  , int cch, float (&o)[8]) {
    const bf16_t* proj = (const bf16_t*)(a.ws + WS_PROJ);
    if (tpos >= 0) { const u32x4 w = *(const u32x4*)(proj + (size_t)(si.row0 + tok) * NPROJ + 512 + cch);
        o[0] = bf2f(w.x & 0xffff); o[1] = bf2f(w.x >> 16); o[2] = bf2f(w.y & 0xffff); o[3] = bf2f(w.y >> 16); o[4] = bf2f(w.z & 0xffff); o[5] = bf2f(w.z >> 16); o[6] = bf2f(w.w & 0xffff); o[7] = bf2f(w.w >> 16); }
    else if (si.smp && tpos >= -3) { const float* c = a.in[I_CSSD] + (size_t)(si.b * 3 + (tpos + 3)) * 1024 + cch;
#pragma unroll
        for (int e = 0; e < 8; ++e) o[e] = c[e]; }
    else {
#pragma unroll
        for (int e = 0; e < 8; ++e) o[e] = 0.f; }
}

__device__ __forceinline__ void rowvals(const Args& a, const SeqInfo& si, const u32x4 w, int tpos, int cch, float (&o)[8]) {
    o[0] = bf2f(w.x & 0xffff); o[1] = bf2f(w.x >> 16); o[2] = bf2f(w.y & 0xffff); o[3] = bf2f(w.y >> 16); o[4] = bf2f(w.z & 0xffff); o[5] = bf2f(w.z >> 16); o[6] = bf2f(w.w & 0xffff); o[7] = bf2f(w.w >> 16);
    if (tpos < 0) {
        if (si.smp && tpos >= -3) { const float* c = a.in[I_CSSD] + (size_t)(si.b * 3 + (tpos + 3)) * 1024 + cch;
#pragma unroll
            for (int e = 0; e < 8; ++e) o[e] = c[e]; }
        else {
#pragma unroll
            for (int e = 0; e < 8; ++e) o[e] = 0.f; }
    }
}
__device__ __forceinline__ void ssd_stage(const Args& a, LAS unsigned char* lds, const SeqInfo& si, int g, int c_in_seq, int tid, int mode) {
    const int cg8 = tid & 63;
    if (mode == 0 && cg8 >= 48) return;
    int cch, kind;
    if (cg8 < 32) { kind = 0; cch = g * 256 + cg8 * 8; } else if (cg8 < 48) { kind = 1; cch = 512 + g * 128 + (cg8 - 32) * 8; } else { kind = 2; cch = 768 + g * 128 + (cg8 - 48) * 8; }
    float w[4][8], bias[8];
#pragma unroll
    for (int k = 0; k < 4; ++k) { const f32x4 a0 = *(const f32x4*)(a.in[I_SCW] + k * 1024 + cch), a1 = *(const f32x4*)(a.in[I_SCW] + k * 1024 + cch + 4);
#pragma unroll
        for (int e = 0; e < 4; ++e) { w[k][e] = a0[e]; w[k][4 + e] = a1[e]; } }
    { const f32x4 a0 = *(const f32x4*)(a.in[I_SCB] + cch), a1 = *(const f32x4*)(a.in[I_SCB] + cch + 4);
#pragma unroll
      for (int e = 0; e < 4; ++e) { bias[e] = a0[e]; bias[4 + e] = a1[e]; } }
    const int seq0 = si.smp ? -32 : c_in_seq * 64;
#pragma unroll
    for (int tgi = 0; tgi < 2; ++tgi) {
    const int tg = __builtin_amdgcn_readfirstlane(tid >> 6) + 4 * tgi;
    const int t0 = 8 * tg;
    float r0[8], r1[8], r2[8], r3[8];
    u32x4 rw[11];
    { const bf16_t* pr = (const bf16_t*)(a.ws + WS_PROJ) + (size_t)(si.row0 + t0 - 3) * NPROJ + 512 + cch;
#pragma unroll
      for (int i = 0; i < 11; ++i) rw[i] = *(const u32x4*)(pr + (size_t)i * NPROJ); }
    rowvals(a, si, rw[0], seq0 + t0 - 3, cch, r0); rowvals(a, si, rw[1], seq0 + t0 - 2, cch, r1); rowvals(a, si, rw[2], seq0 + t0 - 1, cch, r2);
    unsigned pk[4][8]; float prev[8];
    const LAS float* aux = (const LAS float*)(lds + L_CS) + 512;
#pragma unroll
    for (int i = 0; i < 8; ++i) {
        rowvals(a, si, rw[3 + i], seq0 + t0 + i, cch, r3);
        const bool real = (t0 + i) >= si.pad;
        float sc = 1.f;
        if (mode == 0) { const float sv = aux[((cg8 >> 3) & 3) * 64 + t0 + i]; sc = kind == 0 ? sv : 1.f; }
#pragma unroll
        for (int e = 0; e < 8; ++e) { const float v = __builtin_fmaf(w[3][e], r3[e], __builtin_fmaf(w[2][e], r2[e], __builtin_fmaf(w[1][e], r1[e], __builtin_fmaf(w[0][e], r0[e], bias[e]))));
            const float ov = real ? silu_f(v) * sc : 0.f; r0[e] = r1[e]; r1[e] = r2[e]; r2[e] = r3[e];
            if (i & 1) pk[i >> 1][e] = pk2(prev[e], ov); else prev[e] = ov; }
    }
    const bool transposed = (kind == 0) || (mode == 0);
    if (transposed) {
        LAS bf16_t* base = kind == 0 ? (LAS bf16_t*)(lds + L_XT) + (cg8 * 8) * XT_LD : (LAS bf16_t*)(lds + L_BT) + ((cg8 - 32) * 8) * XT_LD;
#pragma unroll
        for (int e = 0; e < 8; ++e) { u32x4 o; o.x = pk[0][e]; o.y = pk[1][e]; o.z = pk[2][e]; o.w = pk[3][e];
            *(LAS u32x4*)(base + e * XT_LD + ((tg ^ (cg8 & 7)) << 3)) = o; }
    } else {
        LAS bf16_t* base = kind == 1 ? (LAS bf16_t*)(lds + L_BT) + (cg8 - 32) * 8 : (LAS bf16_t*)(lds + L_CN) + (cg8 - 48) * 8;
#pragma unroll
        for (int q = 0; q < 4; ++q) {
            u32x4 o0, o1;
#pragma unroll
            for (int c2 = 0; c2 < 4; ++c2) { const unsigned lo = pk[q][2 * c2], hi = pk[q][2 * c2 + 1];
                o0[c2] = (lo & 0xffffu) | (hi << 16); o1[c2] = (lo >> 16) | (hi & 0xffff0000u); }
            *(LAS u32x4*)(base + (t0 + 2 * q) * BN_LD) = o0; *(LAS u32x4*)(base + (t0 + 2 * q + 1) * BN_LD) = o1;
        }
    }
    }
}

#define MFMA32(a, b, c) __builtin_amdgcn_mfma_f32_32x32x16_bf16((a), (b), (c), 0, 0, 0)
__device__ __forceinline__ f32x16 zero16() { f32x16 z; for (int i = 0; i < 16; ++i) z[i] = 0.f; return z; }

__device__ __forceinline__ void ssd_passA_unit(const Args& a, LAS unsigned char* lds, int unit, int tid, int w4, int lane, LAS unsigned* bcnt, unsigned& btarget) {
    const int ubc = unit >> 1, g = unit & 1;
    const SeqInfo si = ssd_unit(ubc);
    sub_barrier(bcnt, btarget, lane);
    ssd_cs(a, lds, si, g, lane, 0, w4 == 0 ? (float*)(a.ws + WS_CDEC) : nullptr);
    ssd_stage(a, lds, si, g, ubc & 127, tid, 0);
    sub_barrier(bcnt, btarget, lane);
    const int h4 = w4, r = lane & 31, hf = lane >> 5;
    const LAS bf16_t* XT = (const LAS bf16_t*)(lds + L_XT); const LAS bf16_t* BT = (const LAS bf16_t*)(lds + L_BT);
    bf16_t* sst = (bf16_t*)(a.ws + WS_SST) + ((size_t)si.slot * 8 + g * 4 + h4) * 8192;
#pragma unroll 1
    for (int nh = 0; nh < 2; ++nh) {
        f32x16 acc[2][2]; acc[0][0] = zero16(); acc[0][1] = zero16(); acc[1][0] = zero16(); acc[1][1] = zero16();
#pragma unroll
        for (int ks = 0; ks < 4; ++ks) {
            bf16x8 af[2], bfr[2];
#pragma unroll
            for (int ni = 0; ni < 2; ++ni) af[ni] = *(const LAS bf16x8*)(BT + (nh * 64 + ni * 32 + r) * XT_LD + (((ks * 2 + hf) ^ ((ni * 4 + (r >> 3)) & 7)) << 3));
#pragma unroll
            for (int pj = 0; pj < 2; ++pj) bfr[pj] = *(const LAS bf16x8*)(XT + (h4 * 64 + pj * 32 + r) * XT_LD + (((ks * 2 + hf) ^ ((pj * 4 + (r >> 3)) & 7)) << 3));
#pragma unroll
            for (int ni = 0; ni < 2; ++ni)
#pragma unroll
                for (int pj = 0; pj < 2; ++pj) acc[ni][pj] = MFMA32(af[ni], bfr[pj], acc[ni][pj]);
        }
#pragma unroll
        for (int ni = 0; ni < 2; ++ni)
#pragma unroll
            for (int pj = 0; pj < 2; ++pj)
#pragma unroll
                for (int i = 0; i < 4; ++i) { const int p = pj * 32 + r, n = nh * 64 + ni * 32 + 8 * i + 4 * hf;
                    u32x2 w; w.x = pk2(acc[ni][pj][4 * i], acc[ni][pj][4 * i + 1]); w.y = pk2(acc[ni][pj][4 * i + 2], acc[ni][pj][4 * i + 3]);
                    *(u32x2*)(sst + p * 128 + n) = w; }
    }
}

__device__ __forceinline__ void ssd_passC_unit(const Args& a, LAS unsigned char* lds, int unit, int tid, int w4, int lane, LAS unsigned* bcnt, unsigned& btarget) {
    const int ubc = unit >> 1, g = unit & 1;
    const SeqInfo si = ssd_unit(ubc);
    sub_barrier(bcnt, btarget, lane);
    ssd_cs(a, lds, si, g, lane, 1, nullptr);
    ssd_stage(a, lds, si, g, ubc & 127, tid, 1);
    sub_barrier(bcnt, btarget, lane);
    const int h4 = w4, r = lane & 31, hf = lane >> 5, h = g * 4 + h4;
    const LAS bf16_t* XT = (const LAS bf16_t*)(lds + L_XT) + h4 * 64 * XT_LD; const LAS bf16_t* Bn = (const LAS bf16_t*)(lds + L_BT); const LAS bf16_t* Cn = (const LAS bf16_t*)(lds + L_CN);
    const LAS float* cs = (const LAS float*)(lds + L_CS) + h4 * 64; const LAS float* dtl = cs + 256; const LAS float* ecs = cs + 512; LAS float* red = (LAS float*)(lds + L_CS) + 768;
#pragma unroll 1
    for (int lh = 0; lh < 2; ++lh) {
    const int l = lh * 32 + r;
    const int row = si.row0 + l;
    const bool realtok = l >= si.pad;
    const bf16_t* zrow = (const bf16_t*)(a.ws + WS_PROJ) + (size_t)row * NPROJ + g * 256 + h4 * 64;
    u32x2 zq[2][4];
#pragma unroll
    for (int pt = 0; pt < 2; ++pt)
#pragma unroll
        for (int i = 0; i < 4; ++i) zq[pt][i] = *(const u32x2*)(zrow + pt * 32 + 8 * i + 4 * hf);
    bf16x8 cf[8];
#pragma unroll
    for (int ks = 0; ks < 8; ++ks) cf[ks] = *(const LAS bf16x8*)(Cn + l * BN_LD + ks * 16 + 8 * hf);
    f32x16 ya[2]; ya[0] = zero16(); ya[1] = zero16();
    const bf16_t* hp = (const bf16_t*)(a.ws + WS_SST) + ((size_t)si.slot * 8 + h) * 8192;
#pragma unroll
    for (int ks = 0; ks < 8; ++ks) {
#pragma unroll
        for (int pt = 0; pt < 2; ++pt) { const bf16x8 af = *(const bf16x8*)(hp + (pt * 32 + r) * 128 + ks * 16 + 8 * hf); ya[pt] = MFMA32(af, cf[ks], ya[pt]); }
    }
    { const float e = ecs[l];
#pragma unroll
      for (int pt = 0; pt < 2; ++pt)
#pragma unroll
          for (int i = 0; i < 16; ++i) ya[pt][i] *= e; }
    const float csl = cs[l];
#pragma unroll
    for (int st = 0; st < 2; ++st) {
        if (st <= lh) {
            f32x16 sa = zero16();
#pragma unroll
            for (int ks = 0; ks < 8; ++ks) { const bf16x8 af = *(const LAS bf16x8*)(Bn + (st * 32 + r) * BN_LD + ks * 16 + 8 * hf); sa = MFMA32(af, cf[ks], sa); }
#pragma unroll
            for (int i = 0; i < 16; ++i) { const int s = st * 32 + (i & 3) + 8 * (i >> 2) + 4 * hf;
                const float v = sa[i] * __builtin_amdgcn_exp2f(csl - cs[s]) * dtl[s]; sa[i] = (s <= l) ? v : 0.f; }
#pragma unroll
            for (int k2 = 0; k2 < 2; ++k2) {
                u32x4 gp; gp.x = pk2(sa[8 * k2 + 0], sa[8 * k2 + 1]); gp.y = pk2(sa[8 * k2 + 2], sa[8 * k2 + 3]); gp.z = pk2(sa[8 * k2 + 4], sa[8 * k2 + 5]); gp.w = pk2(sa[8 * k2 + 6], sa[8 * k2 + 7]);
                const bf16x8 gf = __builtin_bit_cast(bf16x8, gp);
#pragma unroll
                for (int pt = 0; pt < 2; ++pt) {
                    const LAS bf16_t* xr = XT + (pt * 32 + r) * XT_LD + 4 * hf; const int swz = (pt * 4 + (r >> 3)) & 7;
                    const u32x2 lo = *(const LAS u32x2*)(xr + (((st * 4 + 2 * k2) ^ swz) << 3)), hi = *(const LAS u32x2*)(xr + (((st * 4 + 2 * k2 + 1) ^ swz) << 3));
                    u32x4 xa; xa.x = lo.x; xa.y = lo.y; xa.z = hi.x; xa.w = hi.y;
                    ya[pt] = MFMA32(__builtin_bit_cast(bf16x8, xa), gf, ya[pt]);
                }
            }
        }
    }
    const float Dh = a.in[I_SSDD][h];
    float ssq = 0.f;
#pragma unroll
    for (int pt = 0; pt < 2; ++pt)
#pragma unroll
        for (int i = 0; i < 4; ++i) {
            const int p0 = pt * 32 + 8 * i + 4 * hf;
            const u32x2 zz = zq[pt][i];
            const float zv[4] = {bf2f(zz.x & 0xffff), bf2f(zz.x >> 16), bf2f(zz.y & 0xffff), bf2f(zz.y >> 16)};
#pragma unroll
            for (int j = 0; j < 4; ++j) { const float xv = bf2f(XT[(p0 + j) * XT_LD + ((((l >> 3) ^ ((pt * 4 + i) & 7)) << 3) | (l & 7))]); const float y = (ya[pt][4 * i + j] + Dh * xv) * silu_f(zv[j]); ya[pt][4 * i + j] = y; ssq += y * y; }
        }
    ssq += __shfl_xor(ssq, 32);
    if (hf == 0) red[h4 * 64 + l] = ssq;
    sub_barrier(bcnt, btarget, lane);
    const float* nw0 = a.in[I_SNW] + g * 256 + h4 * 64;
    const float tot = red[l] + red[64 + l] + red[128 + l] + red[192 + l];
    const float rs = 1.f / sqrtf(tot * (1.f / 256.f) + EPS);
    if (realtok) {
        bf16_t* orow = (bf16_t*)(a.ws + WS_MIXIN) + (size_t)row * DM + g * 256 + h4 * 64;
#pragma unroll
        for (int pt = 0; pt < 2; ++pt)
#pragma unroll
            for (int i = 0; i < 4; ++i) { const int p0 = pt * 32 + 8 * i + 4 * hf; const f32x4 nq = *(const f32x4*)(nw0 + p0);
                u32x2 w; w.x = pk2(ya[pt][4 * i] * rs * nq[0], ya[pt][4 * i + 1] * rs * nq[1]); w.y = pk2(ya[pt][4 * i + 2] * rs * nq[2], ya[pt][4 * i + 3] * rs * nq[3]);
                *(u32x2*)(orow + p0) = w; }
    }
    }
}

struct S5Consts { float lbr, lbi; bf16x8 bb[4]; };
__device__ __forceinline__ void s5_lambda(const Args& a, int g, int p, float& lbr, float& lbi, float& qr, float& qi) {
    const float lr = a.in[I_LRE][g * 64 + p], li = a.in[I_LIM][g * 64 + p], dt = expf(a.in[I_LDT][g]);
    const float mag = expf(lr * dt), ang = li * dt;
    lbr = mag * cosf(ang); lbi = mag * sinf(ang);
    const float den = lr * lr + li * li;
    qr = ((lbr - 1.f) * lr + lbi * li) / den; qi = (lbi * lr - (lbr - 1.f) * li) / den;
}
__device__ __forceinline__ void s5_consts(const Args& a, int g, int lane, S5Consts& c) {
    const int r = lane & 31, hf = lane >> 5;
    float lb0r, lb0i, q0r, q0i, lb1r, lb1i, q1r, q1i;
    s5_lambda(a, g, r, lb0r, lb0i, q0r, q0i); s5_lambda(a, g, 32 + r, lb1r, lb1i, q1r, q1i);
    c.lbr = hf ? lb1r : lb0r; c.lbi = hf ? lb1i : lb0i;
#pragma unroll
    for (int nb = 0; nb < 4; ++nb) {
        const int ps = r + 32 * (nb >> 1); const float qr = (nb >> 1) ? q1r : q0r, qi = (nb >> 1) ? q1i : q0i;
        const float* br = a.in[I_BRE] + (size_t)(g * 64 + ps) * 16 + 8 * hf; const float* bi = a.in[I_BIM] + (size_t)(g * 64 + ps) * 16 + 8 * hf;
        float v[8];
#pragma unroll
        for (int j = 0; j < 8; ++j) v[j] = (nb & 1) ? (qr * bi[j] + qi * br[j]) : (qr * br[j] - qi * bi[j]);
        u32x4 w; w.x = pk2(v[0], v[1]); w.y = pk2(v[2], v[3]); w.z = pk2(v[4], v[5]); w.w = pk2(v[6], v[7]);
        c.bb[nb] = __builtin_bit_cast(bf16x8, w);
    }
}
template <bool STORE>
__device__ __forceinline__ void s5_block(const Args& a, const S5Consts& c, const bf16x8 uf, int lane, float& hr, float& hi, LAS unsigned char* wl, const bf16_t* nxt, bf16x8& nuf) {
    f32x16 bu[4];
#pragma unroll
    for (int nb = 0; nb < 4; ++nb) bu[nb] = MFMA32(uf, c.bb[nb], zero16());
    asm volatile("" ::: "memory");
    nuf = *(const bf16x8*)nxt;
    asm volatile("" ::: "memory");
#pragma unroll
    for (int i = 0; i < 16; ++i) {
        auto s0 = __builtin_amdgcn_permlane32_swap(__float_as_uint(bu[0][i]), __float_as_uint(bu[2][i]), false, false);
        auto s1 = __builtin_amdgcn_permlane32_swap(__float_as_uint(bu[1][i]), __float_as_uint(bu[3][i]), false, false);
        bu[0][i] = __uint_as_float(s0[0]); bu[2][i] = __uint_as_float(s0[1]); bu[1][i] = __uint_as_float(s1[0]); bu[3][i] = __uint_as_float(s1[1]);
    }
    const float nlbi = -c.lbi;
#pragma unroll
    for (int ib = 0; ib < 4; ++ib) {
#pragma unroll
        for (int j = 0; j < 4; ++j) { const float nr = __builtin_fmaf(c.lbr, hr, __builtin_fmaf(nlbi, hi, bu[0][4 * ib + j])), ni = __builtin_fmaf(c.lbr, hi, __builtin_fmaf(c.lbi, hr, bu[1][4 * ib + j])); hr = nr; hi = ni; if (STORE) *(LAS unsigned*)(wl + (8 * ib + j) * 272 + lane * 4) = pk2(hr, hi); }
#pragma unroll
        for (int j = 0; j < 4; ++j) { const float nr = __builtin_fmaf(c.lbr, hr, __builtin_fmaf(nlbi, hi, bu[2][4 * ib + j])), ni = __builtin_fmaf(c.lbr, hi, __builtin_fmaf(c.lbi, hr, bu[3][4 * ib + j])); hr = nr; hi = ni; if (STORE) *(LAS unsigned*)(wl + (8 * ib + 4 + j) * 272 + lane * 4) = pk2(hr, hi); }
    }
}
__device__ __forceinline__ void s5_passA_item(const Args& a, int item, int lane) {
    const int b = item >> 8, g = (item >> 3) & 31, seg = item & 7;
    S5Consts c; s5_consts(a, g, lane, c);
    float hr = 0.f, hi = 0.f;
    const int row0 = b * SEQ + seg * 1024;
    const bf16_t* up_ = (const bf16_t*)(a.ws + WS_PROJ) + (size_t)(row0 + (lane & 31)) * NPROJ + 1536 + g * 16 + 8 * (lane >> 5);
    bf16x8 uf = *(const bf16x8*)up_;
    for (int blk = 0; blk < 32; ++blk) { const int nb = blk < 31 ? blk + 1 : 31; bf16x8 nuf; s5_block<false>(a, c, uf, lane, hr, hi, nullptr, up_ + (size_t)nb * 32 * NPROJ, nuf); uf = nuf; }
    float* loc = (float*)(a.ws + WS_S5LOC) + (size_t)item * 128;
    loc[lane] = hr; loc[64 + lane] = hi;
}
constexpr int S5_LD = 272;
__device__ __forceinline__ void s5_passC_run(const Args& a, LAS unsigned char* wlds, int row0, int nblk, int g, int lane, float& hr, float& hi) {
    S5Consts c; s5_consts(a, g, lane, c);
    const int r16 = lane & 15, q4 = lane >> 4;
    bf16x8 ca[4];
#pragma unroll
    for (int kb = 0; kb < 4; ++kb) { float v[8];
#pragma unroll
        for (int j = 0; j < 8; ++j) { const int comp = 32 * kb + 8 * q4 + j, p = comp >> 1; v[j] = (comp & 1) ? -a.in[I_CIM][(size_t)(g * 16 + r16) * 64 + p] : a.in[I_CRE][(size_t)(g * 16 + r16) * 64 + p]; }
        u32x4 w; w.x = pk2(v[0], v[1]); w.y = pk2(v[2], v[3]); w.z = pk2(v[4], v[5]); w.w = pk2(v[6], v[7]); ca[kb] = __builtin_bit_cast(bf16x8, w); }
    bf16x4 ga[2];
#pragma unroll
    for (int mb = 0; mb < 2; ++mb) { float v[4];
#pragma unroll
        for (int j = 0; j < 4; ++j) v[j] = a.in[I_GLUW][(size_t)(g * 16 + 4 * q4 + j) * 32 + mb * 16 + r16];
        u32x2 w; w.x = pk2(v[0], v[1]); w.y = pk2(v[2], v[3]); ga[mb] = __builtin_bit_cast(bf16x4, w); }
    f32x4 dD, gb0, gb1;
#pragma unroll
    for (int j = 0; j < 4; ++j) { dD[j] = a.in[I_S5D][g * 16 + 4 * q4 + j]; gb0[j] = a.in[I_GLUB][g * 32 + 4 * q4 + j]; gb1[j] = a.in[I_GLUB][g * 32 + 16 + 4 * q4 + j]; }
    const bf16_t* proj = (const bf16_t*)(a.ws + WS_PROJ);
    bf16_t* mixin = (bf16_t*)(a.ws + WS_MIXIN);
    const bf16_t* up_ = proj + (size_t)(row0 + (lane & 31)) * NPROJ + 1536 + g * 16 + 8 * (lane >> 5);
    bf16x8 uf = *(const bf16x8*)up_;
    u32x2 uus[2], uun[2];
#pragma unroll
    for (int sb = 0; sb < 2; ++sb) uus[sb] = *(const u32x2*)(proj + (size_t)(row0 + sb * 16 + r16) * NPROJ + 1536 + g * 16 + 4 * q4);
    for (int blk = 0; blk < nblk; ++blk) {
        const int rb = row0 + blk * 32;
        const int nb = blk < nblk - 1 ? blk + 1 : blk; bf16x8 nuf;
        s5_block<true>(a, c, uf, lane, hr, hi, wlds, up_ + (size_t)nb * 32 * NPROJ, nuf); uf = nuf;
#pragma unroll
        for (int sb = 0; sb < 2; ++sb) uun[sb] = *(const u32x2*)(proj + (size_t)(row0 + nb * 32 + sb * 16 + r16) * NPROJ + 1536 + g * 16 + 4 * q4);
        asm volatile("s_waitcnt lgkmcnt(0)" ::: "memory");
#pragma unroll
        for (int sb = 0; sb < 2; ++sb) {
            f32x4 y = (f32x4){0.f, 0.f, 0.f, 0.f};
#pragma unroll
            for (int kb = 0; kb < 4; ++kb) { const bf16x8 hb = *(const LAS bf16x8*)(wlds + (sb * 16 + r16) * S5_LD + (32 * kb + 8 * q4) * 2);
                y = __builtin_amdgcn_mfma_f32_16x16x32_bf16(ca[kb], hb, y, 0, 0, 0); }
            const int row = rb + sb * 16 + r16;
            const u32x2 uu = uus[sb];
            const float uv[4] = {bf2f(uu.x & 0xffff), bf2f(uu.x >> 16), bf2f(uu.y & 0xffff), bf2f(uu.y >> 16)};
            float ge[4];
#pragma unroll
            for (int j = 0; j < 4; ++j) ge[j] = gelu_tanh(y[j] + dD[j] * uv[j]);
            u32x2 gw; gw.x = pk2(ge[0], ge[1]); gw.y = pk2(ge[2], ge[3]);
            const bf16x4 gbf = __builtin_bit_cast(bf16x4, gw);
            const f32x4 o0 = __builtin_amdgcn_mfma_f32_16x16x16bf16_1k(ga[0], gbf, gb0, 0, 0, 0);
            const f32x4 o1 = __builtin_amdgcn_mfma_f32_16x16x16bf16_1k(ga[1], gbf, gb1, 0, 0, 0);
            float ov[4];
#pragma unroll
            for (int j = 0; j < 4; ++j) ov[j] = o0[j] * __builtin_amdgcn_rcpf(1.f + __builtin_amdgcn_exp2f(-1.4426950409f * o1[j]));
            u32x2 ow; ow.x = pk2(ov[0], ov[1]); ow.y = pk2(ov[2], ov[3]);
            *(u32x2*)(mixin + (size_t)row * DM + 512 + g * 16 + 4 * q4) = ow;
        }
        asm volatile("s_waitcnt lgkmcnt(0)" ::: "memory");
        uus[0] = uun[0]; uus[1] = uun[1];
    }
}

#define XB_TMO      128
#define XB_XCNT(j)  (256  + 64 * (j))
#define XB_XSUB(j)  (1280 + 64 * (j))
#define XB_XGEN(j)  (2304 + 64 * (j))
#define XB_TOP      3328
#define XB_TOPGEN   3392
#define XCD_BAR_WORDS 3456
#define XB_SPIN_CAP (1u << 18)

__device__ __forceinline__ unsigned xb_ld(unsigned* p)              { return __hip_atomic_load(p, __ATOMIC_RELAXED, __HIP_MEMORY_SCOPE_AGENT); }
__device__ __forceinline__ unsigned xb_add(unsigned* p, unsigned v) { return __hip_atomic_fetch_add(p, v, __ATOMIC_RELAXED, __HIP_MEMORY_SCOPE_AGENT); }
__device__ __forceinline__ unsigned xb_xcc_id() { return (unsigned)__builtin_amdgcn_s_getreg((3 << 11) | 20) & 0xFu; }
#define XB_SPIN(cond, bar) do { unsigned _sp = 0; while (cond) { __builtin_amdgcn_s_sleep(1); \
    if ((++_sp & 255u) == 0u) { if (xb_ld(&(bar)[XB_TMO])) break; if (_sp > XB_SPIN_CAP) { atomicAdd(&(bar)[XB_TMO], 1u); break; } } } } while (0)

struct XcdBarrier {
    unsigned* bar; unsigned x;
    volatile LAS unsigned* st;
};

__device__ __forceinline__ XcdBarrier xcd_barrier_post(unsigned* bar, volatile LAS unsigned* st) {
    XcdBarrier b; b.bar = bar; b.x = xb_xcc_id(); b.st = st;
    if (threadIdx.x == 0) (void)xb_add(&bar[XB_XCNT(b.x)], 1u);
    return b;
}
__device__ __forceinline__ void xcd_barrier_complete(unsigned* bar, unsigned x, unsigned& nloc, unsigned& nx) {
    const unsigned G = gridDim.x * gridDim.y * gridDim.z;
    unsigned sum, cnt, mine, sp = 0u;
    for (;;) {
        sum = 0u; cnt = 0u; mine = 0u;
#pragma unroll
        for (unsigned j = 0; j < 16; ++j) { const unsigned c = xb_ld(&bar[XB_XCNT(j)]); sum += c; cnt += (c > 0u) ? 1u : 0u; mine = (j == x) ? c : mine; }
        if (sum == G) break;
        __builtin_amdgcn_s_sleep(1);
        if ((++sp & 255u) == 0u) { if (xb_ld(&bar[XB_TMO])) break; if (sp > XB_SPIN_CAP) { atomicAdd(&bar[XB_TMO], 1u); break; } }
    }
    nloc = mine > 0u ? mine : 1u; nx = cnt > 0u ? cnt : 1u;
}

__device__ __forceinline__ void xcd_barrier(const XcdBarrier& b) {
    asm volatile("s_waitcnt vmcnt(0)" ::: "memory");
    __syncthreads();
    if (threadIdx.x == 0) {
        unsigned* bar = b.bar;
        __builtin_amdgcn_s_waitcnt(0);
        unsigned nloc = b.st[0], nx = b.st[1];
        if (nloc == 0u) { xcd_barrier_complete(bar, b.x, nloc, nx); b.st[0] = nloc; b.st[1] = nx; }
        const unsigned old = xb_add(&bar[XB_XSUB(b.x)], 1u);
        const unsigned gen = old / nloc;
        if (old + 1u == (gen + 1u) * nloc) {
            __builtin_amdgcn_fence(__ATOMIC_RELEASE, "agent");
            asm volatile("s_waitcnt vmcnt(0)" ::: "memory");
            const unsigned og = xb_add(&bar[XB_TOP], 1u);
            const unsigned tg = og / nx;
            if (og + 1u == (tg + 1u) * nx) xb_add(&bar[XB_TOPGEN], 1u);
            else XB_SPIN(xb_ld(&bar[XB_TOPGEN]) == tg, bar);
            __builtin_amdgcn_fence(__ATOMIC_ACQUIRE, "agent");
            xb_add(&bar[XB_XGEN(b.x)], 1u);
            asm volatile("s_waitcnt vmcnt(0)" ::: "memory");
        } else {
            XB_SPIN(xb_ld(&bar[XB_XGEN(b.x)]) == gen, bar);
            __builtin_amdgcn_fence(__ATOMIC_ACQUIRE, "agent");
            asm volatile("s_waitcnt vmcnt(0)" ::: "memory");
        }
    }
    __syncthreads();
}


constexpr int LDS_BYTES = 163840;
__global__ void __launch_bounds__(512, 2) fwd_kernel(Args a) {
    extern __shared__ __attribute__((aligned(16))) unsigned char lds_raw[];
    LAS unsigned char* lds = (LAS unsigned char*)lds_raw;
    const int tid = threadIdx.x, lane = tid & 63, wave = __builtin_amdgcn_readfirstlane(tid >> 6);
    const int G = gridDim.x, bx = blockIdx.x;
    const int gw = bx * 8 + wave, NGW = G * 8;
    unsigned char* ws = a.ws;
#if ONE_LAUNCH
    cg::grid_group grid = cg::this_grid();
    volatile LAS unsigned* bst = (volatile LAS unsigned*)(lds + LDS_BYTES - 16);
    if (tid < 4) bst[tid] = 0u;
    __syncthreads();
    XcdBarrier xbar = xcd_barrier_post((unsigned*)(ws + WS_BAR), bst);
#define GSYNC() xcd_barrier(xbar)
#else
#define GSYNC() do {} while (0)
#endif
#ifndef PHMASK
#define PHMASK 0x3ff
#endif
#define IN(k) (((PHMASK >> (k)) & 1) && a.ph_lo <= (k) && (k) < a.ph_hi)
#define SEAM(k) do { if (IN(k) && IN((k) + 1)) GSYNC(); } while (0)

    if (IN(0)) { p0_prologue(a, lds, gw, NGW, lane, wave); }
#if ONE_LAUNCH
    if (a.ph_hi > 1000) grid.sync();
#endif
    SEAM(0);
    if (IN(1)) {
        pg8::Gemm g{(const bf16_t*)(ws + WS_HB), (const bf16_t*)(ws + WS_WIN), RP / 256, NPROJ / 256, DM, 64};
        pg8::StaticOrder S; S.init(g.nM, g.nN, G, bx);
        EpiProj E{(bf16_t*)(ws + WS_PROJ), (const float*)(ws + WS_RSTD1), NPROJ};
        pg8::gemm_phase<EpiProj>(lds, g, S, E);
        mini_gemm<0>(lds, (const bf16_t*)(ws + WS_HB) + (size_t)RP * DM, (const bf16_t*)(ws + WS_WIN), DM, NPROJ, (bf16_t*)(ws + WS_PROJ) + (size_t)RP * NPROJ, NPROJ, (const float*)(ws + WS_RSTD1) + RP, nullptr, bx, G, tid, wave, lane);
    }
    SEAM(1);
    if (IN(2)) {
        {
            const int sb = wave >> 2, sid = tid & 255, w4 = wave & 3;
            LAS unsigned char* sl = lds + sb * SUB_LDS; LAS unsigned* bcnt = (LAS unsigned*)(sl + L_SSD_END);
            if (sid == 0) *bcnt = 0u;
            __syncthreads();
            unsigned btarget = 0u;
            const bool spread = (G == 256);
            const int ulim = spread ? NBATCH * NCHUNK * 2 : NUNITS_BC * 2, u0 = bx * 2 + sb;
            const int nk = u0 < ulim ? (ulim - u0 + 2 * G - 1) / (2 * G) : 0;
            const int sj = (spread && sb == 0 && (bx & 15) == 8) ? (bx >> 4) : -1;
            if (sb) __builtin_amdgcn_s_sleep(100);
            for (int k = 0; k < nk + (sj >= 0 ? 1 : 0); ++k) ssd_passA_unit(a, sl, k < nk ? u0 + k * 2 * G : NBATCH * NCHUNK * 2 + sj, sid, w4, lane, bcnt, btarget);
            __syncthreads();
        }
        for (int it = gw; it < NBATCH * 32 * 8; it += NGW) s5_passA_item(a, it, lane);
        const bf16_t* proj = (const bf16_t*)(ws + WS_PROJ);
        for (int i = bx * 512 + tid; i < 16 * 3 * 1024; i += G * 512) {
            const int sq = i / 3072, rem = i % 3072, k = rem >> 10, ch = rem & 1023;
            const int row = sq < 8 ? sq * SEQ + SEQ - 3 + k : RP + (sq - 8) * DSEQ + DSEQ - 3 + k;
            const float v = bf2f(proj[(size_t)row * NPROJ + 512 + ch]);
            if (sq < 8) a.out[O_CONVP + (size_t)(sq * 3 + k) * 1024 + ch] = v; else a.out[O_CONVS + (size_t)((sq - 8) * 3 + k) * 1024 + ch] = v;
        }
    }
    SEAM(2);
    if (IN(3)) {
        bf16_t* sst = (bf16_t*)(ws + WS_SST); const float* cdec = (const float*)(ws + WS_CDEC);
        for (int i = bx * 512 + tid; i < 16 * 8 * 2048; i += G * 512) {
            const int sq = i >> 14, h = (i >> 11) & 7, e4 = (i & 2047) * 4;
            const bool smp = sq >= 8; const int b = sq & 7;
            const int nch = smp ? 1 : NCHUNK, slot0 = smp ? NBATCH * NCHUNK + b : b * NCHUNK;
            f32x4 hc = (f32x4){0.f, 0.f, 0.f, 0.f};
            if (smp) hc = *(const f32x4*)(a.in[I_SSSD] + ((size_t)(b * 8 + h) * 8192 + e4));
            for (int c = 0; c < nch; ++c) {
                u32x2* p = (u32x2*)(sst + ((size_t)(slot0 + c) * 8 + h) * 8192 + e4);
                const u32x2 w = *p; const float d = cdec[(size_t)(slot0 + c) * 8 + h];
                u32x2 o; o.x = pk2(hc[0], hc[1]); o.y = pk2(hc[2], hc[3]); *p = o;
                hc[0] = hc[0] * d + bf2f(w.x & 0xffff); hc[1] = hc[1] * d + bf2f(w.x >> 16); hc[2] = hc[2] * d + bf2f(w.y & 0xffff); hc[3] = hc[3] * d + bf2f(w.y >> 16);
            }
            *(f32x4*)(a.out + (smp ? O_SSDS : O_SSDP) + ((size_t)(b * 8 + h) * 8192 + e4)) = hc;
        }
        for (int i = bx * 512 + tid; i < NBATCH * 32 * 64; i += G * 512) {
            const int b = i >> 11, g = (i >> 6) & 31, p = i & 63;
            float lbr, lbi, qr, qi; s5_lambda(a, g, p, lbr, lbi, qr, qi);
            float pr = lbr, pi = lbi;
            for (int k = 0; k < 10; ++k) { const float nr = pr * pr - pi * pi, ni = 2.f * pr * pi; pr = nr; pi = ni; }
            const float* loc = (const float*)(ws + WS_S5LOC) + (size_t)((b * 32 + g) * 8) * 128; float* hin = (float*)(ws + WS_S5HIN) + (size_t)((b * 32 + g) * 8) * 128;
            float hr = 0.f, hi = 0.f;
            for (int s = 0; s < 8; ++s) { hin[s * 128 + p] = hr; hin[s * 128 + 64 + p] = hi;
                const float nr = pr * hr - pi * hi + loc[s * 128 + p], ni = pr * hi + pi * hr + loc[s * 128 + 64 + p]; hr = nr; hi = ni; }
            a.out[O_S5REP + i] = hr; a.out[O_S5IMP + i] = hi;
        }
    }
    SEAM(3);
    if (IN(4)) {
        {
            const int sb = wave >> 2, sid = tid & 255, w4 = wave & 3;
            LAS unsigned char* sl = lds + sb * SUB_LDS; LAS unsigned* bcnt = (LAS unsigned*)(sl + L_SSD_END);
            if (sid == 0) *bcnt = 0u;
            __syncthreads();
            unsigned btarget = 0u;
            const bool spread = (G == 256);
            const int ulim = spread ? NBATCH * NCHUNK * 2 : NUNITS_BC * 2, u0 = bx * 2 + sb;
            const int nk = u0 < ulim ? (ulim - u0 + 2 * G - 1) / (2 * G) : 0;
            const int sj = (spread && sb == 0 && (bx & 15) == 8) ? (bx >> 4) : -1;
            if (sb) __builtin_amdgcn_s_sleep(100);
            for (int k = 0; k < nk + (sj >= 0 ? 1 : 0); ++k) ssd_passC_unit(a, sl, k < nk ? u0 + k * 2 * G : NBATCH * NCHUNK * 2 + sj, sid, w4, lane, bcnt, btarget);
        }
        __syncthreads();
        LAS unsigned char* wlds = lds + wave * (32 * S5_LD);
        for (int it = gw; it < NBATCH * 32 * 8 + NBATCH * 32; it += NGW) {
            if (it < NBATCH * 32 * 8) {
                const int b = it >> 8, g = (it >> 3) & 31, seg = it & 7;
                const float* hin = (const float*)(ws + WS_S5HIN) + (size_t)it * 128;
                float hr = hin[lane], hi = hin[64 + lane];
                s5_passC_run(a, wlds, b * SEQ + seg * 1024, 32, g, lane, hr, hi);
            } else {
                const int j = it - NBATCH * 32 * 8, b = j >> 5, g = j & 31;
                float hr = a.in[I_S5RE][(size_t)(b * 32 + g) * 64 + lane], hi = a.in[I_S5IM][(size_t)(b * 32 + g) * 64 + lane];
                s5_passC_run(a, wlds, RP + b * DSEQ, 1, g, lane, hr, hi);
                a.out[O_S5RES + (size_t)(b * 32 + g) * 64 + lane] = hr; a.out[O_S5IMS + (size_t)(b * 32 + g) * 64 + lane] = hi;
            }
        }
        __syncthreads();
    }
    SEAM(4);
    if (IN(5)) {
        pg8::Gemm g{(const bf16_t*)(ws + WS_MIXIN), (const bf16_t*)(ws + WS_WOUT), RP / 256, DM / 256, DM, 64};
        pg8::StaticOrder S; S.init(g.nM, g.nN, G, bx);
        EpiSq E{(bf16_t*)(ws + WS_MIX), (float*)(ws + WS_SUMSQ2), DM};
        pg8::gemm_phase<EpiSq>(lds, g, S, E);
        mini_gemm<1>(lds, (const bf16_t*)(ws + WS_MIXIN) + (size_t)RP * DM, (const bf16_t*)(ws + WS_WOUT), DM, DM, (bf16_t*)(ws + WS_MIX) + (size_t)RP * DM, DM, nullptr, (float*)(ws + WS_SUMSQ2) + RP, bx, G, tid, wave, lane);
    }
    SEAM(5);
    if (IN(6)) {
        const bf16_t* mix = (const bf16_t*)(ws + WS_MIX); const float* s2 = (const float*)(ws + WS_SUMSQ2); bf16_t* hb = (bf16_t*)(ws + WS_HB); float* rstd3 = (float*)(ws + WS_RSTD3);
        const float* pw = a.in[I_POSTMIX];
        f32x4 w4[4];
#pragma unroll
        for (int q = 0; q < 4; ++q) w4[q] = *(const f32x4*)(pw + q * 256 + lane * 4);
        for (int row0 = 2 * gw; row0 < R; row0 += 2 * NGW) {
            f32x4 xv[2][4]; u32x2 mm[2][4]; float rs[2];
#pragma unroll
            for (int rr = 0; rr < 2; ++rr) { const int row = row0 + rr;
                rs[rr] = s2[row];
#pragma unroll
                for (int q = 0; q < 4; ++q) { const u32x2 xx = *(const u32x2*)(hb + (size_t)row * DM + q * 256 + lane * 4);
                    xv[rr][q][0] = bf2f(xx.x & 0xffff); xv[rr][q][1] = bf2f(xx.x >> 16); xv[rr][q][2] = bf2f(xx.y & 0xffff); xv[rr][q][3] = bf2f(xx.y >> 16);
                    mm[rr][q] = *(const u32x2*)(mix + (size_t)row * DM + q * 256 + lane * 4); } }
#pragma unroll
            for (int rr = 0; rr < 2; ++rr) { const int row = row0 + rr;
                const float r_ = 1.f / sqrtf(rs[rr] * (1.f / DM) + EPS);
                float ss = 0.f; f32x4 hv[4];
#pragma unroll
                for (int q = 0; q < 4; ++q) { const u32x2 m2 = mm[rr][q];
                    hv[q][0] = xv[rr][q][0] + bf2f(m2.x & 0xffff) * r_ * w4[q][0]; hv[q][1] = xv[rr][q][1] + bf2f(m2.x >> 16) * r_ * w4[q][1]; hv[q][2] = xv[rr][q][2] + bf2f(m2.y & 0xffff) * r_ * w4[q][2]; hv[q][3] = xv[rr][q][3] + bf2f(m2.y >> 16) * r_ * w4[q][3];
                    ss += (hv[q][0] * hv[q][0] + hv[q][1] * hv[q][1]) + (hv[q][2] * hv[q][2] + hv[q][3] * hv[q][3]); }
                ss = wave_sum(ss);
#pragma unroll
                for (int q = 0; q < 4; ++q) { u32x2 w; w.x = pk2(hv[q][0], hv[q][1]); w.y = pk2(hv[q][2], hv[q][3]); *(u32x2*)(hb + (size_t)row * DM + q * 256 + lane * 4) = w; }
                if (lane == 0) rstd3[row] = 1.f / sqrtf(ss * (1.f / DM) + EPS); }
        }
    }
    SEAM(6);
    if (IN(7)) {
        constexpr int nM = (R + 247) / 248;
        pg8::Gemm g{(const bf16_t*)(ws + WS_HB) - 2 * DM, (const bf16_t*)(ws + WS_WUP), nM, NUP / 256, DM, 62};
        pg8::StaticOrder S; S.init(g.nM, g.nN, G, bx);
        const int nfull = (nM * (NUP / 256)) % G;
        EpiUp E{(bf16_t*)(ws + WS_ACT), (const float*)(ws + WS_RSTD3), a.in[I_FCW], a.in[I_FCB], a.in[I_CFFN], a.out + O_FFNP, a.out + O_FFNS, lds + 131072};
        pg8::gemm_phase<EpiUp>(lds, g, S, E);
        if (nfull == 0 || G - nfull < 8) up_fixup(a, lds, bx, G, tid, wave, lane);
        else if (bx >= nfull) up_fixup(a, lds, bx - nfull, G - nfull, tid, wave, lane);
    }
    SEAM(7);
    if (IN(8)) {
        pg8::Gemm g{(const bf16_t*)(ws + WS_ACT), (const bf16_t*)(ws + WS_WDOWN), RP / 256, DM / 256, DFF, 64};
        pg8::StaticOrder S; S.init(g.nM, g.nN, G, bx);
        EpiSq E{(bf16_t*)(ws + WS_FFN), (float*)(ws + WS_SUMSQ4), DM};
        pg8::gemm_phase<EpiSq>(lds, g, S, E);
        mini_gemm<1>(lds, (const bf16_t*)(ws + WS_ACT) + (size_t)RP * DFF, (const bf16_t*)(ws + WS_WDOWN), DFF, DM, (bf16_t*)(ws + WS_FFN) + (size_t)RP * DM, DM, nullptr, (float*)(ws + WS_SUMSQ4) + RP, bx, G, tid, wave, lane);
    }
    SEAM(8);
    if (IN(9)) {
        const bf16_t* ffn = (const bf16_t*)(ws + WS_FFN); const float* s4 = (const float*)(ws + WS_SUMSQ4); const bf16_t* hb = (const bf16_t*)(ws + WS_HB);
        const float* pw = a.in[I_POSTFFN];
        f32x4 w4[4];
#pragma unroll
        for (int q = 0; q < 4; ++q) w4[q] = *(const f32x4*)(pw + q * 256 + lane * 4);
        for (int row0 = 2 * gw; row0 < R; row0 += 2 * NGW) {
            u32x2 hh[2][4], mm[2][4]; float rs[2];
#pragma unroll
            for (int rr = 0; rr < 2; ++rr) { const int row = row0 + rr; rs[rr] = s4[row];
#pragma unroll
                for (int q = 0; q < 4; ++q) { hh[rr][q] = *(const u32x2*)(hb + (size_t)row * DM + q * 256 + lane * 4); mm[rr][q] = *(const u32x2*)(ffn + (size_t)row * DM + q * 256 + lane * 4); } }
#pragma unroll
            for (int rr = 0; rr < 2; ++rr) { const int row = row0 + rr;
                float* yr = row < RP ? a.out + O_YP + (size_t)row * DM : a.out + O_YS + (size_t)(row - RP) * DM;
                const float r_ = 1.f / sqrtf(rs[rr] * (1.f / DM) + EPS);
#pragma unroll
                for (int q = 0; q < 4; ++q) { const u32x2 h2 = hh[rr][q], m2 = mm[rr][q];
                    f32x4 o; o[0] = bf2f(h2.x & 0xffff) + bf2f(m2.x & 0xffff) * r_ * w4[q][0]; o[1] = bf2f(h2.x >> 16) + bf2f(m2.x >> 16) * r_ * w4[q][1];
                    o[2] = bf2f(h2.y & 0xffff) + bf2f(m2.y & 0xffff) * r_ * w4[q][2]; o[3] = bf2f(h2.y >> 16) + bf2f(m2.y >> 16) * r_ * w4[q][3];
                    __builtin_nontemporal_store(o, (f32x4*)(yr + q * 256 + lane * 4)); } }
        }
    }
}

constexpr int NPHASE = 10;
extern "C" void kernel_launch(void* const* d_in, const int* in_sizes, int n_in, void* d_out, int out_size, void* d_ws, size_t ws_size, hipStream_t stream) {
    static int grid = 0;
    if (grid == 0) {
        if (n_in != 33 || ws_size < WS_END) { fprintf(stderr, "kernel_launch: unexpected n_in %d / ws %zu\n", n_in, ws_size); grid = -1; return; }
        int dev = 0, cus = 0, per_cu = 0;
        hipGetDevice(&dev); hipDeviceGetAttribute(&cus, hipDeviceAttributeMultiprocessorCount, dev);
        hipFuncSetAttribute((const void*)fwd_kernel, hipFuncAttributeMaxDynamicSharedMemorySize, LDS_BYTES);
        hipOccupancyMaxActiveBlocksPerMultiprocessor(&per_cu, (const void*)fwd_kernel, 512, LDS_BYTES);
        (void)hipGetLastError();
        if (per_cu < 1) per_cu = 1;
        grid = cus * 1;
    }
    if (grid < 0) return;
    Args a{};
    for (int i = 0; i < 33; ++i) a.in[i] = (const float*)d_in[i];
    a.out = (float*)d_out; a.ws = (unsigned char*)d_ws;
#if ONE_LAUNCH
    (void)hipMemsetAsync((char*)d_ws + WS_BAR, 0, 16384, stream);
    a.ph_lo = 0; a.ph_hi = NPHASE;
    void* args[] = {&a};
    hipError_t e = hipLaunchCooperativeKernel((const void*)fwd_kernel, dim3(grid), dim3(512), args, LDS_BYTES, stream);
    if (e != hipSuccess) fprintf(stderr, "cooperative launch failed: %s (grid %d)\n", hipGetErrorString(e), grid);
#else
#ifndef DUPMASK
#define DUPMASK 0
#endif
    for (int p = 0; p < NPHASE; ++p) { a.ph_lo = p; a.ph_hi = p + 1; for (int rep = 0; rep < (((DUPMASK >> p) & 1) ? 2 : 1); ++rep) hipLaunchKernelGGL(fwd_kernel, dim3(grid), dim3(512), LDS_BYTES, stream, a); }
#endif
}
```
